# Optimizing an MI355X kernel written in HIP

```python
import numpy as np
import jax
import jax.numpy as jnp
from jax import lax

D_MODEL = 1024
BATCH = 8
SEQ = 4096
DEPTH = 2

HEAD_DIM = 64
N_MIX_HEADS = D_MODEL // HEAD_DIM
MIX_WIDTH = N_MIX_HEADS * HEAD_DIM
NSA_HEADS = N_MIX_HEADS // 2
FOX_HEADS = N_MIX_HEADS // 4
SB_HEADS = N_MIX_HEADS - NSA_HEADS - FOX_HEADS
NSA_KV_GROUPS = 2
NSA_HEADS_PER_GROUP = NSA_HEADS // NSA_KV_GROUPS
NSA_CMP_LEN = 32
NSA_CMP_STRIDE = 16
NSA_CMP_HIDDEN = 128
NSA_SLC_LEN = 64
NSA_TOP_N = 16
NSA_WINDOW = 512
NSA_N_BRANCHES = 3
NSA_Q_BLOCK = 32
Q_BLOCK = 128
ROPE_THETA = 10000.0
RMS_EPS = 1e-6
PLE_DIM = 256
D_FF = -(-(8 * D_MODEL) // (3 * 256)) * 256
NEG_INF = -1e30
FORCE = 1e9
TINY = 1e-20

_NSA_KV = NSA_KV_GROUPS * HEAD_DIM
IN_SPLITS = (
    NSA_HEADS * HEAD_DIM,
    _NSA_KV, _NSA_KV,
    _NSA_KV, _NSA_KV,
    _NSA_KV, _NSA_KV,
    NSA_HEADS * NSA_N_BRANCHES,
    FOX_HEADS * HEAD_DIM, FOX_HEADS * HEAD_DIM, FOX_HEADS * HEAD_DIM,
    FOX_HEADS,
    SB_HEADS * HEAD_DIM, SB_HEADS * HEAD_DIM, SB_HEADS * HEAD_DIM,
)
IN_WIDTH = sum(IN_SPLITS)

kernel_name = "hybrid_nsa_fox_stickbreaking_parallel_heads"


def rms_norm(x, g):
    xf = x.astype(jnp.float32)
    y = xf * lax.rsqrt(jnp.mean(xf * xf, axis=-1, keepdims=True) + RMS_EPS)
    return (y * g.astype(jnp.float32)).astype(x.dtype)


def rope(x, positions):
    half = x.shape[-1] // 2
    inv_freq = ROPE_THETA ** (-jnp.arange(half, dtype=jnp.float32) / half)
    ang = positions.astype(jnp.float32)[..., None] * inv_freq
    cos = jnp.cos(ang)[:, :, None, :]
    sin = jnp.sin(ang)[:, :, None, :]
    xf = x.astype(jnp.float32)
    x1, x2 = xf[..., :half], xf[..., half:]
    return jnp.concatenate([x1 * cos - x2 * sin, x2 * cos + x1 * sin], axis=-1).astype(x.dtype)


def masked_softmax(logits, mask):
    l = jnp.where(mask, logits, NEG_INF)
    m = jnp.max(l, axis=-1, keepdims=True)
    e = jnp.where(mask, jnp.exp(l - m), 0.0)
    return e / jnp.maximum(jnp.sum(e, axis=-1, keepdims=True), TINY)


def compress_blocks(kv, pos_emb, w1, w2):
    b, s, g, d = kv.shape
    n_cmp = (s - NSA_CMP_LEN) // NSA_CMP_STRIDE + 1
    idx = np.arange(n_cmp)[:, None] * NSA_CMP_STRIDE + np.arange(NSA_CMP_LEN)[None, :]
    blocks = kv[:, idx] + pos_emb[:, None, :]
    blocks = blocks.transpose(0, 1, 3, 2, 4).reshape(b, n_cmp, g, NSA_CMP_LEN * d)
    return jax.nn.gelu(blocks @ w1) @ w2


def nsa_attention(q, k_cmp, v_cmp, k_slc, v_slc, k_win, v_win, gates,
                  pos_k, w1_k, w2_k, pos_v, w1_v, w2_v):
    b, s, h, d = q.shape
    g_, hpg, tq, win = NSA_KV_GROUPS, NSA_HEADS_PER_GROUP, NSA_Q_BLOCK, NSA_WINDOW
    scale = d ** -0.5
    kc = compress_blocks(k_cmp, pos_k, w1_k, w2_k)
    vc = compress_blocks(v_cmp, pos_v, w1_v, w2_v)
    n_cmp = kc.shape[1]
    cmp_start = np.arange(n_cmp) * NSA_CMP_STRIDE
    cmp_end = jnp.asarray(cmp_start + NSA_CMP_LEN - 1)
    n_blk = s // NSA_SLC_LEN
    n_sel = min(NSA_TOP_N, n_blk)
    blk_start = np.arange(n_blk) * NSA_SLC_LEN
    overlap = jnp.asarray(((cmp_start[:, None] < blk_start[None, :] + NSA_SLC_LEN)
                           & (cmp_start[:, None] + NSA_CMP_LEN > blk_start[None, :])).astype(np.float32))
    ks_blocks = k_slc.reshape(b, n_blk, NSA_SLC_LEN, g_, d).transpose(0, 3, 1, 2, 4)
    vs_blocks = v_slc.reshape(b, n_blk, NSA_SLC_LEN, g_, d).transpose(0, 3, 1, 2, 4)
    pad = ((0, 0), (win, 0), (0, 0), (0, 0))
    kw_pad = jnp.pad(k_win, pad)
    vw_pad = jnp.pad(v_win, pad)
    b_idx = jnp.arange(b)[:, None, None, None]
    g_idx = jnp.arange(g_)[None, :, None, None]
    blk_ids = jnp.arange(n_blk)
    win_off = jnp.arange(win + tq)
    slc_off = jnp.arange(NSA_SLC_LEN)

    def step(args):
        q_blk, g_blk, q0 = args
        t = q0 + jnp.arange(tq)
        qg = q_blk.reshape(b, tq, g_, hpg, d)
        s_c = jnp.einsum('btghd,bngd->bghtn', qg, kc).astype(jnp.float32) * scale
        p_c = masked_softmax(s_c, cmp_end[None, :] <= t[:, None])
        o_c = jnp.einsum('bghtn,bngd->btghd', p_c.astype(vc.dtype), vc)
        imp = jnp.einsum('bghtn,nj->bgtj', p_c, overlap)
        cur = t // NSA_SLC_LEN
        valid = blk_ids[None, :] <= cur[:, None]
        forced = ((blk_ids[None, :] == 0) | (blk_ids[None, :] == cur[:, None])
                  | (blk_ids[None, :] == cur[:, None] - 1))
        score = jnp.where(forced, FORCE, jnp.where(valid, imp, -FORCE))
        _, sel = lax.top_k(score, n_sel)
        ks = ks_blocks[b_idx, g_idx, sel]
        vs = vs_blocks[b_idx, g_idx, sel]
        s_s = jnp.einsum('btghd,bgtnkd->bghtnk', qg, ks).astype(jnp.float32) * scale
        kpos = sel[..., None] * NSA_SLC_LEN + slc_off
        mask_s = (kpos <= t[:, None, None])[:, :, None].reshape(b, g_, 1, tq, n_sel * NSA_SLC_LEN)
        p_s = masked_softmax(s_s.reshape(b, g_, hpg, tq, n_sel * NSA_SLC_LEN), mask_s)
        p_s = p_s.reshape(b, g_, hpg, tq, n_sel, NSA_SLC_LEN)
        o_s = jnp.einsum('bghtnk,bgtnkd->btghd', p_s.astype(vs.dtype), vs)
        kw = lax.dynamic_slice_in_dim(kw_pad, q0, win + tq, axis=1)
        vw = lax.dynamic_slice_in_dim(vw_pad, q0, win + tq, axis=1)
        s_pos = q0 - win + win_off
        diff = t[:, None] - s_pos[None, :]
        mask_w = (diff >= 0) & (diff < win) & (s_pos[None, :] >= 0)
        s_w = jnp.einsum('btghd,bkgd->bghtk', qg, kw).astype(jnp.float32) * scale
        p_w = masked_softmax(s_w, mask_w)
        o_w = jnp.einsum('bghtk,bkgd->btghd', p_w.astype(vw.dtype), vw)
        gt = g_blk.reshape(b, tq, g_, hpg, NSA_N_BRANCHES)
        o = gt[..., 0:1] * o_c + gt[..., 1:2] * o_s + gt[..., 2:3] * o_w
        return o.reshape(b, tq, h, d)

    nqb = s // tq
    q_b = q.reshape(b, nqb, tq, h, d).swapaxes(0, 1)
    g_b = gates.reshape(b, nqb, tq, h, NSA_N_BRANCHES).swapaxes(0, 1)
    starts = jnp.arange(nqb, dtype=jnp.int32) * tq
    out = lax.map(step, (q_b, g_b, starts))
    return out.swapaxes(0, 1).reshape(b, s, h, d)


def forgetting_attention(q, k, v, log_f):
    b, s, h, d = q.shape
    scale = d ** -0.5
    c = jnp.cumsum(log_f.astype(jnp.float32), axis=1).transpose(0, 2, 1)
    s_idx = jnp.arange(s)

    def step(args):
        q_blk, c_blk, q0 = args
        t = q0 + jnp.arange(Q_BLOCK)
        logits = (jnp.einsum('bthd,bshd->bhts', q_blk, k).astype(jnp.float32) * scale
                  + c_blk[..., None] - c[:, :, None, :])
        p = masked_softmax(logits, s_idx[None, :] <= t[:, None])
        return jnp.einsum('bhts,bshd->bthd', p.astype(v.dtype), v)

    nqb = s // Q_BLOCK
    q_b = q.reshape(b, nqb, Q_BLOCK, h, d).swapaxes(0, 1)
    c_b = c.reshape(b, h, nqb, Q_BLOCK).transpose(2, 0, 1, 3)
    starts = jnp.arange(nqb, dtype=jnp.int32) * Q_BLOCK
    out = lax.map(step, (q_b, c_b, starts))
    return out.swapaxes(0, 1).reshape(b, s, h, d)


def stick_breaking_attention(q, k, v):
    b, s, h, d = q.shape
    scale = d ** -0.5
    s_idx = jnp.arange(s)

    def step(args):
        q_blk, q0 = args
        t = q0 + jnp.arange(Q_BLOCK)
        z = jnp.einsum('bthd,bshd->bhts', q_blk, k).astype(jnp.float32) * scale
        mask = s_idx[None, :] < t[:, None]
        log_rest = jnp.where(mask, jax.nn.log_sigmoid(-z), 0.0)
        after = lax.cumsum(log_rest, axis=3, reverse=True) - log_rest
        a = jnp.where(mask, jnp.exp(jax.nn.log_sigmoid(z) + after), 0.0)
        return jnp.einsum('bhts,bshd->bthd', a.astype(v.dtype), v)

    nqb = s // Q_BLOCK
    q_b = q.reshape(b, nqb, Q_BLOCK, h, d).swapaxes(0, 1)
    starts = jnp.arange(nqb, dtype=jnp.int32) * Q_BLOCK
    out = lax.map(step, (q_b, starts))
    return out.swapaxes(0, 1).reshape(b, s, h, d)


def setup_inputs(seed: int = 0) -> dict:
    key = jax.random.key(seed)
    ks = jax.random.split(key, 24)
    f32 = jnp.float32
    L = DEPTH

    def nrm(k, shape, scale):
        return jax.random.normal(k, shape, f32) * scale

    cmp_in = NSA_CMP_LEN * HEAD_DIM
    return {
        "x": nrm(ks[0], (BATCH, SEQ, D_MODEL), 1.0),
        "p": nrm(ks[1], (DEPTH, BATCH, SEQ, PLE_DIM), 1.0),
        "positions": jnp.tile(jnp.arange(SEQ, dtype=jnp.int32)[None, :], (BATCH, 1)),
        "norm_mix": 1.0 + nrm(ks[2], (L, D_MODEL), 0.02),
        "w_in": nrm(ks[3], (L, D_MODEL, IN_WIDTH), D_MODEL ** -0.5),
        "b_nsa_gate": nrm(ks[4], (L, NSA_HEADS * NSA_N_BRANCHES), 0.1),
        "b_forget": 2.0 + nrm(ks[5], (L, FOX_HEADS), 0.5),
        "nsa_cmp_pos_k": nrm(ks[6], (L, NSA_CMP_LEN, HEAD_DIM), 0.1),
        "nsa_cmp_w1_k": nrm(ks[7], (L, cmp_in, NSA_CMP_HIDDEN), cmp_in ** -0.5),
        "nsa_cmp_w2_k": nrm(ks[8], (L, NSA_CMP_HIDDEN, HEAD_DIM), NSA_CMP_HIDDEN ** -0.5),
        "nsa_cmp_pos_v": nrm(ks[9], (L, NSA_CMP_LEN, HEAD_DIM), 0.1),
        "nsa_cmp_w1_v": nrm(ks[10], (L, cmp_in, NSA_CMP_HIDDEN), cmp_in ** -0.5),
        "nsa_cmp_w2_v": nrm(ks[11], (L, NSA_CMP_HIDDEN, HEAD_DIM), NSA_CMP_HIDDEN ** -0.5),
        "head_norm": 1.0 + nrm(ks[12], (L, MIX_WIDTH), 0.02),
        "w_out": nrm(ks[13], (L, MIX_WIDTH, D_MODEL), MIX_WIDTH ** -0.5),
        "norm_ffn": 1.0 + nrm(ks[14], (L, D_MODEL), 0.02),
        "w_ffn_gate": nrm(ks[15], (L, D_MODEL, D_FF), D_MODEL ** -0.5),
        "w_ffn_up": nrm(ks[16], (L, D_MODEL, D_FF), D_MODEL ** -0.5),
        "w_ffn_down": nrm(ks[17], (L, D_FF, D_MODEL), D_FF ** -0.5),
        "norm_ple": 1.0 + nrm(ks[18], (L, D_MODEL), 0.02),
        "w_ple_proj": nrm(ks[19], (L, PLE_DIM, D_MODEL), PLE_DIM ** -0.5),
        "w_ple_gate": nrm(ks[20], (L, D_MODEL, D_MODEL), D_MODEL ** -0.5),
        "norm_final": 1.0 + nrm(ks[21], (D_MODEL,), 0.02),
    }


def reference(x, p, positions, norm_mix, w_in, b_nsa_gate, b_forget,
              nsa_cmp_pos_k, nsa_cmp_w1_k, nsa_cmp_w2_k,
              nsa_cmp_pos_v, nsa_cmp_w1_v, nsa_cmp_w2_v,
              head_norm, w_out, norm_ffn, w_ffn_gate, w_ffn_up, w_ffn_down,
              norm_ple, w_ple_proj, w_ple_gate, norm_final):
    b, s, _ = x.shape
    offsets = [int(o) for o in np.cumsum(IN_SPLITS)[:-1]]

    def heads(a, n):
        return a.reshape(b, s, n, HEAD_DIM)

    h = x
    for i in range(DEPTH):
        hn = rms_norm(h, norm_mix[i])
        proj = hn @ w_in[i]
        (nq, nkc, nvc, nks, nvs, nkw, nvw, ngate,
         fq, fk, fv, ff, sq, sk, sv) = jnp.split(proj, offsets, axis=-1)
        nq = rope(heads(nq, NSA_HEADS), positions)
        nkc = rope(heads(nkc, NSA_KV_GROUPS), positions)
        nks = rope(heads(nks, NSA_KV_GROUPS), positions)
        nkw = rope(heads(nkw, NSA_KV_GROUPS), positions)
        gates = jax.nn.sigmoid(ngate.reshape(b, s, NSA_HEADS, NSA_N_BRANCHES)
                               + b_nsa_gate[i].reshape(NSA_HEADS, NSA_N_BRANCHES))
        o_nsa = nsa_attention(nq, nkc, heads(nvc, NSA_KV_GROUPS), nks, heads(nvs, NSA_KV_GROUPS),
                              nkw, heads(nvw, NSA_KV_GROUPS), gates,
                              nsa_cmp_pos_k[i], nsa_cmp_w1_k[i], nsa_cmp_w2_k[i],
                              nsa_cmp_pos_v[i], nsa_cmp_w1_v[i], nsa_cmp_w2_v[i])
        log_f = jax.nn.log_sigmoid((ff + b_forget[i]).astype(jnp.float32))
        o_fox = forgetting_attention(heads(fq, FOX_HEADS), heads(fk, FOX_HEADS),
                                     heads(fv, FOX_HEADS), log_f)
        o_sb = stick_breaking_attention(heads(sq, SB_HEADS), heads(sk, SB_HEADS), heads(sv, SB_HEADS))
        o = jnp.concatenate([o_nsa, o_fox, o_sb], axis=2)
        o = rms_norm(o, head_norm[i].reshape(N_MIX_HEADS, HEAD_DIM))
        h = h + o.reshape(b, s, MIX_WIDTH) @ w_out[i]
        hn = rms_norm(h, norm_ffn[i])
        h = h + (jax.nn.silu(hn @ w_ffn_gate[i]) * (hn @ w_ffn_up[i])) @ w_ffn_down[i]
        gate = jax.nn.sigmoid(rms_norm(h, norm_ple[i]) @ w_ple_gate[i])
        h = h + (p[i] @ w_ple_proj[i]) * gate
    return rms_norm(h, norm_final)
```

```cpp
#include <hip/hip_runtime.h>
#include <cstdio>
#include <cstdint>
#include <cmath>

typedef _Float16 half_t;
typedef _Float16 half8 __attribute__((ext_vector_type(8)));
typedef float f32x16 __attribute__((ext_vector_type(16)));
typedef float f32x4 __attribute__((ext_vector_type(4)));

constexpr int BATCH = 8, SEQ = 4096, DM = 1024, DEPTH = 2, T = BATCH * SEQ;
constexpr int HD = 64, NSA_H = 8, FOX_H = 4, SB_H = 4, NSA_G = 2;
constexpr int IN_W = 2844, DFF = 2816, PLE = 256;
constexpr int NCMP = 255, NCMP_PAD = 256, CMP_HID = 128;
constexpr float RMS_EPS = 1e-6f, TINY = 1e-20f;
constexpr float LOG2E = 1.4426950408889634f;
constexpr float QSCALE2 = 0.125f * LOG2E;
constexpr int C_NQ = 0, C_KC = 512, C_VC = 640, C_KS = 768, C_VS = 896, C_KW = 1024, C_VW = 1152, C_GATE = 1280,
              C_FQ = 1304, C_FK = 1560, C_FV = 1816, C_FF = 2072, C_SQ = 2076, C_SK = 2332, C_SV = 2588;

constexpr size_t MiB = 1u << 20;
constexpr size_t WS_CTL = 0;
constexpr size_t WS_SS = 1 * MiB;
constexpr size_t ZERO_BYTES = 2 * MiB;
constexpr size_t WS_ROPE = 2 * MiB;
constexpr size_t WS_H16 = 10 * MiB;
constexpr size_t WS_PROJ = 74 * MiB;
constexpr size_t WS_NQ = WS_PROJ;
constexpr size_t WS_KC_IN = WS_NQ + 32 * MiB;
constexpr size_t WS_VC_IN = WS_KC_IN + 8 * MiB;
constexpr size_t WS_KS = WS_VC_IN + 8 * MiB;
constexpr size_t WS_VS = WS_KS + 8 * MiB;
constexpr size_t WS_KW = WS_VS + 8 * MiB;
constexpr size_t WS_VW = WS_KW + 8 * MiB;
constexpr size_t WS_FQ = WS_VW + 8 * MiB;
constexpr size_t WS_FK = WS_FQ + 16 * MiB;
constexpr size_t WS_FV = WS_FK + 16 * MiB;
constexpr size_t WS_SQ = WS_FV + 16 * MiB;
constexpr size_t WS_SK = WS_SQ + 16 * MiB;
constexpr size_t WS_SV = WS_SK + 16 * MiB;
constexpr size_t WS_ACT = WS_PROJ;
constexpr size_t WS_GATES = WS_PROJ + 176 * MiB;
constexpr size_t WS_FLOG = WS_GATES + 3 * MiB;
constexpr size_t WS_CFOX = WS_FLOG + 1 * MiB;
constexpr size_t WS_KC = WS_CFOX + 1 * MiB;
constexpr size_t WS_VC = WS_KC + 1 * MiB;
constexpr size_t WS_O16 = WS_VC + 1 * MiB;
constexpr size_t WS_H16B = WS_O16 + 64 * MiB;
constexpr size_t WS_END = WS_H16B + 64 * MiB;
static_assert(WS_SV + 16 * MiB == WS_PROJ + 176 * MiB, "proj map");
static_assert((size_t)T * DFF * 2 == 176 * MiB, "act overlay");

__device__ __forceinline__ float wave_sum(float v) {
#pragma unroll
    for (int o = 1; o < 64; o <<= 1) v += __shfl_xor(v, o);
    return v;
}
__device__ __forceinline__ float wave_max(float v) {
#pragma unroll
    for (int o = 1; o < 64; o <<= 1) v = fmaxf(v, __shfl_xor(v, o));
    return v;
}
__device__ __forceinline__ float sigmoidf_(float x) { return 1.f / (1.f + expf(-x)); }
__device__ __forceinline__ float log_sigmoidf_(float x) { return fminf(x, 0.f) - log1pf(expf(-fabsf(x))); }

__global__ __launch_bounds__(256) void k_prologue(const float* x, const int* pos, half_t* h16, float* ss0, float2* rope) {
    const int row = blockIdx.x * 4 + (threadIdx.x >> 6), lane = threadIdx.x & 63;
    const float* xr = x + (size_t)row * DM; half_t* hr = h16 + (size_t)row * DM;
    float s = 0.f;
    for (int c = lane; c < DM; c += 64) { const float v = xr[c]; s += v * v; hr[c] = (half_t)v; }
    s = wave_sum(s);
    if (lane == 0) ss0[row] = s;
    if (lane < 32) {
        const float inv_freq = powf(10000.f, -(float)lane / 32.f);
        const float ang = (float)pos[row] * inv_freq;
        rope[(size_t)row * 32 + lane] = make_float2(cosf(ang), sinf(ang));
    }
}
__global__ __launch_bounds__(256) void k_rowss(const half_t* h16, float* ss) {
    const int row = blockIdx.x * 4 + (threadIdx.x >> 6), lane = threadIdx.x & 63;
    const half_t* hr = h16 + (size_t)row * DM; float s = 0.f;
    for (int c = lane; c < DM; c += 64) { const float v = (float)hr[c]; s += v * v; }
    s = wave_sum(s);
    if (lane == 0) ss[row] = s;
}
__global__ __launch_bounds__(256) void k_final(const half_t* h16, const float* ss, const float* g, float* out) {
    const int row = blockIdx.x * 4 + (threadIdx.x >> 6), lane = threadIdx.x & 63;
    const float rstd = rsqrtf(ss[row] * (1.f / DM) + RMS_EPS);
    for (int c = lane; c < DM; c += 64) out[(size_t)row * DM + c] = (float)h16[(size_t)row * DM + c] * rstd * g[c];
}

template <class AT, bool DUAL, class Epi>
__global__ __launch_bounds__(256) void k_gemm(const AT* A, int lda, const float* W, const float* W2, int ldw, const float* gain, int N, int K, Epi epi) {
    const int wave = threadIdx.x >> 6, lane = threadIdx.x & 63;
    const int row0 = blockIdx.y * 64 + (wave >> 1) * 32, col0 = blockIdx.x * 64 + (wave & 1) * 32;
    const int r = lane & 31, kh = lane >> 5;
    const int col = col0 + r; const bool cok = col < N;
    f32x16 acc = {0.f, 0.f, 0.f, 0.f, 0.f, 0.f, 0.f, 0.f, 0.f, 0.f, 0.f, 0.f, 0.f, 0.f, 0.f, 0.f}, acc2 = acc;
    const AT* ar = A + (size_t)(row0 + r) * lda;
    for (int k0 = 0; k0 < K; k0 += 8) {
        const int kb = k0 + 4 * kh;
        float a[4], b[4], b2[4];
#pragma unroll
        for (int i = 0; i < 4; ++i) {
            a[i] = (float)ar[kb + i] * (gain ? gain[kb + i] : 1.f);
            b[i] = cok ? W[(size_t)(kb + i) * ldw + col] : 0.f;
            if (DUAL) b2[i] = cok ? W2[(size_t)(kb + i) * ldw + col] : 0.f;
        }
#pragma unroll
        for (int i = 0; i < 4; ++i) {
            acc = __builtin_amdgcn_mfma_f32_32x32x2f32(a[i], b[i], acc, 0, 0, 0);
            if (DUAL) acc2 = __builtin_amdgcn_mfma_f32_32x32x2f32(a[i], b2[i], acc2, 0, 0, 0);
        }
    }
    if (!cok) return;
#pragma unroll
    for (int reg = 0; reg < 16; ++reg) {
        const int row = row0 + (reg & 3) + 8 * (reg >> 2) + 4 * kh;
        epi(row, col, acc[reg], acc2[reg]);
    }
}

struct EpiInProj {
    const float* ss; const float* b_gate; const float* b_forget;
    half_t *nq, *kc, *vc, *ks, *vs, *kw, *vw, *fq, *fk, *fv, *sq, *sk, *sv; float* gates; float* flog;
    __device__ void operator()(int row, int col, float v, float) const {
        v *= rsqrtf(ss[row] * (1.f / DM) + RMS_EPS);
        const int b = row / SEQ, s = row % SEQ;
        auto grp = [&](half_t* base, int c, int nh) { const int h = c >> 6, d = c & 63; base[(((size_t)b * nh + h) * SEQ + s) * 64 + d] = (half_t)v; };
        if (col < C_KC) nq[(size_t)row * 512 + col] = (half_t)v;
        else if (col < C_VC) grp(kc, col - C_KC, 2);
        else if (col < C_KS) grp(vc, col - C_VC, 2);
        else if (col < C_VS) grp(ks, col - C_KS, 2);
        else if (col < C_KW) grp(vs, col - C_VS, 2);
        else if (col < C_VW) grp(kw, col - C_KW, 2);
        else if (col < C_GATE) grp(vw, col - C_VW, 2);
        else if (col < C_FQ) gates[(size_t)row * 24 + (col - C_GATE)] = sigmoidf_(v + b_gate[col - C_GATE]);
        else if (col < C_FK) { v *= QSCALE2; grp(fq, col - C_FQ, 4); }
        else if (col < C_FV) grp(fk, col - C_FK, 4);
        else if (col < C_FF) grp(fv, col - C_FV, 4);
        else if (col < C_SQ) flog[((size_t)b * 4 + (col - C_FF)) * SEQ + s] = log_sigmoidf_(v + b_forget[col - C_FF]);
        else if (col < C_SK) { v *= 0.125f; grp(sq, col - C_SQ, 4); }
        else if (col < C_SV) grp(sk, col - C_SK, 4);
        else grp(sv, col - C_SV, 4);
    }
};
struct EpiResid { half_t* h16; __device__ void operator()(int row, int col, float v, float) const { half_t* p = h16 + (size_t)row * DM + col; *p = (half_t)((float)*p + v); } };
struct EpiSwiglu { const float* ss; half_t* act; __device__ void operator()(int row, int col, float g, float u) const {
    const float rstd = rsqrtf(ss[row] * (1.f / DM) + RMS_EPS); g *= rstd; u *= rstd;
    act[(size_t)row * DFF + col] = (half_t)(g / (1.f + expf(-g)) * u); } };
struct EpiStore16 { half_t* o; int ld; __device__ void operator()(int row, int col, float v, float) const { o[(size_t)row * ld + col] = (half_t)v; } };
struct EpiPle { const float* ss; const half_t* pp; const half_t* hin; half_t* hout; __device__ void operator()(int row, int col, float v, float) const {
    const float rstd = rsqrtf(ss[row] * (1.f / DM) + RMS_EPS); const size_t o = (size_t)row * DM + col;
    hout[o] = (half_t)((float)hin[o] + (float)pp[o] * sigmoidf_(v * rstd)); } };

__global__ __launch_bounds__(256) void k_rope(half_t* buf, const float2* rope, int nh, int token_major, float scale) {
    const size_t idx = (size_t)blockIdx.x * 256 + threadIdx.x;
    const int i = idx & 31; const size_t th = idx >> 5; const int h = th % nh; const int row = th / nh;
    if (row >= T) return;
    const int b = row / SEQ, s = row % SEQ;
    half_t* p = token_major ? buf + ((size_t)row * nh + h) * 64 : buf + (((size_t)b * nh + h) * SEQ + s) * 64;
    const float2 cs = rope[(size_t)row * 32 + i];
    const float x1 = (float)p[i], x2 = (float)p[i + 32];
    p[i] = (half_t)((x1 * cs.x - x2 * cs.y) * scale); p[i + 32] = (half_t)((x2 * cs.x + x1 * cs.y) * scale);
}
__global__ __launch_bounds__(64) void k_cumsum(const float* flog, float* c) {
    const int bh = blockIdx.x, lane = threadIdx.x; const float* f = flog + (size_t)bh * SEQ + lane * 64; float* o = c + (size_t)bh * SEQ + lane * 64;
    float tot = 0.f; for (int i = 0; i < 64; ++i) tot += f[i];
    float inc = tot;
#pragma unroll
    for (int d = 1; d < 64; d <<= 1) { const float v = __shfl_up(inc, d); if (lane >= d) inc += v; }
    float acc = inc - tot;
    for (int i = 0; i < 64; ++i) { acc += f[i]; o[i] = acc * LOG2E; }
}
__device__ __forceinline__ float gelu_tanh(float x) { return 0.5f * x * (1.f + tanhf(0.7978845608028654f * (x + 0.044715f * x * x * x))); }
__global__ __launch_bounds__(128) void k_compress(const half_t* kin, const float* pos, const float* w1, const float* w2, half_t* out) {
    const int n = blockIdx.x % NCMP_PAD, bg = blockIdx.x / NCMP_PAD;
    __shared__ float xs[2048]; __shared__ float hs[128];
    half_t* o = out + ((size_t)bg * NCMP_PAD + n) * 64;
    if (n >= NCMP) { if (threadIdx.x < 64) o[threadIdx.x] = (half_t)0.f; return; }
    const half_t* src = kin + ((size_t)bg * SEQ + 16 * n) * 64;
    for (int i = threadIdx.x; i < 2048; i += 128) xs[i] = (float)src[i] + pos[i];
    __syncthreads();
    float a = 0.f;
    for (int k = 0; k < 2048; ++k) a += xs[k] * w1[(size_t)k * 128 + threadIdx.x];
    hs[threadIdx.x] = gelu_tanh(a);
    __syncthreads();
    if (threadIdx.x < 64) { float r = 0.f; for (int k = 0; k < 128; ++k) r += hs[k] * w2[k * 64 + threadIdx.x]; o[threadIdx.x] = (half_t)r; }
}
__device__ __forceinline__ float dot64(const float* q, const half_t* k) {
    float s = 0.f; const uint4* kp = (const uint4*)k;
#pragma unroll
    for (int c = 0; c < 8; ++c) { const uint4 u = kp[c]; const half8 h = __builtin_bit_cast(half8, u);
#pragma unroll
        for (int j = 0; j < 8; ++j) s += q[c * 8 + j] * (float)h[j]; }
    return s;
}
__global__ __launch_bounds__(256) void k_nsa(const half_t* nq, const half_t* kc, const half_t* vc, const half_t* kslc, const half_t* vslc,
                                             const half_t* kwin, const half_t* vwin, const float* gates, half_t* o16) {
    const int bt = blockIdx.x >> 1, g = blockIdx.x & 1, b = bt / SEQ, t = bt % SEQ;
    const int hh = threadIdx.x >> 6, lane = threadIdx.x & 63, head = g * 4 + hh;
    __shared__ float qs[4][64]; __shared__ float sc[4][1024]; __shared__ float pc[4][256]; __shared__ float scoreb[64]; __shared__ int sel[16]; __shared__ int nsel;
    qs[hh][lane] = (float)nq[((size_t)bt * 8 + head) * 64 + lane];
    __syncthreads();
    const size_t bg = (size_t)b * 2 + g;
    const half_t* kcb = kc + bg * NCMP_PAD * 64; const half_t* vcb = vc + bg * NCMP_PAD * 64;
    int nv = t >= 31 ? (t - 31) / 16 + 1 : 0; if (nv > NCMP) nv = NCMP;
    float mx = -INFINITY;
    for (int n = lane; n < nv; n += 64) { const float s = dot64(qs[hh], kcb + (size_t)n * 64); sc[hh][n] = s; mx = fmaxf(mx, s); }
    mx = wave_max(mx); float l = 0.f;
    for (int n = lane; n < nv; n += 64) { const float e = exp2f(sc[hh][n] - mx); sc[hh][n] = e; l += e; }
    l = wave_sum(l); float inv = 1.f / fmaxf(l, TINY);
    for (int n = lane; n < 256; n += 64) pc[hh][n] = n < nv ? sc[hh][n] * inv : 0.f;
    __syncthreads();
    float oc = 0.f; for (int n = 0; n < nv; ++n) oc += pc[hh][n] * (float)vcb[(size_t)n * 64 + lane];
    const int cur = t >> 6;
    float score = 0.f;
    if (hh == 0) { const int j = lane; float imp = 0.f; const int n0 = max(4 * j - 1, 0), n1 = min(4 * j + 3, NCMP - 1);
        for (int n = n0; n <= n1; ++n) imp += (pc[0][n] + pc[1][n]) + (pc[2][n] + pc[3][n]);
        const bool forced = (j == 0) || (j == cur) || (j == cur - 1);
        score = forced ? 1e9f : (j <= cur ? imp : -1e9f); scoreb[j] = score; }
    __syncthreads();
    if (hh == 0) { const int j = lane; int rank = 0;
        for (int jj = 0; jj < 64; ++jj) { const float o = scoreb[jj]; rank += ((o > score) || (o == score && jj < j)) ? 1 : 0; }
        const bool s = (rank < 16) && (j <= cur); const unsigned long long m = __ballot(s);
        if (lane == 0) nsel = __popcll(m);
        if (s) sel[__popcll(m & ((1ull << lane) - 1ull))] = j; }
    __syncthreads();
    const half_t* ksb = kslc + bg * SEQ * 64; const half_t* vsb = vslc + bg * SEQ * 64;
    const int ns = nsel; mx = -INFINITY;
    for (int i = 0; i < ns; ++i) { const int key = sel[i] * 64 + lane; const float s = key <= t ? dot64(qs[hh], ksb + (size_t)key * 64) : -INFINITY; sc[hh][i * 64 + lane] = s; mx = fmaxf(mx, s); }
    mx = wave_max(mx); l = 0.f;
    for (int i = 0; i < ns; ++i) { const float s = sc[hh][i * 64 + lane]; const float e = (s == -INFINITY) ? 0.f : exp2f(s - mx); sc[hh][i * 64 + lane] = e; l += e; }
    l = wave_sum(l); inv = 1.f / fmaxf(l, TINY);
    __syncthreads();
    float os = 0.f;
    for (int i = 0; i < ns; ++i) { const half_t* vb = vsb + (size_t)sel[i] * 64 * 64; for (int kk = 0; kk < 64; ++kk) os += sc[hh][i * 64 + kk] * (float)vb[(size_t)kk * 64 + lane]; }
    os *= inv;
    __syncthreads();
    const half_t* kwb = kwin + bg * SEQ * 64; const half_t* vwb = vwin + bg * SEQ * 64;
    const int lo = max(0, t - 511), cnt = t - lo + 1; mx = -INFINITY;
    for (int i = lane; i < cnt; i += 64) { const float s = dot64(qs[hh], kwb + (size_t)(lo + i) * 64); sc[hh][i] = s; mx = fmaxf(mx, s); }
    mx = wave_max(mx); l = 0.f;
    for (int i = lane; i < cnt; i += 64) { const float e = exp2f(sc[hh][i] - mx); sc[hh][i] = e; l += e; }
    l = wave_sum(l); inv = 1.f / fmaxf(l, TINY);
    __syncthreads();
    float ow = 0.f; for (int i = 0; i < cnt; ++i) ow += sc[hh][i] * (float)vwb[(size_t)(lo + i) * 64 + lane];
    ow *= inv;
    const float* gt = gates + (size_t)bt * 24 + head * 3;
    const float o = gt[0] * oc + gt[1] * os + gt[2] * ow;
    const float ms = wave_sum(o * o) * (1.f / 64.f);
    o16[(size_t)bt * DM + head * 64 + lane] = (half_t)(o * rsqrtf(ms + RMS_EPS));
}
__global__ __launch_bounds__(128) void k_fox(const half_t* fq, const half_t* fk, const half_t* fv, const float* c, half_t* o16) {
    const int w = threadIdx.x >> 6, lane = threadIdx.x & 63;
    const int rowid = blockIdx.x * 2 + w; const int t = rowid % SEQ, bh = rowid / SEQ, b = bh / FOX_H, h = bh % FOX_H;
    __shared__ float qs[2][64]; __shared__ float sc[2][SEQ];
    qs[w][lane] = (float)fq[((size_t)bh * SEQ + t) * 64 + lane];
    __syncthreads();
    const half_t* kb = fk + (size_t)bh * SEQ * 64; const half_t* vb = fv + (size_t)bh * SEQ * 64; const float* cb = c + (size_t)bh * SEQ;
    const float ct = cb[t]; float mx = -INFINITY;
    for (int s = lane; s <= t; s += 64) { const float v = dot64(qs[w], kb + (size_t)s * 64) + ct - cb[s]; sc[w][s] = v; mx = fmaxf(mx, v); }
    mx = wave_max(mx); float l = 0.f;
    for (int s = lane; s <= t; s += 64) { const float e = exp2f(sc[w][s] - mx); sc[w][s] = e; l += e; }
    l = wave_sum(l); const float inv = 1.f / fmaxf(l, TINY);
    __syncthreads();
    float o = 0.f; for (int s = 0; s <= t; ++s) o += sc[w][s] * (float)vb[(size_t)s * 64 + lane];
    o *= inv;
    const float ms = wave_sum(o * o) * (1.f / 64.f);
    o16[((size_t)b * SEQ + t) * DM + (NSA_H + h) * 64 + lane] = (half_t)(o * rsqrtf(ms + RMS_EPS));
}
__global__ __launch_bounds__(128) void k_sb(const half_t* sq, const half_t* sk, const half_t* sv, half_t* o16) {
    const int w = threadIdx.x >> 6, lane = threadIdx.x & 63;
    const int rowid = blockIdx.x * 2 + w; const int t = rowid % SEQ, bh = rowid / SEQ, b = bh / SB_H, h = bh % SB_H;
    __shared__ float qs[2][64]; __shared__ float sc[2][SEQ];
    qs[w][lane] = (float)sq[((size_t)bh * SEQ + t) * 64 + lane];
    __syncthreads();
    const half_t* kb = sk + (size_t)bh * SEQ * 64; const half_t* vb = sv + (size_t)bh * SEQ * 64;
    float carry = 0.f;
    const int nchunk = (t + 63) / 64;
    for (int ch = nchunk - 1; ch >= 0; --ch) {
        const int s = ch * 64 + lane; const bool ok = s < t;
        float z = 0.f; if (ok) z = dot64(qs[w], kb + (size_t)s * 64);
        const float lr = ok ? log_sigmoidf_(-z) : 0.f;
        float suf = lr;
#pragma unroll
        for (int o = 1; o < 64; o <<= 1) { const float v = __shfl_down(suf, o); if (lane + o < 64) suf += v; }
        const float after = carry + suf - lr;
        sc[w][s] = ok ? expf(log_sigmoidf_(z) + after) : 0.f;
        carry += __shfl(suf, 0);
    }
    __syncthreads();
    float o = 0.f; for (int s = 0; s < t; ++s) o += sc[w][s] * (float)vb[(size_t)s * 64 + lane];
    const float ms = wave_sum(o * o) * (1.f / 64.f);
    o16[((size_t)b * SEQ + t) * DM + (NSA_H + FOX_H + h) * 64 + lane] = (half_t)(o * rsqrtf(ms + RMS_EPS));
}

extern "C" void kernel_launch(void* const* d_in, const int* in_sizes, int n_in, void* d_out, int out_size, void* d_ws, size_t ws_size, hipStream_t stream) {
    if (n_in != 23 || ws_size < WS_END) { fprintf(stderr, "kernel_launch: unexpected inputs (n_in %d, ws %zu < %zu)\n", n_in, ws_size, (size_t)WS_END); return; }
    const float* x = (const float*)d_in[0]; const float* p = (const float*)d_in[1]; const int* pos = (const int*)d_in[2];
    const float* norm_mix = (const float*)d_in[3]; const float* w_in = (const float*)d_in[4]; const float* b_gate = (const float*)d_in[5]; const float* b_forget = (const float*)d_in[6];
    const float* cpos_k = (const float*)d_in[7]; const float* cw1_k = (const float*)d_in[8]; const float* cw2_k = (const float*)d_in[9];
    const float* cpos_v = (const float*)d_in[10]; const float* cw1_v = (const float*)d_in[11]; const float* cw2_v = (const float*)d_in[12];
    const float* head_norm = (const float*)d_in[13]; const float* w_out = (const float*)d_in[14]; const float* norm_ffn = (const float*)d_in[15];
    const float* w_g = (const float*)d_in[16]; const float* w_u = (const float*)d_in[17]; const float* w_d = (const float*)d_in[18];
    const float* norm_ple = (const float*)d_in[19]; const float* w_pp = (const float*)d_in[20]; const float* w_pg = (const float*)d_in[21]; const float* norm_final = (const float*)d_in[22];
    unsigned char* ws = (unsigned char*)d_ws;
    float* ss = (float*)(ws + WS_SS); float2* rope = (float2*)(ws + WS_ROPE); half_t* h16 = (half_t*)(ws + WS_H16); half_t* h16b = (half_t*)(ws + WS_H16B);
    half_t *nq = (half_t*)(ws + WS_NQ), *kci = (half_t*)(ws + WS_KC_IN), *vci = (half_t*)(ws + WS_VC_IN), *ks = (half_t*)(ws + WS_KS), *vs = (half_t*)(ws + WS_VS),
           *kw = (half_t*)(ws + WS_KW), *vw = (half_t*)(ws + WS_VW), *fq = (half_t*)(ws + WS_FQ), *fk = (half_t*)(ws + WS_FK), *fv = (half_t*)(ws + WS_FV),
           *sq = (half_t*)(ws + WS_SQ), *sk = (half_t*)(ws + WS_SK), *sv = (half_t*)(ws + WS_SV), *act = (half_t*)(ws + WS_ACT), *kc = (half_t*)(ws + WS_KC), *vc = (half_t*)(ws + WS_VC),
           *o16 = (half_t*)(ws + WS_O16), *pp16 = (half_t*)(ws + WS_O16);
    float* gates = (float*)(ws + WS_GATES); float* flog = (float*)(ws + WS_FLOG); float* cfox = (float*)(ws + WS_CFOX);
    hipMemsetAsync(ws, 0, ZERO_BYTES, stream);
    k_prologue<<<T / 4, 256, 0, stream>>>(x, pos, h16, ss, rope);
    for (int L = 0; L < DEPTH; ++L) {
        float* ssA = ss + (size_t)(3 * L) * T; float* ssB = ss + (size_t)(3 * L + 1) * T; float* ssC = ss + (size_t)(3 * L + 2) * T; float* ssN = ss + (size_t)(3 * L + 3) * T;
        EpiInProj ein{ssA, b_gate + L * 24, b_forget + L * 4, nq, kci, vci, ks, vs, kw, vw, fq, fk, fv, sq, sk, sv, gates, flog};
        k_gemm<half_t, false, EpiInProj><<<dim3((IN_W + 63) / 64, T / 64), 256, 0, stream>>>(h16, DM, w_in + (size_t)L * DM * IN_W, nullptr, IN_W, norm_mix + L * DM, IN_W, DM, ein);
        k_rope<<<(T * 8 * 32) / 256, 256, 0, stream>>>(nq, rope, 8, 1, QSCALE2);
        k_rope<<<(T * 2 * 32) / 256, 256, 0, stream>>>(kci, rope, 2, 0, 1.f);
        k_rope<<<(T * 2 * 32) / 256, 256, 0, stream>>>(ks, rope, 2, 0, 1.f);
        k_rope<<<(T * 2 * 32) / 256, 256, 0, stream>>>(kw, rope, 2, 0, 1.f);
        k_cumsum<<<BATCH * FOX_H, 64, 0, stream>>>(flog, cfox);
        k_compress<<<BATCH * NSA_G * NCMP_PAD, 128, 0, stream>>>(kci, cpos_k + L * 2048, cw1_k + (size_t)L * 2048 * 128, cw2_k + (size_t)L * 128 * 64, kc);
        k_compress<<<BATCH * NSA_G * NCMP_PAD, 128, 0, stream>>>(vci, cpos_v + L * 2048, cw1_v + (size_t)L * 2048 * 128, cw2_v + (size_t)L * 128 * 64, vc);
        k_nsa<<<T * 2, 256, 0, stream>>>(nq, kc, vc, ks, vs, kw, vw, gates, o16);
        k_fox<<<BATCH * FOX_H * SEQ / 2, 128, 0, stream>>>(fq, fk, fv, cfox, o16);
        k_sb<<<BATCH * SB_H * SEQ / 2, 128, 0, stream>>>(sq, sk, sv, o16);
        k_gemm<half_t, false, EpiResid><<<dim3(DM / 64, T / 64), 256, 0, stream>>>(o16, DM, w_out + (size_t)L * DM * DM, nullptr, DM, head_norm + L * DM, DM, DM, EpiResid{h16});
        k_rowss<<<T / 4, 256, 0, stream>>>(h16, ssB);
        k_gemm<half_t, true, EpiSwiglu><<<dim3(DFF / 64, T / 64), 256, 0, stream>>>(h16, DM, w_g + (size_t)L * DM * DFF, w_u + (size_t)L * DM * DFF, DFF, norm_ffn + L * DM, DFF, DM, EpiSwiglu{ssB, act});
        k_gemm<half_t, false, EpiResid><<<dim3(DM / 64, T / 64), 256, 0, stream>>>(act, DFF, w_d + (size_t)L * DFF * DM, nullptr, DM, nullptr, DM, DFF, EpiResid{h16});
        k_rowss<<<T / 4, 256, 0, stream>>>(h16, ssC);
        k_gemm<float, false, EpiStore16><<<dim3(DM / 64, T / 64), 256, 0, stream>>>(p + (size_t)L * T * PLE, PLE, w_pp + (size_t)L * PLE * DM, nullptr, DM, nullptr, DM, PLE, EpiStore16{pp16, DM});
        k_gemm<half_t, false, EpiPle><<<dim3(DM / 64, T / 64), 256, 0, stream>>>(h16, DM, w_pg + (size_t)L * DM * DM, nullptr, DM, norm_ple + L * DM, DM, DM, EpiPle{ssC, pp16, h16, h16b});
        k_rowss<<<T / 4, 256, 0, stream>>>(h16b, ssN);
        { half_t* tmp = h16; h16 = h16b; h16b = tmp; }
    }
    k_final<<<T / 4, 256, 0, stream>>>(h16, ss + (size_t)6 * T, norm_final, (float*)d_out);
}
```

```cpp
#include <hip/hip_runtime.h>
#include <cstdio>
#include <cstdint>
#include <cmath>

typedef _Float16 half_t;
typedef _Float16 half8 __attribute__((ext_vector_type(8)));
typedef float f32x16 __attribute__((ext_vector_type(16)));
typedef float f32x4 __attribute__((ext_vector_type(4)));

constexpr int BATCH = 8, SEQ = 4096, DM = 1024, DEPTH = 2, T = BATCH * SEQ;
constexpr int HD = 64, NSA_H = 8, FOX_H = 4, SB_H = 4, NSA_G = 2;
constexpr int IN_W = 2844, DFF = 2816, PLE = 256;
constexpr int NCMP = 255, NCMP_PAD = 256, CMP_HID = 128;
constexpr float RMS_EPS = 1e-6f, TINY = 1e-20f;
constexpr float LOG2E = 1.4426950408889634f;
constexpr float QSCALE2 = 0.125f * LOG2E;
constexpr int C_NQ = 0, C_KC = 512, C_VC = 640, C_KS = 768, C_VS = 896, C_KW = 1024, C_VW = 1152, C_GATE = 1280,
              C_FQ = 1304, C_FK = 1560, C_FV = 1816, C_FF = 2072, C_SQ = 2076, C_SK = 2332, C_SV = 2588;

constexpr size_t MiB = 1u << 20;
constexpr size_t WS_CTL = 0;
constexpr size_t WS_SS = 1 * MiB;
constexpr size_t ZERO_BYTES = 2 * MiB;
constexpr size_t WS_BIAS = 2 * MiB - 4096;
constexpr size_t WS_ROPE = 2 * MiB;
constexpr size_t WS_H16 = 10 * MiB;
constexpr size_t WS_PROJ = 74 * MiB;
constexpr size_t WS_NQ = WS_PROJ;
constexpr size_t WS_KC_IN = WS_NQ + 32 * MiB;
constexpr size_t WS_VC_IN = WS_KC_IN + 8 * MiB;
constexpr size_t WS_KS = WS_VC_IN + 8 * MiB;
constexpr size_t WS_VS = WS_KS + 8 * MiB;
constexpr size_t WS_KW = WS_VS + 8 * MiB;
constexpr size_t WS_VW = WS_KW + 8 * MiB;
constexpr size_t WS_FQ = WS_VW + 8 * MiB;
constexpr size_t WS_FK = WS_FQ + 16 * MiB;
constexpr size_t WS_FV = WS_FK + 16 * MiB;
constexpr size_t WS_SQ = WS_FV + 16 * MiB;
constexpr size_t WS_SK = WS_SQ + 16 * MiB;
constexpr size_t WS_SV = WS_SK + 16 * MiB;
constexpr size_t WS_ACT = WS_PROJ;
constexpr size_t WS_GATES = WS_PROJ + 176 * MiB;
constexpr size_t WS_FLOG = WS_GATES + 3 * MiB;
constexpr size_t WS_CFOX = WS_FLOG + 1 * MiB;
constexpr size_t WS_KN = WS_CFOX + 512 * 1024;
constexpr size_t WS_KC = WS_CFOX + 1 * MiB;
constexpr size_t WS_VC = WS_KC + 1 * MiB;
constexpr size_t WS_O16 = WS_VC + 1 * MiB;
constexpr size_t WS_H16B = WS_O16 + 64 * MiB;
constexpr size_t WS_END = WS_H16B + 64 * MiB;
static_assert(WS_SV + 16 * MiB == WS_PROJ + 176 * MiB, "proj map");
static_assert((size_t)T * DFF * 2 == 176 * MiB, "act overlay");

__device__ __forceinline__ float wave_sum(float v) {
#pragma unroll
    for (int o = 1; o < 64; o <<= 1) v += __shfl_xor(v, o);
    return v;
}

typedef unsigned short u16;
#define GAS __attribute__((address_space(1)))
#define LAS __attribute__((address_space(3)))
template <int M> __device__ __forceinline__ float lx(float v) {
    static_assert(M >= 1 && M <= 16, "lx"); return __int_as_float(__builtin_amdgcn_ds_swizzle(__float_as_int(v), (M << 10) | 0x1F)); }
template <int M> __device__ __forceinline__ unsigned lxu(unsigned v) { return (unsigned)__builtin_amdgcn_ds_swizzle((int)v, (M << 10) | 0x1F); }
__device__ __forceinline__ float pair_sum(float v) { const unsigned u = __float_as_uint(v); const auto r = __builtin_amdgcn_permlane32_swap(u, u, false, false); return __uint_as_float(r[0]) + __uint_as_float(r[1]); }
__device__ __forceinline__ float pair_max(float v) { const unsigned u = __float_as_uint(v); const auto r = __builtin_amdgcn_permlane32_swap(u, u, false, false); return fmaxf(__uint_as_float(r[0]), __uint_as_float(r[1])); }
__device__ __forceinline__ float pair_other(float v, int hi) { const unsigned u = __float_as_uint(v); const auto r = __builtin_amdgcn_permlane32_swap(u, u, false, false); return __uint_as_float(hi ? r[0] : r[1]); }
__device__ __forceinline__ float wsum64(float v) { v += lx<1>(v); v += lx<2>(v); v += lx<4>(v); v += lx<8>(v); v += lx<16>(v); return pair_sum(v); }
__device__ __forceinline__ int lane_id_fresh() { int l; asm volatile("v_mbcnt_lo_u32_b32 %0, -1, 0\n\tv_mbcnt_hi_u32_b32 %0, -1, %0" : "=v"(l)); return l; }

namespace pg8 {
#define PG8_LAS __attribute__((address_space(3)))
typedef unsigned short bf16_t;
typedef _Float16 bf16x8 __attribute__((ext_vector_type(8)));
typedef float f32x4 __attribute__((ext_vector_type(4)));
typedef unsigned u32x4 __attribute__((ext_vector_type(4)));
constexpr int BM = 256, BK = 64, HALF = 128, HTB = HALF * BK * 2  , STAGE_BYTES = 8 * HTB, NXCD = 8, WGM = 8;

__host__ __device__ __forceinline__ int lds_byte(int r, int c) { const int st = (r >> 4) * 2 + (c >> 5), rr = r & 15, cc = c & 31, ob = rr * 64 + cc * 2; return st * 1024 + (ob ^ (((ob >> 9) & 1) << 5)); }
__host__ __device__ __forceinline__ void stage_rc(int b, int& R, int& C) { const int st = b / 1024, sb = b % 1024, swz = sb ^ (((sb >> 9) & 1) << 5); R = (st >> 1) * 16 + swz / 64; C = (st & 1) * 32 + (swz % 64) / 2; }
__host__ __device__ __forceinline__ int perm32(int rho) { const int n = rho >> 4, i = rho & 15; return 8 * (i >> 2) + 4 * n + (i & 3); }

struct Unit { int pm, pn; };
struct Gemm { const bf16_t* A; const bf16_t* Bt; int M, N, K; };

struct StaticOrder {
    int nM, nN, nwg, G, c;
    __host__ __device__ void init(int M, int N, int G_, int c_) { nM = M / BM; nN = N / BM; nwg = nM * nN; G = G_; c = c_; }
    __host__ __device__ bool next(int i, Unit& u) const {
        const long L = (long)i * G + c; if (L >= nwg) return false;
        int wgid = (int)L; { const int q = nwg / NXCD, r = nwg % NXCD, xcd = wgid % NXCD, off = wgid / NXCD; wgid = (xcd < r ? xcd * (q + 1) : r * (q + 1) + (xcd - r) * q) + off; }
        const int nig = WGM * nN, gid = wgid / nig, fm = gid * WGM, gsz = (nM - fm) < WGM ? (nM - fm) : WGM;
        u.pm = fm + ((wgid % nig) % gsz); u.pn = (wgid % nig) / gsz; return true;
    }
    __device__ __forceinline__ void a_ready(const Unit&) const {}
    __device__ __forceinline__ void done(const Unit&) const {}
};


typedef _Float16 h16x8 __attribute__((ext_vector_type(8)));
__device__ __forceinline__ float rstd_of(const float* ss, int row) { return rsqrtf(((const GAS float*)ss)[row] * (1.f / 1024.f) + 1e-6f); }
__device__ __forceinline__ float fast_sigmoid(float x) { return __builtin_amdgcn_rcpf(1.f + __expf(-x)); }
__device__ unsigned pg8_sink_words[16 * 32];
__device__ __forceinline__ void pg8_pad16() {
#pragma unroll
    for (int i = 0; i < 16; ++i) ((GAS unsigned*)pg8_sink_words)[i * 32] = 0u; }
#define PG8_ACCV(ai, bj, m, j) (acc[ai][bj][m][(j) >> 2][(j) & 3])

struct EpiResid {
    static constexpr bool PERM = true, AFTER_DRAIN = false, IDEMPOTENT = false, NEEDS_ALIGN_EPI = false;
    bf16_t* h; float* ssn;
    __device__ __forceinline__ void operator()(const f32x4 (&acc)[2][2][4][2], const Unit& u, int wr, int wc, int fr, int fq) const {
        { int l_; asm volatile("v_mbcnt_lo_u32_b32 %0, -1, 0\n\tv_mbcnt_hi_u32_b32 %0, -1, %0" : "=v"(l_)); fr = l_ & 15; fq = l_ >> 4; }
        const int col0 = u.pn * BM + wc * 32 + 8 * fq;
        h16x8 hv[8][2];
#pragma unroll
        for (int g_ = 0; g_ < 8; ++g_) { const int row = u.pm * BM + (g_ >> 2) * HALF + wr * 64 + (g_ & 3) * 16 + fr;
#pragma unroll
            for (int bj = 0; bj < 2; ++bj) hv[g_][bj] = *(const GAS h16x8*)(h + (size_t)row * 1024 + col0 + bj * HALF); }
        asm volatile("" ::: "memory");
#pragma unroll
        for (int ai = 0; ai < 2; ++ai)
#pragma unroll
            for (int m = 0; m < 4; ++m) {
                const int row = u.pm * BM + ai * HALF + wr * 64 + m * 16 + fr; float s = 0.f;
#pragma unroll
                for (int bj = 0; bj < 2; ++bj) {
                    GAS h16x8* p = (GAS h16x8*)(h + (size_t)row * 1024 + col0 + bj * HALF); h16x8 o = hv[ai * 4 + m][bj];
#pragma unroll
                    for (int j = 0; j < 8; ++j) { const _Float16 r = (_Float16)((float)o[j] + PG8_ACCV(ai, bj, m, j)); o[j] = r; const float rf = (float)r; s += rf * rf; }
                    *p = o;
                }
                s += lx<16>(s); s = pair_sum(s);
                if (fq == 0) __builtin_amdgcn_global_atomic_fadd_f32((GAS float*)(ssn + row), s);
            }
    }
};
struct EpiSwiglu {
    static constexpr bool PERM = true, AFTER_DRAIN = false, IDEMPOTENT = true, NEEDS_ALIGN_EPI = false;
    const float* ss; bf16_t* act;
    __device__ __forceinline__ void operator()(const f32x4 (&acc)[2][2][4][2], const Unit& u, int wr, int wc, int fr, int fq) const {
        { int l_; asm volatile("v_mbcnt_lo_u32_b32 %0, -1, 0\n\tv_mbcnt_hi_u32_b32 %0, -1, %0" : "=v"(l_)); fr = l_ & 15; fq = l_ >> 4; }
        const int col0 = u.pn * HALF + wc * 32 + 8 * fq;
        float rsv[8];
#pragma unroll
        for (int i = 0; i < 8; ++i) rsv[i] = ((const GAS float*)ss)[u.pm * BM + (i >> 2) * HALF + wr * 64 + (i & 3) * 16 + fr];
        asm volatile("" ::: "memory");
#pragma unroll
        for (int ai = 0; ai < 2; ++ai)
#pragma unroll
            for (int m = 0; m < 4; ++m) {
                const int row = u.pm * BM + ai * HALF + wr * 64 + m * 16 + fr; const float rstd = rsqrtf(rsv[ai * 4 + m] * (1.f / 1024.f) + 1e-6f), r2 = rstd * rstd, rl = rstd * 1.4426950408889634f;
                h16x8 o;
                float ex[8], nu[8];
#pragma unroll
                for (int j = 0; j < 8; ++j) ex[j] = __builtin_amdgcn_exp2f(-(PG8_ACCV(ai, 0, m, j) * rl));
#pragma unroll
                for (int j = 0; j < 8; ++j) nu[j] = (PG8_ACCV(ai, 0, m, j) * r2) * PG8_ACCV(ai, 1, m, j);
#pragma unroll
                for (int j = 0; j < 8; ++j) ex[j] = __builtin_amdgcn_rcpf(1.f + ex[j]);
#pragma unroll
                for (int j = 0; j < 8; ++j) o[j] = (_Float16)(nu[j] * ex[j]);
                *(GAS h16x8*)(act + (size_t)row * 2816 + col0) = o;

            }
    }
};
struct EpiStore {
    static constexpr bool PERM = true, AFTER_DRAIN = false, IDEMPOTENT = true, NEEDS_ALIGN_EPI = false;
    bf16_t* o;
    __device__ __forceinline__ void operator()(const f32x4 (&acc)[2][2][4][2], const Unit& u, int wr, int wc, int fr, int fq) const {
        { int l_; asm volatile("v_mbcnt_lo_u32_b32 %0, -1, 0\n\tv_mbcnt_hi_u32_b32 %0, -1, %0" : "=v"(l_)); fr = l_ & 15; fq = l_ >> 4; }
        const int col0 = u.pn * BM + wc * 32 + 8 * fq;
#pragma unroll
        for (int ai = 0; ai < 2; ++ai)
#pragma unroll
            for (int m = 0; m < 4; ++m) {
                const int row = u.pm * BM + ai * HALF + wr * 64 + m * 16 + fr;
#pragma unroll
                for (int bj = 0; bj < 2; ++bj) { h16x8 v;
#pragma unroll
                    for (int j = 0; j < 8; ++j) v[j] = (_Float16)PG8_ACCV(ai, bj, m, j);
                    *(GAS h16x8*)(o + (size_t)row * 1024 + col0 + bj * HALF) = v; }
            }
    }
};
struct EpiPle {
    static constexpr bool PERM = true, AFTER_DRAIN = false, IDEMPOTENT = false, NEEDS_ALIGN_EPI = false;
    unsigned char* ws; int L;
    __device__ __forceinline__ void operator()(const f32x4 (&acc)[2][2][4][2], const Unit& u, int wr, int wc, int fr, int fq) const {
        { int l_; asm volatile("v_mbcnt_lo_u32_b32 %0, -1, 0\n\tv_mbcnt_hi_u32_b32 %0, -1, %0" : "=v"(l_)); fr = l_ & 15; fq = l_ >> 4; }
        const float* ss = (const float*)(ws + WS_SS) + (size_t)(3 * L + 2) * 32768; float* ssn = (float*)(ws + WS_SS) + (size_t)(3 * L + 3) * 32768;
        const bf16_t* pp = (const bf16_t*)(ws + WS_O16); const bf16_t* hin = (const bf16_t*)(ws + ((L & 1) ? WS_H16B : WS_H16)); bf16_t* hout = (bf16_t*)(ws + ((L & 1) ? WS_H16 : WS_H16B));
        const int col0 = u.pn * BM + wc * 32 + 8 * fq;
        float rsv[8];
#pragma unroll
        for (int i = 0; i < 8; ++i) rsv[i] = ((const GAS float*)ss)[u.pm * BM + (i >> 2) * HALF + wr * 64 + (i & 3) * 16 + fr];
        h16x8 so[8][2]; float sq[8];
#pragma unroll
        for (int ai = 0; ai < 2; ++ai) {
            h16x8 hv[4][2], pv[4][2];
#pragma unroll
            for (int m = 0; m < 4; ++m) { const int row = u.pm * BM + ai * HALF + wr * 64 + m * 16 + fr;
#pragma unroll
                for (int bj = 0; bj < 2; ++bj) { const size_t off = (size_t)row * 1024 + col0 + bj * HALF; hv[m][bj] = *(const GAS h16x8*)(hin + off); pv[m][bj] = *(const GAS h16x8*)(pp + off); } }
            asm volatile("" ::: "memory");
#pragma unroll
            for (int m = 0; m < 4; ++m) { const float rstd = rsqrtf(rsv[ai * 4 + m] * (1.f / 1024.f) + 1e-6f); float s = 0.f;
#pragma unroll
                for (int bj = 0; bj < 2; ++bj) { h16x8 o;
#pragma unroll
                    for (int j = 0; j < 8; ++j) { const _Float16 r = (_Float16)((float)hv[m][bj][j] + (float)pv[m][bj][j] * fast_sigmoid(PG8_ACCV(ai, bj, m, j) * rstd)); o[j] = r; const float rf = (float)r; s += rf * rf; }
                    so[ai * 4 + m][bj] = o; }
                s += lx<16>(s); sq[ai * 4 + m] = pair_sum(s); }
            asm volatile("" ::: "memory");
        }
#pragma unroll
        for (int g_ = 0; g_ < 8; ++g_) { const int row = u.pm * BM + (g_ >> 2) * HALF + wr * 64 + (g_ & 3) * 16 + fr;
#pragma unroll
            for (int bj = 0; bj < 2; ++bj) *(GAS h16x8*)(hout + (size_t)row * 1024 + col0 + bj * HALF) = so[g_][bj];
            if (fq == 0) __builtin_amdgcn_global_atomic_fadd_f32((GAS float*)(ssn + row), sq[g_]); }
    }
};
struct EpiPleFinal {
    static constexpr bool PERM = true, AFTER_DRAIN = false, IDEMPOTENT = false, NEEDS_ALIGN_EPI = true;
    unsigned char* ws; float* out; const float* gain; int L;
    __device__ __forceinline__ void operator()(const f32x4 (&acc)[2][2][4][2], const Unit& u, int wr, int wc, int fr, int fq) const {
        { int l_; asm volatile("v_mbcnt_lo_u32_b32 %0, -1, 0\n\tv_mbcnt_hi_u32_b32 %0, -1, %0" : "=v"(l_)); fr = l_ & 15; fq = l_ >> 4; }
        const float* ss = (const float*)(ws + WS_SS) + (size_t)(3 * L + 2) * 32768; float* ssn = (float*)(ws + WS_SS) + (size_t)(3 * L + 3) * 32768;
        const bf16_t* pp = (const bf16_t*)(ws + WS_O16); const bf16_t* hin = (const bf16_t*)(ws + ((L & 1) ? WS_H16B : WS_H16));
        unsigned* ctr = (unsigned*)(ws + WS_CTL) + 65536 + 64 * u.pm;
        const int col0 = u.pn * BM + wc * 32 + 8 * fq;
        float rsv[8];
#pragma unroll
        for (int i = 0; i < 8; ++i) rsv[i] = ((const GAS float*)ss)[u.pm * BM + (i >> 2) * HALF + wr * 64 + (i & 3) * 16 + fr];
        float res[8][2][8]; float sq[8];
#pragma unroll
        for (int ai = 0; ai < 2; ++ai) {
            h16x8 hv[4][2], pv[4][2];
#pragma unroll
            for (int m = 0; m < 4; ++m) { const int row = u.pm * BM + ai * HALF + wr * 64 + m * 16 + fr;
#pragma unroll
                for (int bj = 0; bj < 2; ++bj) { const size_t off = (size_t)row * 1024 + col0 + bj * HALF; hv[m][bj] = *(const GAS h16x8*)(hin + off); pv[m][bj] = *(const GAS h16x8*)(pp + off); } }
            asm volatile("" ::: "memory");
#pragma unroll
            for (int m = 0; m < 4; ++m) { const float rstd = rsqrtf(rsv[ai * 4 + m] * (1.f / 1024.f) + 1e-6f); float s = 0.f;
#pragma unroll
                for (int bj = 0; bj < 2; ++bj)
#pragma unroll
                    for (int j = 0; j < 8; ++j) { const float r = (float)hv[m][bj][j] + (float)pv[m][bj][j] * fast_sigmoid(PG8_ACCV(ai, bj, m, j) * rstd); res[ai * 4 + m][bj][j] = r; s += r * r; }
                s += lx<16>(s); sq[ai * 4 + m] = pair_sum(s); }
            asm volatile("" ::: "memory");
        }
#pragma unroll
        for (int g_ = 0; g_ < 8; ++g_) { const int row = u.pm * BM + (g_ >> 2) * HALF + wr * 64 + (g_ & 3) * 16 + fr;
            if (fq == 0) __builtin_amdgcn_global_atomic_fadd_f32((GAS float*)(ssn + row), sq[g_]); }
        asm volatile("s_waitcnt vmcnt(0)" ::: "memory");
        if (fq == 0 && fr == 0) __hip_atomic_fetch_add(ctr, 1u, __ATOMIC_RELAXED, __HIP_MEMORY_SCOPE_AGENT);
        while (__hip_atomic_load(ctr, __ATOMIC_RELAXED, __HIP_MEMORY_SCOPE_AGENT) < 32u) __builtin_amdgcn_s_sleep(2);
        asm volatile("" ::: "memory");
        f32x4 gv[2][2];
#pragma unroll
        for (int bj = 0; bj < 2; ++bj) { gv[bj][0] = *(const GAS f32x4*)(gain + col0 + bj * HALF); gv[bj][1] = *(const GAS f32x4*)(gain + col0 + bj * HALF + 4); }
        float rf[8];
#pragma unroll
        for (int g_ = 0; g_ < 8; ++g_) rf[g_] = __hip_atomic_load(ssn + u.pm * BM + (g_ >> 2) * HALF + wr * 64 + (g_ & 3) * 16 + fr, __ATOMIC_RELAXED, __HIP_MEMORY_SCOPE_AGENT);
#pragma unroll
        for (int g_ = 0; g_ < 8; ++g_) { const int row = u.pm * BM + (g_ >> 2) * HALF + wr * 64 + (g_ & 3) * 16 + fr; const float rstd = rsqrtf(rf[g_] * (1.f / 1024.f) + 1e-6f);
#pragma unroll
            for (int bj = 0; bj < 2; ++bj) { GAS f32x4* o = (GAS f32x4*)(out + (size_t)row * 1024 + col0 + bj * HALF); f32x4 a, b;
#pragma unroll
                for (int j = 0; j < 4; ++j) { a[j] = res[g_][bj][j] * rstd * gv[bj][0][j]; b[j] = res[g_][bj][4 + j] * rstd * gv[bj][1][j]; }
                o[0] = a; o[1] = b; } }
    }
};
struct EpiInProj {
    static constexpr bool PERM = true, AFTER_DRAIN = false, IDEMPOTENT = true, NEEDS_ALIGN_EPI = false;
    unsigned char* ws; int L;
    __device__ __forceinline__ void operator()(const f32x4 (&acc)[2][2][4][2], const Unit& u, int wr, int wc, int fr, int fq) const {
        { int l_; asm volatile("v_mbcnt_lo_u32_b32 %0, -1, 0\n\tv_mbcnt_hi_u32_b32 %0, -1, %0" : "=v"(l_)); fr = l_ & 15; fq = l_ >> 4; }
        const float* ss = (const float*)(ws + WS_SS) + (size_t)(3 * L) * 32768; const float2* rope = (const float2*)(ws + WS_ROPE);
        const float* b_gate = (const float*)(ws + WS_BIAS) + L * 32; const float* b_forget = b_gate + 24;
        bf16_t* const nq = (bf16_t*)(ws + WS_NQ); float* const gates = (float*)(ws + WS_GATES); float* const flog = (float*)(ws + WS_FLOG);
        const int slot = u.pn * 4 + wc;
        if (slot > 44) { pg8_pad16(); return; }
        bf16_t* base = nq; int nh = 8, hidx = slot; bool tokmajor = false, rope_on = false; float scale = 1.f;
        if (slot < 8) { tokmajor = true; rope_on = true; scale = 0.125f * 1.4426950408889634f; }
        else if (slot < 14) { const int t = slot - 8; base = (bf16_t*)(ws + (t < 2 ? WS_KC_IN : (t < 4 ? WS_KS : WS_KW))); nh = 2; hidx = t & 1; rope_on = true; }
        else if (slot < 20) { const int t = slot - 14; base = (bf16_t*)(ws + (t < 2 ? WS_VC_IN : (t < 4 ? WS_VS : WS_VW))); nh = 2; hidx = t & 1; }
        else if (slot < 44) { const int t = slot - 20, which = t >> 2; hidx = t & 3; nh = 4;
            base = (bf16_t*)(ws + WS_FQ + (size_t)which * (16u << 20));
            scale = which == 0 ? 0.125f * 1.4426950408889634f : (which == 3 ? 0.125f : 1.f); }
        float rsv[8];
#pragma unroll
        for (int i = 0; i < 8; ++i) rsv[i] = ((const GAS float*)ss)[u.pm * BM + (i >> 2) * HALF + wr * 64 + (i & 3) * 16 + fr];
        h16x8 so1[8], so2[8];
        f32x4 rb[2][4];
        const int rrow0 = u.pm * BM + wr * 64 + fr;
        f32x4 bg0 = {0.f, 0.f, 0.f, 0.f}, bg1 = bg0;
        if (slot == 44) { if (fq < 3) { bg0 = *(const GAS f32x4*)(b_gate + 8 * fq); bg1 = *(const GAS f32x4*)(b_gate + 8 * fq + 4); } else bg0 = *(const GAS f32x4*)b_forget; }
#pragma unroll
        for (int ai = 0; ai < 2; ++ai) {
#pragma unroll
            for (int m = 0; m < 4; ++m) {
                if (rope_on && (m & 1) == 0) {
#pragma unroll
                    for (int mm = m; mm < m + 2; ++mm) { const GAS f32x4* cs = (const GAS f32x4*)(rope + (size_t)(rrow0 + ai * HALF + mm * 16) * 32 + 8 * fq);
#pragma unroll
                        for (int jj = 0; jj < 4; ++jj) rb[mm & 1][jj] = cs[jj]; }
                    asm volatile("" ::: "memory"); }
                const int row = u.pm * BM + ai * HALF + wr * 64 + m * 16 + fr; const float rs = rsqrtf(rsv[ai * 4 + m] * (1.f / 1024.f) + 1e-6f) * scale;
                const int b = row >> 12, s = row & 4095;
                constexpr int dummy_ = 0; (void)dummy_;
                const int g_ = ai * 4 + m;
                if (slot == 44) {
                    float v[8];
#pragma unroll
                    for (int j = 0; j < 8; ++j) v[j] = PG8_ACCV(ai, 0, m, j) * rs;
                    if (fq < 3) { const f32x4 b0 = bg0, b1 = bg1; f32x4 o0, o1;
#pragma unroll
                        for (int j = 0; j < 4; ++j) { o0[j] = 1.f / (1.f + expf(-(v[j] + b0[j]))); o1[j] = 1.f / (1.f + expf(-(v[4 + j] + b1[j]))); }
                        float* gp = gates + (size_t)row * 24 + 8 * fq; *(GAS f32x4*)gp = o0; *(GAS f32x4*)(gp + 4) = o1; }
                    else { const f32x4 bf = bg0; GAS float* fp = (GAS float*)(flog + (size_t)b * 4 * 4096 + s);
#pragma unroll
                        for (int j = 0; j < 4; ++j) { const float xx = v[j] + bf[j]; fp[(size_t)j * 4096] = fminf(xx, 0.f) - log1pf(expf(-fabsf(xx))); } }
                    asm volatile("" ::: "memory");
                    continue;
                }
                float x1[8], x2[8];
#pragma unroll
                for (int j = 0; j < 8; ++j) { x1[j] = PG8_ACCV(ai, 0, m, j) * rs; x2[j] = PG8_ACCV(ai, 1, m, j) * rs; }
                if (rope_on) {
#pragma unroll
                    for (int jj = 0; jj < 4; ++jj) { const f32x4 t = rb[m & 1][jj];
                        { const float a = x1[2 * jj], bb = x2[2 * jj]; x1[2 * jj] = a * t[0] - bb * t[1]; x2[2 * jj] = bb * t[0] + a * t[1]; }
                        { const float a = x1[2 * jj + 1], bb = x2[2 * jj + 1]; x1[2 * jj + 1] = a * t[2] - bb * t[3]; x2[2 * jj + 1] = bb * t[2] + a * t[3]; } }
                }
#pragma unroll
                for (int j = 0; j < 8; ++j) { so1[g_][j] = (_Float16)x1[j]; so2[g_][j] = (_Float16)x2[j]; }
                if (m & 1) asm volatile("" ::: "memory");
            }
        }
        if (slot != 44) {
#pragma unroll
            for (int g_ = 0; g_ < 8; ++g_) {
                const int row = u.pm * BM + (g_ >> 2) * HALF + wr * 64 + (g_ & 3) * 16 + fr, b = row >> 12, s = row & 4095;
                bf16_t* dst = tokmajor ? base + ((size_t)row * 8 + hidx) * 64 : base + (((size_t)b * nh + hidx) * 4096 + s) * 64;
                *(GAS h16x8*)(dst + 8 * fq) = so1[g_]; *(GAS h16x8*)(dst + 32 + 8 * fq) = so2[g_]; }
        }
    }
};
#undef PG8_ACCV

template <class Epi, class Sched, bool ALIGN_EPI = false, bool SP2 = false>
__device__ __forceinline__ void gemm_phase(PG8_LAS unsigned char* lds, const Gemm g, const Sched& S, const Epi& E, const int wave_idx  ) {
    static_assert(ALIGN_EPI || !Epi::NEEDS_ALIGN_EPI, "this epilogue waits for other workgroups: all eight waves must enter it together");
    int lane_; asm volatile("v_mbcnt_lo_u32_b32 %0, -1, 0\n\tv_mbcnt_hi_u32_b32 %0, -1, %0" : "=v"(lane_));
    int wid_ = wave_idx; asm volatile("" : "+s"(wid_));
    const int wid = wid_, lane = lane_, tid = wid * 64 + lane, wr = wid >> 2, wc = wid & 3, fr = lane & 15, fq = lane >> 4;
    const int K = g.K, nt = K / BK;
    unsigned voffA[2], voffB[2];
#pragma unroll
    for (int i = 0; i < 2; ++i) { int R, C; stage_rc(tid * 16 + i * 8192, R, C); const int Rb = Epi::PERM ? ((R & ~31) + perm32(R & 31)) : R;
        voffA[i] = (unsigned)(R * K + C) * 2u; voffB[i] = (unsigned)(Rb * K + C) * 2u; }
    const size_t kstep = (size_t)(BK * 2);
    const size_t hstep = (size_t)HALF * K * 2;
    const size_t tstep = 2 * hstep;
    const unsigned ldsw = (unsigned)wid * 1024u;
    const int aoff = lds_byte(wr * 64 + fr, fq * 8), boff = lds_byte(wc * 32 + fr, fq * 8);
#define PG8_SA(b, h) (((b) * 2 + (h)) * HTB)
#define PG8_SB(b, h) ((4 + (b) * 2 + (h)) * HTB)
#define PG8_STAGE(bufoff, gbase, voff) do { _Pragma("unroll") for (int _i = 0; _i < 2; ++_i) \
        __builtin_amdgcn_global_load_lds((const unsigned*)((const char*)(gbase) + (voff)[_i]), (PG8_LAS unsigned*)(lds + (bufoff) + ldsw + _i * 8192), 16, 0, 0); } while (0)
#define PG8_LDA(dst, b, h) do { _Pragma("unroll") for (int m = 0; m < 4; ++m) _Pragma("unroll") for (int k = 0; k < 2; ++k) dst[m][k] = *(const PG8_LAS bf16x8*)(lds + PG8_SA(b, h) + aoff + m * 2048 + k * 1024); } while (0)
#define PG8_LDB(dst, b, h) do { _Pragma("unroll") for (int n = 0; n < 2; ++n) _Pragma("unroll") for (int k = 0; k < 2; ++k) dst[n][k] = *(const PG8_LAS bf16x8*)(lds + PG8_SB(b, h) + boff + n * 2048 + k * 1024); } while (0)
#define PG8_MMA(ai, bj, At, Bt) do { __builtin_amdgcn_s_setprio(1); _Pragma("unroll") for (int m = 0; m < 4; ++m) _Pragma("unroll") for (int n = 0; n < 2; ++n) _Pragma("unroll") for (int k = 0; k < 2; ++k) \
        acc[ai][bj][m][n] = __builtin_amdgcn_mfma_f32_16x16x32_f16(Bt[n][k], At[m][k], acc[ai][bj][m][n], 0, 0, 0); __builtin_amdgcn_s_setprio(0); } while (0)
#define PG8_WAIT_V(n) asm volatile("s_waitcnt vmcnt(" #n ")" ::: "memory")
#define PG8_WAIT_V8_OR_24(tt) asm volatile("s_waitcnt vmcnt(24)\n\ts_cmp_eq_u32 %0, 0\n\ts_cbranch_scc1 .Lpg8w%=\n\ts_waitcnt vmcnt(8)\n.Lpg8w%=:" :: "s"(tt) : "memory", "scc")
#define PG8_WAIT_L(n) asm volatile("s_waitcnt lgkmcnt(" #n ")" ::: "memory")
#define PG8_BAR __builtin_amdgcn_s_barrier()
#define PG8_SCHED __builtin_amdgcn_sched_barrier(0)
    Unit cur, nxt; int ui = 0;
    if (!S.next(0, cur)) return;
    __builtin_amdgcn_s_waitcnt(0x0F70);
    f32x4 acc[2][2][4][2];
#pragma unroll
    for (int a = 0; a < 2; ++a)
#pragma unroll
        for (int b = 0; b < 2; ++b)
#pragma unroll
            for (int m = 0; m < 4; ++m)
#pragma unroll
                for (int n = 0; n < 2; ++n) acc[a][b][m][n] = (f32x4){0.f, 0.f, 0.f, 0.f};
    bf16x8 At[4][2], B0[2][2], B1[2][2];
    const char* cA = (const char*)g.A + (size_t)cur.pm * tstep; const char* cB = (const char*)g.Bt + (size_t)cur.pn * tstep;
    S.a_ready(cur);
    if constexpr (SP2) {
        PG8_STAGE(PG8_SB(0, 0), cB, voffB); PG8_STAGE(PG8_SB(0, 1), cB + hstep, voffB); PG8_STAGE(PG8_SA(0, 0), cA, voffA); PG8_STAGE(PG8_SA(0, 1), cA + hstep, voffA);
        if (wr == 1) PG8_BAR;
        PG8_WAIT_V(2); PG8_BAR;
        PG8_STAGE(PG8_SB(1, 0), cB + kstep, voffB); PG8_STAGE(PG8_SA(1, 0), cA + kstep, voffA); PG8_STAGE(PG8_SB(1, 1), cB + hstep + kstep, voffB);
        PG8_WAIT_V(6); PG8_BAR;
        pg8_pad16();
    } else {
        PG8_STAGE(PG8_SB(0, 0), cB, voffB); PG8_STAGE(PG8_SA(0, 0), cA, voffA); PG8_STAGE(PG8_SB(0, 1), cB + hstep, voffB); PG8_STAGE(PG8_SA(0, 1), cA + hstep, voffA);
        if (wr == 1) PG8_BAR;
        PG8_WAIT_V(4); PG8_BAR;
        PG8_STAGE(PG8_SB(1, 0), cB + kstep, voffB); PG8_STAGE(PG8_SA(1, 0), cA + kstep, voffA); PG8_STAGE(PG8_SB(1, 1), cB + hstep + kstep, voffB);
        PG8_WAIT_V(6); PG8_BAR;
    }
    for (;;) {
        const bool has_next = S.next(ui + 1, nxt);
        const char* nA = has_next ? (const char*)g.A + (size_t)nxt.pm * tstep : cA; const char* nB = has_next ? (const char*)g.Bt + (size_t)nxt.pn * tstep : cB;
        for (int t = 0; t < nt; t += 2) {
            const bool last = (t == nt - 2);
            const char* a1 = cA + (size_t)(t + 1) * kstep;
            const char* a2 = last ? nA : cA + (size_t)(t + 2) * kstep; const char* b2 = last ? nB : cB + (size_t)(t + 2) * kstep;
            const char* a3 = a2 + kstep; const char* b3 = b2 + kstep;
            if (last && has_next) S.a_ready(nxt);
            if constexpr (SP2) {
            PG8_LDB(B0, 0, 0); PG8_LDB(B1, 0, 1); PG8_SCHED; PG8_LDA(At, 0, 0); PG8_STAGE(PG8_SA(1, 1), a1 + hstep, voffA);
            PG8_WAIT_V8_OR_24(t);
            PG8_WAIT_L(0); PG8_BAR; PG8_MMA(0, 0, At, B0); PG8_MMA(0, 1, At, B1); PG8_BAR; PG8_SCHED;
            PG8_LDA(At, 0, 1); PG8_STAGE(PG8_SB(0, 0), b2, voffB); PG8_STAGE(PG8_SB(0, 1), b2 + hstep, voffB); PG8_STAGE(PG8_SA(0, 0), a2, voffA);
            PG8_WAIT_V8_OR_24(t);
            PG8_WAIT_L(0); PG8_BAR; PG8_MMA(1, 0, At, B0); PG8_MMA(1, 1, At, B1); PG8_BAR; PG8_SCHED;
            PG8_LDB(B0, 1, 0); PG8_LDB(B1, 1, 1); PG8_SCHED; PG8_LDA(At, 1, 0); PG8_STAGE(PG8_SA(0, 1), a2 + hstep, voffA);
            PG8_WAIT_V(8); PG8_WAIT_L(0); PG8_BAR; PG8_MMA(0, 0, At, B0); PG8_MMA(0, 1, At, B1); PG8_BAR; PG8_SCHED;
            PG8_LDA(At, 1, 1); PG8_STAGE(PG8_SB(1, 0), b3, voffB); PG8_STAGE(PG8_SB(1, 1), b3 + hstep, voffB); PG8_STAGE(PG8_SA(1, 0), a3, voffA);
            PG8_WAIT_V(8); PG8_WAIT_L(0); PG8_BAR; PG8_MMA(1, 0, At, B0); PG8_MMA(1, 1, At, B1); PG8_BAR; PG8_SCHED;
            } else {
            PG8_LDB(B0, 0, 0); PG8_SCHED; PG8_LDA(At, 0, 0); PG8_STAGE(PG8_SA(1, 1), a1 + hstep, voffA);
            PG8_WAIT_L(8); PG8_BAR; PG8_WAIT_L(0); PG8_MMA(0, 0, At, B0); PG8_BAR; PG8_SCHED;
            PG8_LDB(B1, 0, 1); PG8_STAGE(PG8_SB(0, 0), b2, voffB);
            PG8_BAR; PG8_WAIT_L(0); PG8_MMA(0, 1, At, B1); PG8_BAR;
            PG8_LDA(At, 0, 1); PG8_STAGE(PG8_SA(0, 0), a2, voffA);
            PG8_BAR; PG8_WAIT_L(0); PG8_MMA(1, 0, At, B0); PG8_BAR; PG8_SCHED;
            PG8_STAGE(PG8_SB(0, 1), b2 + hstep, voffB);
            PG8_WAIT_V(6); PG8_BAR; PG8_MMA(1, 1, At, B1); PG8_BAR;
            PG8_LDB(B0, 1, 0); PG8_SCHED; PG8_LDA(At, 1, 0); PG8_STAGE(PG8_SA(0, 1), a2 + hstep, voffA);
            PG8_WAIT_L(8); PG8_BAR; PG8_WAIT_L(0); PG8_MMA(0, 0, At, B0); PG8_BAR; PG8_SCHED;
            PG8_LDB(B1, 1, 1); PG8_STAGE(PG8_SB(1, 0), b3, voffB);
            PG8_BAR; PG8_WAIT_L(0); PG8_MMA(0, 1, At, B1); PG8_BAR;
            PG8_LDA(At, 1, 1); PG8_STAGE(PG8_SA(1, 0), a3, voffA);
            PG8_BAR; PG8_WAIT_L(0); PG8_MMA(1, 0, At, B0); PG8_BAR; PG8_SCHED;
            PG8_STAGE(PG8_SB(1, 1), b3 + hstep, voffB);
            PG8_WAIT_V(6); PG8_BAR; PG8_MMA(1, 1, At, B1); PG8_BAR;
            }
        }
        if constexpr (ALIGN_EPI) { if (wr == 0) PG8_BAR; }
        if constexpr (!Epi::AFTER_DRAIN) { E(acc, cur, wr, wc, fr, fq);
#if defined(PROBE_EPI)
            if constexpr (Epi::IDEMPOTENT) { asm volatile("" ::: "memory"); E(acc, cur, wr, wc, fr, fq); }
#endif
            S.done(cur); }
        if (!has_next) break;
#pragma unroll
        for (int a = 0; a < 2; ++a)
#pragma unroll
            for (int b = 0; b < 2; ++b)
#pragma unroll
                for (int m = 0; m < 4; ++m)
#pragma unroll
                    for (int n = 0; n < 2; ++n) acc[a][b][m][n] = (f32x4){0.f, 0.f, 0.f, 0.f};
        cur = nxt; cA = nA; cB = nB; ++ui;
        if constexpr (ALIGN_EPI) { if (wr == 1) PG8_BAR; }
    }
    PG8_WAIT_V(0);
    if constexpr (!ALIGN_EPI) { if (wr == 0) PG8_BAR; }
    PG8_BAR;
    if constexpr (Epi::AFTER_DRAIN) { E.fused(acc, cur, wr, wc, fr, fq, lds, wid, lane); S.done(cur); }
#undef PG8_SA
#undef PG8_SB
#undef PG8_STAGE
#undef PG8_LDA
#undef PG8_LDB
#undef PG8_MMA
#undef PG8_WAIT_V
#undef PG8_WAIT_V8_OR_24
#undef PG8_WAIT_L
#undef PG8_BAR
#undef PG8_SCHED
}
}

#define GAS __attribute__((address_space(1)))
#define LAS __attribute__((address_space(3)))
typedef unsigned v4u __attribute__((ext_vector_type(4)));
typedef GAS unsigned gu32;
typedef GAS unsigned long long gu64;
#define RLX_AGENT __ATOMIC_RELAXED, __HIP_MEMORY_SCOPE_AGENT
#define LDS_WAIT() asm volatile("s_waitcnt lgkmcnt(0)" ::: "memory")
#define VM_WAIT() asm volatile("s_waitcnt vmcnt(0)" ::: "memory")
__device__ __forceinline__ unsigned long long rt() { return __builtin_amdgcn_s_memrealtime(); }
__device__ __forceinline__ unsigned f2bf(float f) { unsigned u = __builtin_bit_cast(unsigned, f); return (u + 0x7fffu + ((u >> 16) & 1u)) >> 16; }
__device__ __forceinline__ unsigned pk2(float lo, float hi) { return f2bf(lo) | (f2bf(hi) << 16); }
#define XB_TMO      128
#define XB_XCNT(j)  (256  + 64 * (j))
#define XB_XSUB(j)  (1280 + 64 * (j))
#define XB_XGEN(j)  (2304 + 64 * (j))
#define XB_TOP      3328
#define XB_TOPGEN   3392
#define XCD_BAR_WORDS 3456
#define XB_SPIN_CAP (1u << 18)

__device__ __forceinline__ unsigned xb_ld(unsigned* p)              { return __hip_atomic_load(p, __ATOMIC_RELAXED, __HIP_MEMORY_SCOPE_AGENT); }
__device__ __forceinline__ unsigned xb_add(unsigned* p, unsigned v) { return __hip_atomic_fetch_add(p, v, __ATOMIC_RELAXED, __HIP_MEMORY_SCOPE_AGENT); }
__device__ __forceinline__ unsigned xb_xcc_id() { return (unsigned)__builtin_amdgcn_s_getreg((3 << 11) | 20) & 0xFu; }
#define XB_SPIN(cond, bar) do { unsigned _sp = 0; while (cond) { __builtin_amdgcn_s_sleep(1); \
    if ((++_sp & 255u) == 0u) { if (xb_ld(&(bar)[XB_TMO])) break; if (_sp > XB_SPIN_CAP) { atomicAdd(&(bar)[XB_TMO], 1u); break; } } } } while (0)

struct XcdBarrier {
    unsigned* bar; unsigned x;
    volatile LAS unsigned* st;
};

__device__ __forceinline__ XcdBarrier xcd_barrier_post(unsigned* bar, volatile LAS unsigned* st) {
    XcdBarrier b; b.bar = bar; b.x = xb_xcc_id(); b.st = st;
    if (threadIdx.x == 0) (void)xb_add(&bar[XB_XCNT(b.x)], 1u);
    return b;
}
__device__ __forceinline__ void xcd_barrier_complete(unsigned* bar, unsigned x, unsigned& nloc, unsigned& nx) {
    const unsigned G = gridDim.x * gridDim.y * gridDim.z;
    unsigned sum, cnt, mine, sp = 0u;
    for (;;) {
        sum = 0u; cnt = 0u; mine = 0u;
#pragma unroll
        for (unsigned j = 0; j < 16; ++j) { const unsigned c = xb_ld(&bar[XB_XCNT(j)]); sum += c; cnt += (c > 0u) ? 1u : 0u; mine = (j == x) ? c : mine; }
        if (sum == G) break;
        __builtin_amdgcn_s_sleep(1);
        if ((++sp & 255u) == 0u) { if (xb_ld(&bar[XB_TMO])) break; if (sp > XB_SPIN_CAP) { atomicAdd(&bar[XB_TMO], 1u); break; } }
    }
    nloc = mine > 0u ? mine : 1u; nx = cnt > 0u ? cnt : 1u;
}

__device__ __forceinline__ void xcd_barrier(const XcdBarrier& b, const bool is_thread0  ) {
    asm volatile("s_waitcnt vmcnt(0)" ::: "memory");
    __syncthreads();
    if (is_thread0) {
        unsigned* bar = b.bar;
        __builtin_amdgcn_s_waitcnt(0);
        unsigned nloc = b.st[0], nx = b.st[1];
        if (nloc == 0u) { xcd_barrier_complete(bar, b.x, nloc, nx); b.st[0] = nloc; b.st[1] = nx; }
        const unsigned old = xb_add(&bar[XB_XSUB(b.x)], 1u);
        const unsigned gen = old / nloc;
        if (old + 1u == (gen + 1u) * nloc) {
            __builtin_amdgcn_fence(__ATOMIC_RELEASE, "agent");
            asm volatile("s_waitcnt vmcnt(0)" ::: "memory");
            const unsigned og = xb_add(&bar[XB_TOP], 1u);
            const unsigned tg = og / nx;
            if (og + 1u == (tg + 1u) * nx) xb_add(&bar[XB_TOPGEN], 1u);
            else XB_SPIN(xb_ld(&bar[XB_TOPGEN]) == tg, bar);
            __builtin_amdgcn_fence(__ATOMIC_ACQUIRE, "agent");
            xb_add(&bar[XB_XGEN(b.x)], 1u);
            asm volatile("s_waitcnt vmcnt(0)" ::: "memory");
        } else {
            XB_SPIN(xb_ld(&bar[XB_XGEN(b.x)]) == gen, bar);
            __builtin_amdgcn_fence(__ATOMIC_ACQUIRE, "agent");
            asm volatile("s_waitcnt vmcnt(0)" ::: "memory");
        }
    }
    __syncthreads();
}


namespace att {
typedef _Float16 h8 __attribute__((ext_vector_type(8)));
typedef _Float16 h4 __attribute__((ext_vector_type(4)));
typedef float f16v __attribute__((ext_vector_type(16)));
typedef short s16x4 __attribute__((ext_vector_type(4)));
#define ATT_ZERO16 {0.f,0.f,0.f,0.f,0.f,0.f,0.f,0.f,0.f,0.f,0.f,0.f,0.f,0.f,0.f,0.f}
constexpr float NEG_BIG = -1e30f;
__device__ __forceinline__ float lz_() { float z = 0.f; asm volatile("" : "+v"(z)); return z; }
#define ATT_Z16() att::splat16(att::lz_())
constexpr int KT_BYTES = 8192;
constexpr int L_K = 0, L_V = 4 * KT_BYTES, L_C = 8 * KT_BYTES,
              L_FLAG = L_C + 1024, L_SLOT = L_FLAG + 64, L_PM = L_C + 1024 + 4096  , L_IMP = L_SLOT + 64, L_MASK = L_IMP + 64 * 65 * 4, L_CALL = L_MASK + 64 * 8, L_OT = L_CALL  , L_END = L_OT + 32 * 512 * 4;
static_assert(L_END <= 153600, "attention LDS map");
__device__ __forceinline__ f16v splat16(float z) { return (f16v){z,z,z,z,z,z,z,z,z,z,z,z,z,z,z,z}; }
__device__ __forceinline__ int crow(int r, int hi) { return (r & 3) + 8 * (r >> 2) + 4 * hi; }

typedef unsigned u4v __attribute__((ext_vector_type(4)));
struct TileRegs { u4v k, v; };
__device__ __forceinline__ void tile_load(TileRegs& r, const u16* Kg, const u16* Vg, int tid) { r.k = ((const GAS u4v*)Kg)[tid]; r.v = ((const GAS u4v*)Vg)[tid]; }
__device__ __forceinline__ void tile_store(const TileRegs& r, LAS unsigned char* bufK, LAS unsigned char* bufV, int tid) {
    const int key = tid >> 3, c = tid & 7;
    *(LAS u4v*)(bufK + key * 128 + ((c ^ ((key >> 1) & 7)) << 4)) = r.k;
    *(LAS u4v*)(bufV + key * 128 + ((c * 16) ^ (((key >> 1) & 1) << 6))) = r.v;
}
__device__ __forceinline__ void qk(f16v& p0, f16v& p1, const LAS unsigned char* bufK, const h8 (&q)[4], int r32, int hi) {
    const LAS unsigned char* kp = bufK + r32 * 128; const int sw = (r32 >> 1) & 7;
    h8 a0[4], a1[4];
#pragma unroll
    for (int d0 = 0; d0 < 4; ++d0) { const int off = ((2 * d0 + hi) ^ sw) << 4; a0[d0] = *(const LAS h8*)(kp + off); a1[d0] = *(const LAS h8*)(kp + 32 * 128 + off); }
    asm volatile("" : "+v"(a0[0]), "+v"(a0[1]), "+v"(a0[2]), "+v"(a0[3]), "+v"(a1[0]), "+v"(a1[1]), "+v"(a1[2]), "+v"(a1[3]));
#pragma unroll
    for (int d0 = 0; d0 < 4; ++d0) { p0 = __builtin_amdgcn_mfma_f32_32x32x16_f16(a0[d0], q[d0], p0, 0, 0, 0); p1 = __builtin_amdgcn_mfma_f32_32x32x16_f16(a1[d0], q[d0], p1, 0, 0, 0); }
}
__device__ __forceinline__ h4 tr_read(const LAS unsigned char* p) { return __builtin_bit_cast(h4, __builtin_amdgcn_ds_read_tr16_b64_v4i16((LAS s16x4*)p)); }
__device__ __forceinline__ void pv(f16v (&o)[2], const LAS unsigned char* bufV, const h8 (&pf)[4], int lane) {
    const int li = lane & 15, g = lane >> 4, hi = g >> 1;
    const int rowA = 4 * hi + (li >> 2);
    const int colb = (16 * (g & 1) + 4 * (li & 3)) * 2;
    const LAS unsigned char* base = bufV + rowA * 128;
    const int x = ((rowA >> 1) & 1) << 6;
#pragma unroll
    for (int dh = 0; dh < 2; ++dh) {
        h8 vf[4];
#pragma unroll
        for (int s = 0; s < 4; ++s) {
            const LAS unsigned char* a = base + s * 16 * 128 + ((colb + 64 * dh) ^ x);
            const h4 lo = tr_read(a), hi4 = tr_read(a + 8 * 128);
            vf[s] = (h8){lo[0], lo[1], lo[2], lo[3], hi4[0], hi4[1], hi4[2], hi4[3]};
        }
        asm volatile("" : "+v"(vf[0]), "+v"(vf[1]), "+v"(vf[2]), "+v"(vf[3]));
#pragma unroll
        for (int s = 0; s < 4; ++s) o[dh] = __builtin_amdgcn_mfma_f32_32x32x16_f16(vf[s], pf[s], o[dh], 0, 0, 0);
    }
}
typedef __fp16 fp16x2_t __attribute__((ext_vector_type(2)));
__device__ __forceinline__ void pack_p(h8 (&pf)[4], const f16v& p0, const f16v& p1) {
    typedef unsigned u4_ __attribute__((ext_vector_type(4)));
#pragma unroll
    for (int s = 0; s < 2; ++s) { u4_ a, b;
#pragma unroll
        for (int j = 0; j < 4; ++j) { a[j] = __builtin_bit_cast(unsigned, __builtin_amdgcn_cvt_pkrtz(p0[8 * s + 2 * j], p0[8 * s + 2 * j + 1])); b[j] = __builtin_bit_cast(unsigned, __builtin_amdgcn_cvt_pkrtz(p1[8 * s + 2 * j], p1[8 * s + 2 * j + 1])); }
        pf[s] = __builtin_bit_cast(h8, a); pf[2 + s] = __builtin_bit_cast(h8, b); }
}
constexpr float SM_THR = 8.f;
__device__ __forceinline__ float sm_ref(float m) { return m == NEG_BIG ? 0.f : m; }
template <bool NEGM = false>
__device__ __forceinline__ void softmax_step(f16v& p0, f16v& p1, float& m, float& l, f16v (&o)[2], f16v* negm = nullptr) {
    float mx = fmaxf(p0[0], p1[0]);
#pragma unroll
    for (int r = 1; r < 16; ++r) mx = fmaxf(fmaxf(mx, p0[r]), p1[r]);
    mx = pair_max(mx);
    const bool first = (m == NEG_BIG) && (mx != -INFINITY);
    const bool move = first || (mx > SM_THR);
    if (__any(move)) {
        const float d = move ? mx : 0.f, alpha = first ? 1.f : __builtin_amdgcn_exp2f(-d);
        if (move) m = sm_ref(m) + d;
        l *= alpha;
#pragma unroll
        for (int r = 0; r < 16; ++r) { o[0][r] *= alpha; o[1][r] *= alpha; p0[r] -= d; p1[r] -= d; }
        if constexpr (NEGM) { const float nm = -sm_ref(m);
#pragma unroll
            for (int r = 0; r < 16; ++r) (*negm)[r] = nm; }
    }
    typedef float f2_ __attribute__((ext_vector_type(2)));
    f2_ ls = {0.f, 0.f};
#pragma unroll
    for (int r = 0; r < 16; r += 2) { p0[r] = __builtin_amdgcn_exp2f(p0[r]); p0[r + 1] = __builtin_amdgcn_exp2f(p0[r + 1]); p1[r] = __builtin_amdgcn_exp2f(p1[r]); p1[r + 1] = __builtin_amdgcn_exp2f(p1[r + 1]);
        ls += (f2_){p0[r], p0[r + 1]} + (f2_){p1[r], p1[r + 1]}; }
    l += ls[0] + ls[1];
}
template <class RowPtr>
__device__ __forceinline__ void norm_store(const f16v (&o)[2], const RowPtr& rowp, LAS unsigned char* stage, int lane) {
    const int r32 = lane & 31, hi = lane >> 5;
    float ss = 0.f;
#pragma unroll
    for (int r = 0; r < 16; ++r) ss += o[0][r] * o[0][r] + o[1][r] * o[1][r];
    ss = pair_sum(ss);
    const float rs = rsqrtf(ss * (1.f / 64.f) + 1e-6f);
#pragma unroll
    for (int dh = 0; dh < 2; ++dh)
#pragma unroll
        for (int g = 0; g < 4; ++g) { const h4 v = {(_Float16)(o[dh][4 * g] * rs), (_Float16)(o[dh][4 * g + 1] * rs), (_Float16)(o[dh][4 * g + 2] * rs), (_Float16)(o[dh][4 * g + 3] * rs)};
            *(LAS h4*)(stage + r32 * 136 + (32 * dh + 8 * g + 4 * hi) * 2) = v; }
    asm volatile("s_waitcnt lgkmcnt(0)" ::: "memory");
    const int c = lane & 7;
#pragma unroll
    for (int j = 0; j < 4; ++j) { const int row = (lane >> 3) + 8 * j; const LAS unsigned char* sp = stage + row * 136 + c * 16;
        const h4 lo = *(const LAS h4*)sp, hi4 = *(const LAS h4*)(sp + 8);
        const h8 v = {lo[0], lo[1], lo[2], lo[3], hi4[0], hi4[1], hi4[2], hi4[3]};
        *(GAS h8*)(rowp(row) + 8 * c) = v; }
    asm volatile("s_waitcnt lgkmcnt(0)" ::: "memory");
}
__device__ __forceinline__ int fetch_unit(gu32* head, volatile LAS unsigned* slot, bool leader) {
    if (leader) *slot = __hip_atomic_fetch_add(head, 1u, __ATOMIC_RELAXED, __HIP_MEMORY_SCOPE_AGENT);
    __syncthreads(); const int u = (int)*slot; __syncthreads(); return u;
}

template <int DEPTH, class Body>
__device__ __forceinline__ void tile_walk(const u16* Kg, const u16* Vg, int kt0, int kt1, LAS unsigned char* lds, int tid, const Body& body) {
    if (kt0 >= kt1) return;
    if constexpr (DEPTH == 2) {
        TileRegs rA, rB;
        tile_load(rA, Kg + (size_t)kt0 * 4096, Vg + (size_t)kt0 * 4096, tid);
        if (kt0 + 1 < kt1) tile_load(rB, Kg + (size_t)(kt0 + 1) * 4096, Vg + (size_t)(kt0 + 1) * 4096, tid);
        tile_store(rA, lds + L_K, lds + L_V, tid);
        if (kt0 + 2 < kt1) tile_load(rA, Kg + (size_t)(kt0 + 2) * 4096, Vg + (size_t)(kt0 + 2) * 4096, tid);
        __syncthreads();
        int kt = kt0;
        for (;;) {
            body(kt, lds + L_K, lds + L_V);
            if (kt + 1 < kt1) tile_store(rB, lds + L_K + KT_BYTES, lds + L_V + KT_BYTES, tid);
            if (kt + 3 < kt1) tile_load(rB, Kg + (size_t)(kt + 3) * 4096, Vg + (size_t)(kt + 3) * 4096, tid);
            __syncthreads();
            if (++kt >= kt1) break;
            body(kt, lds + L_K + KT_BYTES, lds + L_V + KT_BYTES);
            if (kt + 1 < kt1) tile_store(rA, lds + L_K, lds + L_V, tid);
            if (kt + 3 < kt1) tile_load(rA, Kg + (size_t)(kt + 3) * 4096, Vg + (size_t)(kt + 3) * 4096, tid);
            __syncthreads();
            if (++kt >= kt1) break;
        }
    } else {
        TileRegs tr;
        tile_load(tr, Kg + (size_t)kt0 * 4096, Vg + (size_t)kt0 * 4096, tid);
        tile_store(tr, lds + L_K, lds + L_V, tid);
        __syncthreads();
        int it = 0;
        for (int kt = kt0; kt < kt1; ++kt, ++it) {
            const int cur = it & 1, nxt = cur ^ 1; const bool more = kt + 1 < kt1;
            if (more) tile_load(tr, Kg + (size_t)(kt + 1) * 4096, Vg + (size_t)(kt + 1) * 4096, tid);
            body(kt, lds + L_K + cur * KT_BYTES, lds + L_V + cur * KT_BYTES);
            if (more) tile_store(tr, lds + L_K + nxt * KT_BYTES, lds + L_V + nxt * KT_BYTES, tid);
            __syncthreads();
        }
    }
}

template <class Src, class Body>
__device__ __forceinline__ void tile_walk_src(int n, LAS unsigned char* lds, int tid, const Src& src, const Body& body) {
    if (n <= 0) return;
    TileRegs tr; const u16* Kp; const u16* Vp;
    src(0, Kp, Vp); tile_load(tr, Kp, Vp, tid);
    tile_store(tr, lds + L_K, lds + L_V, tid);
    __syncthreads();
    for (int v = 0; v < n; ++v) {
        const int cur = v & 1, nxt = cur ^ 1; const bool more = v + 1 < n;
        if (more) { src(v + 1, Kp, Vp); tile_load(tr, Kp, Vp, tid); }
        body(v, lds + L_K + cur * KT_BYTES, lds + L_V + cur * KT_BYTES);
        if (more) tile_store(tr, lds + L_K + nxt * KT_BYTES, lds + L_V + nxt * KT_BYTES, tid);
        __syncthreads();
    }
}

template <class Body>
__device__ __forceinline__ void tile_walk_pair(const u16* Kg, const u16* Vg, int kt0, int kt1, LAS unsigned char* lds, int tid, const Body& body) {
    if (kt0 >= kt1) return;
    TileRegs ra, rb;
    tile_load(ra, Kg + (size_t)kt0 * 4096, Vg + (size_t)kt0 * 4096, tid);
    if (kt0 + 1 < kt1) tile_load(rb, Kg + (size_t)(kt0 + 1) * 4096, Vg + (size_t)(kt0 + 1) * 4096, tid);
    tile_store(ra, lds + L_K, lds + L_V, tid);
    if (kt0 + 1 < kt1) tile_store(rb, lds + L_K + KT_BYTES, lds + L_V + KT_BYTES, tid);
    __syncthreads();
    int it = 0;
    for (int kt = kt0; kt < kt1; kt += 2, ++it) {
        const int cb = (it & 1) * 2 * KT_BYTES, nb = cb ^ (2 * KT_BYTES); const bool m1 = kt + 2 < kt1, m2 = kt + 3 < kt1;
        if (m1) tile_load(ra, Kg + (size_t)(kt + 2) * 4096, Vg + (size_t)(kt + 2) * 4096, tid);
        if (m2) tile_load(rb, Kg + (size_t)(kt + 3) * 4096, Vg + (size_t)(kt + 3) * 4096, tid);
        body(kt, lds + L_K + cb, lds + L_V + cb);
        if (kt + 1 < kt1) body(kt + 1, lds + L_K + cb + KT_BYTES, lds + L_V + cb + KT_BYTES);
        if (m1) tile_store(ra, lds + L_K + nb, lds + L_V + nb, tid);
        if (m2) tile_store(rb, lds + L_K + nb + KT_BYTES, lds + L_V + nb + KT_BYTES, tid);
        __syncthreads();
    }
}

template <class Body2>
__device__ __forceinline__ void tile_walk_pair2(const u16* Kg, const u16* Vg, int kt0, int kt1, LAS unsigned char* lds, int tid, const Body2& body2) {
    if (kt0 >= kt1) return;
    TileRegs ra, rb;
    tile_load(ra, Kg + (size_t)kt0 * 4096, Vg + (size_t)kt0 * 4096, tid);
    if (kt0 + 1 < kt1) tile_load(rb, Kg + (size_t)(kt0 + 1) * 4096, Vg + (size_t)(kt0 + 1) * 4096, tid);
    tile_store(ra, lds + L_K, lds + L_V, tid);
    if (kt0 + 1 < kt1) tile_store(rb, lds + L_K + KT_BYTES, lds + L_V + KT_BYTES, tid);
    __syncthreads();
    int it = 0;
    for (int kt = kt0; kt < kt1; kt += 2, ++it) {
        const int cb = (it & 1) * 2 * KT_BYTES, nb = cb ^ (2 * KT_BYTES); const bool m1 = kt + 2 < kt1, m2 = kt + 3 < kt1;
        if (m1) tile_load(ra, Kg + (size_t)(kt + 2) * 4096, Vg + (size_t)(kt + 2) * 4096, tid);
        if (m2) tile_load(rb, Kg + (size_t)(kt + 3) * 4096, Vg + (size_t)(kt + 3) * 4096, tid);
        body2(kt, kt + 1 < kt1, lds + L_K + cb, lds + L_V + cb, lds + L_K + cb + KT_BYTES, lds + L_V + cb + KT_BYTES);
        if (m1) tile_store(ra, lds + L_K + nb, lds + L_V + nb, tid);
        if (m2) tile_store(rb, lds + L_K + nb + KT_BYTES, lds + L_V + nb + KT_BYTES, tid);
        __syncthreads();
    }
}
template <class Mask>
__device__ __forceinline__ void attn_two(int kta, int ktb, const LAS unsigned char* bKa, const LAS unsigned char* bVa, const LAS unsigned char* bKb, const LAS unsigned char* bVb,
                                         const h8 (&q)[4], float& m, float& l, f16v (&o)[2], int r32, int hi, int lane, const Mask& mask) {
    const float ref0 = sm_ref(m), ci = -ref0;
    f16v a0 = splat16(ci), a1 = a0, b0 = a0, b1 = a0;
    qk(a0, a1, bKa, q, r32, hi);
    qk(b0, b1, bKb, q, r32, hi);
    mask(kta, a0, a1);
    softmax_step(a0, a1, m, l, o);
    { h8 pf[4]; pack_p(pf, a0, a1); pv(o, bVa, pf, lane); }
    const float dref = sm_ref(m) - ref0;
    if (__any(dref != 0.f)) {
#pragma unroll
        for (int r = 0; r < 16; ++r) { b0[r] -= dref; b1[r] -= dref; } }
    mask(ktb, b0, b1);
    softmax_step(b0, b1, m, l, o);
    { h8 pf[4]; pack_p(pf, b0, b1); pv(o, bVb, pf, lane); }
}
template <class Mask>
__device__ __forceinline__ void attn_one(int kt, const LAS unsigned char* bK, const LAS unsigned char* bV, const h8 (&q)[4], float& m, float& l, f16v (&o)[2], int r32, int hi, int lane, const Mask& mask) {
    const float ci = -sm_ref(m); f16v p0 = splat16(ci), p1 = p0; qk(p0, p1, bK, q, r32, hi);
    mask(kt, p0, p1);
    softmax_step(p0, p1, m, l, o);
    h8 pf[4]; pack_p(pf, p0, p1); pv(o, bV, pf, lane);
}

#define SBAR() __builtin_amdgcn_sched_barrier(0)
#define PIN(x) asm volatile("" : "+v"(x))
typedef unsigned u4w __attribute__((ext_vector_type(4)));
__device__ __forceinline__ unsigned pk2h(float a, float b) { return __builtin_bit_cast(unsigned, __builtin_amdgcn_cvt_pkrtz(a, b)); }
__device__ __forceinline__ bool sm_decide(f16v& C0, f16v& C1, float& m, float& l, float& alpha) {
    float mx = fmaxf(C0[0], C1[0]);
#pragma unroll
    for (int r = 1; r < 16; ++r) mx = fmaxf(fmaxf(mx, C0[r]), C1[r]);
    mx = pair_max(mx);
    const bool first = (m == NEG_BIG) && (mx != -INFINITY);
    const bool move = first || (mx > SM_THR);
    alpha = 1.f;
    if (__any(move)) {
        const float d = move ? mx : 0.f; alpha = first ? 1.f : __builtin_amdgcn_exp2f(-d);
        if (move) m = sm_ref(m) + d;
        l *= alpha;
#pragma unroll
        for (int r = 0; r < 16; ++r) { C0[r] -= d; C1[r] -= d; }
        return true;
    }
    return false;
}
#define PIPE_MF(a, b, c) __builtin_amdgcn_mfma_f32_32x32x16_f16(a, b, c, 0, 0, 0)
#define PIPE_KADDR(kslot, i) ((kslot) + r32 * 128 + ((i) & 1) * 4096 + ((((i) & ~1) + hi) ^ ((r32 >> 1) & 7)) * 16)
template <class CInit, class Mask>
__device__ __forceinline__ void pipe_step(f16v& C0, f16v& C1, const f16v& P0, const f16v& P1, const h8 (&q)[4], float& m, float& l, f16v (&o)[2],
                                          const LAS unsigned char* kcur, const LAS unsigned char* vprev, int kt, int r32, int hi, int lane, const CInit& cinit, const Mask& mask) {
    const int li = lane & 15, g = lane >> 4, rowA = 4 * hi + (li >> 2), colb = (16 * (g & 1) + 4 * (li & 3)) * 2, x = ((rowA >> 1) & 1) << 6;
    const LAS unsigned char* vb = vprev + rowA * 128; const int c0 = colb ^ x, c1 = (colb + 64) ^ x;
    h8 vf[8], kf[8]; u4w pw0, pw1, pw2, pw3;
#define PIPE_VRD(f) do { const LAS unsigned char* a_ = vb + ((f) & 3) * 2048 + (((f) >> 2) ? c1 : c0); const h4 lo_ = tr_read(a_), hi_ = tr_read(a_ + 8 * 128); \
        vf[f] = (h8){lo_[0], lo_[1], lo_[2], lo_[3], hi_[0], hi_[1], hi_[2], hi_[3]}; } while (0)
#define PIPE_KRD(i) do { kf[i] = *(const LAS h8*)PIPE_KADDR(kcur, i); } while (0)
#define PIPE_GAPA(MF, A0, A1, A2, A3, W0, W1, PW) do { MF; sacc += A0; sacc += A1; sacc += A2; sacc += A3; PIN(sacc); W0; W1; PIN(PW); SBAR(); } while (0)
#define PIPE_GAPB(MF, X, B) do { MF; X[B] = __builtin_amdgcn_exp2f(X[B]); X[B + 1] = __builtin_amdgcn_exp2f(X[B + 1]); X[B + 2] = __builtin_amdgcn_exp2f(X[B + 2]); X[B + 3] = __builtin_amdgcn_exp2f(X[B + 3]); PIN(X); SBAR(); } while (0)
    PIPE_KRD(0); PIPE_KRD(1);
    f16v Ci0, Ci1; cinit(kt, Ci0, Ci1);
    SBAR();
    float sacc = P0[0] + P0[1];
    PIPE_KRD(2); PIPE_GAPA(C0 = PIPE_MF(kf[0], q[0], Ci0), P0[2], P0[3], P0[4], P0[5],     pw0[0] = pk2h(P0[0], P0[1]),   pw0[1] = pk2h(P0[2], P0[3]),   pw0);
    PIPE_KRD(3); PIPE_GAPA(C1 = PIPE_MF(kf[1], q[0], Ci1), P0[6], P0[7], P0[8], P0[9],     pw0[2] = pk2h(P0[4], P0[5]),   pw0[3] = pk2h(P0[6], P0[7]),   pw0);
    PIPE_KRD(4); PIPE_GAPA(C0 = PIPE_MF(kf[2], q[1], C0),  P0[10], P0[11], P0[12], P0[13], pw1[0] = pk2h(P0[8], P0[9]),   pw1[1] = pk2h(P0[10], P0[11]), pw1);
    PIPE_KRD(5); PIPE_GAPA(C1 = PIPE_MF(kf[3], q[1], C1),  P0[14], P0[15], P1[0], P1[1],   pw1[2] = pk2h(P0[12], P0[13]), pw1[3] = pk2h(P0[14], P0[15]), pw1);
    PIPE_KRD(6); PIPE_GAPA(C0 = PIPE_MF(kf[4], q[2], C0),  P1[2], P1[3], P1[4], P1[5],     pw2[0] = pk2h(P1[0], P1[1]),   pw2[1] = pk2h(P1[2], P1[3]),   pw2);
    PIPE_KRD(7); PIPE_GAPA(C1 = PIPE_MF(kf[5], q[2], C1),  P1[6], P1[7], P1[8], P1[9],     pw2[2] = pk2h(P1[4], P1[5]),   pw2[3] = pk2h(P1[6], P1[7]),   pw2);
    PIPE_GAPA(C0 = PIPE_MF(kf[6], q[3], C0),  P1[10], P1[11], P1[12], P1[13], pw3[0] = pk2h(P1[8], P1[9]),   pw3[1] = pk2h(P1[10], P1[11]), pw3);
    PIPE_GAPA(C1 = PIPE_MF(kf[7], q[3], C1),  P1[14], P1[15], 0.f, 0.f,       pw3[2] = pk2h(P1[12], P1[13]), pw3[3] = pk2h(P1[14], P1[15]), pw3);
    l += sacc;
    PIPE_VRD(0); PIPE_VRD(4); SBAR();
    mask(kt, C0, C1);
    float alpha; const bool resc = sm_decide(C0, C1, m, l, alpha);
    SBAR();
    PIPE_VRD(1); PIPE_GAPB(o[0] = PIPE_MF(vf[0], __builtin_bit_cast(h8, pw0), o[0]), C0, 0);
    PIPE_VRD(5); PIPE_GAPB(o[1] = PIPE_MF(vf[4], __builtin_bit_cast(h8, pw0), o[1]), C0, 4);
    PIPE_VRD(2); PIPE_GAPB(o[0] = PIPE_MF(vf[1], __builtin_bit_cast(h8, pw1), o[0]), C0, 8);
    PIPE_VRD(6); PIPE_GAPB(o[1] = PIPE_MF(vf[5], __builtin_bit_cast(h8, pw1), o[1]), C0, 12);
    PIPE_VRD(3); PIPE_GAPB(o[0] = PIPE_MF(vf[2], __builtin_bit_cast(h8, pw2), o[0]), C1, 0);
    PIPE_VRD(7); PIPE_GAPB(o[1] = PIPE_MF(vf[6], __builtin_bit_cast(h8, pw2), o[1]), C1, 4);
    PIPE_GAPB(o[0] = PIPE_MF(vf[3], __builtin_bit_cast(h8, pw3), o[0]), C1, 8);
    PIPE_GAPB(o[1] = PIPE_MF(vf[7], __builtin_bit_cast(h8, pw3), o[1]), C1, 12);
    if (resc) {
#pragma unroll
        for (int r = 0; r < 16; ++r) { o[0][r] *= alpha; o[1][r] *= alpha; } }
#undef PIPE_VRD
#undef PIPE_KRD
#undef PIPE_GAPA
#undef PIPE_GAPB
}
template <class CInit, class Mask>
__device__ __forceinline__ void pipe_first(f16v& C0, f16v& C1, const h8 (&q)[4], float& m, float& l, f16v (&o)[2], const LAS unsigned char* kcur, int kt, int r32, int hi, const CInit& cinit, const Mask& mask) {
    cinit(kt, C0, C1);
    qk(C0, C1, kcur, q, r32, hi);
    mask(kt, C0, C1);
    float alpha; const bool resc = sm_decide(C0, C1, m, l, alpha);
    if (resc) {
#pragma unroll
        for (int r = 0; r < 16; ++r) { o[0][r] *= alpha; o[1][r] *= alpha; } }
#pragma unroll
    for (int r = 0; r < 16; ++r) { C0[r] = __builtin_amdgcn_exp2f(C0[r]); C1[r] = __builtin_amdgcn_exp2f(C1[r]); }
}
__device__ __forceinline__ void pipe_drain(const f16v& P0, const f16v& P1, float& l, f16v (&o)[2], const LAS unsigned char* vslot, int lane) {
    float s = 0.f;
#pragma unroll
    for (int r = 0; r < 16; ++r) s += P0[r] + P1[r];
    l += s;
    h8 pf[4]; pack_p(pf, P0, P1);
    pv(o, vslot, pf, lane);
}
template <bool HASC, class Src, class Active, class CInit, class Mask, class PreBar, class PostBar>
__device__ __forceinline__ void pipe_walk(int n, LAS unsigned char* lds, int tid, int lane, const h8 (&q)[4], float& m, float& l, f16v (&o)[2],
                                          const Src& src, const Active& active, const CInit& cinit, const Mask& mask, const PreBar& prebar, const PostBar& postbar) {
    if (n <= 0) return;
    const int r32 = lane & 31, hi = lane >> 5, key = tid >> 3, ch = tid & 7;
    const int kst = key * 128 + ((ch ^ ((key >> 1) & 7)) << 4), vst = key * 128 + ((ch * 16) ^ (((key >> 1) & 1) << 6));
    u4v rk, rv; float cpre = 0.f; const u16* Kp; const u16* Vp; const float* Cp;
    src(0, Kp, Vp, Cp); rk = ((const GAS u4v*)Kp)[tid]; if (HASC && tid < 64) cpre = ((const GAS float*)Cp)[tid];
    *(LAS u4v*)(lds + L_K + kst) = rk; if (HASC && tid < 64) ((LAS float*)(lds + L_C))[tid] = cpre;
    __syncthreads();
    f16v pA0, pA1, pB0, pB1;
    bool pending = false; int v = 0;
#define PIPE_ITER(CN0, CN1, PP0, PP1) { \
        const bool k1 = v + 1 < n; \
        if (k1) { src(v + 1, Kp, Vp, Cp); rk = ((const GAS u4v*)Kp)[tid]; if (HASC && tid < 64) cpre = ((const GAS float*)Cp)[tid]; } \
        src(v, Kp, Vp, Cp); rv = ((const GAS u4v*)Vp)[tid]; \
        const LAS unsigned char* kcur = lds + L_K + (v & 1) * KT_BYTES; \
        const LAS unsigned char* vprev = lds + L_V + ((v + 1) & 1) * KT_BYTES; \
        if (active(v)) { \
            if (pending) pipe_step(CN0, CN1, PP0, PP1, q, m, l, o, kcur, vprev, v, r32, hi, lane, cinit, mask); \
            else { pipe_first(CN0, CN1, q, m, l, o, kcur, v, r32, hi, cinit, mask); pending = true; } \
        } else if (pending) { pipe_drain(PP0, PP1, l, o, vprev, lane); pending = false; } \
        prebar(v); \
        if (k1) { *(LAS u4v*)(lds + L_K + ((v + 1) & 1) * KT_BYTES + kst) = rk; if (HASC && tid < 64) ((LAS float*)(lds + L_C + ((v + 1) & 1) * 256))[tid] = cpre; } \
        *(LAS u4v*)(lds + L_V + (v & 1) * KT_BYTES + vst) = rv; \
        __syncthreads(); }
    bool lastodd = false;
    for (;;) {
        PIPE_ITER(pB0, pB1, pA0, pA1); lastodd = false;
        { const bool stop = postbar(v); ++v; if (stop || v >= n) break; }
        PIPE_ITER(pA0, pA1, pB0, pB1); lastodd = true;
        { const bool stop = postbar(v); ++v; if (stop || v >= n) break; }
    }
#undef PIPE_ITER
    if (pending) { const LAS unsigned char* vlast = lds + L_V + ((v + 1) & 1) * KT_BYTES; if (lastodd) pipe_drain(pA0, pA1, l, o, vlast, lane); else pipe_drain(pB0, pB1, l, o, vlast, lane); }
}

constexpr float FOX_DEAD = -152.f;
__device__ __forceinline__ void fox_unit(unsigned char* ws, LAS unsigned char* lds, int bh, int qb, int wave, int lane) {
    asm volatile("" : "+v"(lane));
    const int tid = wave * 64 + lane, r32 = lane & 31, hi = lane >> 5;
    const u16* Qg = (const u16*)(ws + WS_FQ) + (size_t)bh * SEQ * 64; const u16* Kg = (const u16*)(ws + WS_FK) + (size_t)bh * SEQ * 64; const u16* Vg = (const u16*)(ws + WS_FV) + (size_t)bh * SEQ * 64;
    const GAS float* cg = (const GAS float*)(ws + WS_CFOX) + (size_t)bh * SEQ;
    const int t0w = 256 * qb + 32 * wave, t = t0w + r32;
    h8 q[4]; float qn = 0.f;
#pragma unroll
    for (int d0 = 0; d0 < 4; ++d0) { q[d0] = *(const GAS h8*)(Qg + (size_t)t * 64 + 16 * d0 + 8 * hi);
#pragma unroll
        for (int j = 0; j < 8; ++j) { const float v = (float)q[d0][j]; qn += v * v; } }
    qn = sqrtf(pair_sum(qn)) * 1.001f;
    const float ct = cg[t];
    float m = NEG_BIG, l = 0.f; f16v o[2] = {ATT_Z16(), ATT_Z16()};
    const int ktop = 4 * qb + 3;
    volatile LAS unsigned* flags = (volatile LAS unsigned*)(lds + L_FLAG);
    LAS float* pm = (LAS float*)(lds + L_PM);
    if (wave == 0) { float v = lane <= ktop ? ((const GAS float*)(ws + WS_KN))[bh * 64 + lane] : 0.f;
        int ln = lane; asm volatile("" : "+v"(ln));
#pragma unroll
        for (int d = 1; d < 64; d <<= 1) { const float u = __int_as_float(__builtin_amdgcn_ds_bpermute(4 * (ln - d), __float_as_int(v))); if (ln >= d) v = fmaxf(v, u); }
        pm[lane] = v * 1.001f; pm[64 + lane] = lane <= ktop ? cg[64 * lane + 63] : 0.f; }
    TileRegs tr; float cpre = 0.f;
    tile_load(tr, Kg + (size_t)ktop * 4096, Vg + (size_t)ktop * 4096, tid); if (tid < 64) cpre = cg[64 * ktop + tid];
    tile_store(tr, lds + L_K, lds + L_V, tid); if (tid < 64) ((LAS float*)(lds + L_C))[tid] = cpre;
    __syncthreads();
    bool wave_done = false; int it = 0;
    for (int kt = ktop; kt >= 0; --kt, ++it) {
        const int cur = it & 1, nxt = cur ^ 1; const bool more = kt > 0;
        if (more) { tile_load(tr, Kg + (size_t)(kt - 1) * 4096, Vg + (size_t)(kt - 1) * 4096, tid); if (tid < 64) cpre = cg[64 * (kt - 1) + tid]; }
        const bool reached = 64 * kt <= t0w + 31;
        if (reached && !wave_done) {
            f16v p0, p1; const float ctm = ct - sm_ref(m);
            const LAS float* cs = (const LAS float*)(lds + L_C + cur * 512);
#pragma unroll
            for (int g = 0; g < 4; ++g) { const f32x4 c0 = *(const LAS f32x4*)(cs + 8 * g + 4 * hi), c1 = *(const LAS f32x4*)(cs + 32 + 8 * g + 4 * hi);
#pragma unroll
                for (int e = 0; e < 4; ++e) { p0[4 * g + e] = ctm - c0[e]; p1[4 * g + e] = ctm - c1[e]; } }
            qk(p0, p1, lds + L_K + cur * KT_BYTES, q, r32, hi);
            if (64 * kt + 63 > t0w) {
                int tt = t - 64 * kt; asm volatile("" : "+v"(tt));
#pragma unroll
                for (int r = 0; r < 16; ++r) { const int c = crow(r, hi); if (c > tt) p0[r] = -INFINITY; if (c + 32 > tt) p1[r] = -INFINITY; }
            }
            softmax_step(p0, p1, m, l, o);
            h8 pf[4]; pack_p(pf, p0, p1);
            pv(o, lds + L_V + cur * KT_BYTES, pf, lane);
            if (more) {
                const float bound = qn * pm[kt - 1] + ct - pm[64 + kt - 1] - m;
                wave_done = __all(m != NEG_BIG && bound < FOX_DEAD);
            }
        }
        if (lane == 0) flags[cur * 8 + wave] = (reached && wave_done) ? 1u : 0u;
        if (more) { tile_store(tr, lds + L_K + nxt * KT_BYTES, lds + L_V + nxt * KT_BYTES, tid); if (tid < 64) ((LAS float*)(lds + L_C + nxt * 512))[tid] = cpre; }
        __syncthreads();
        unsigned alld = 1u;
#pragma unroll
        for (int w = 0; w < 8; ++w) alld &= flags[cur * 8 + w];
        if (alld) break;
    }
    __syncthreads();
    l = pair_sum(l); const float inv = 1.f / fmaxf(l, 1e-20f);
#pragma unroll
    for (int r = 0; r < 16; ++r) { o[0][r] *= inv; o[1][r] *= inv; }
    const int b = bh >> 2, h = bh & 3;
    norm_store(o, [&](int r) { return (u16*)(ws + WS_O16) + ((size_t)b * SEQ + t0w + r) * 1024 + (NSA_H + h) * 64; }, lds + L_K + wave * KT_BYTES, lane);
}

constexpr float SB_STOP = -120.f;
__device__ __forceinline__ float softplus_(float z) { return fmaxf(z, 0.f) + 0.6931471805599453f * __builtin_amdgcn_logf(1.f + __builtin_amdgcn_exp2f(-fabsf(z) * 1.4426950408889634f)); }
__device__ __forceinline__ void sb_unit(unsigned char* ws, LAS unsigned char* lds, int bh, int qb, int wave, int lane) {
    asm volatile("" : "+v"(lane));
    const int r32 = lane & 31, hi = lane >> 5;
    const u16* Qg = (const u16*)(ws + WS_SQ) + (size_t)bh * SEQ * 64; const u16* Kg = (const u16*)(ws + WS_SK) + (size_t)bh * SEQ * 64; const u16* Vg = (const u16*)(ws + WS_SV) + (size_t)bh * SEQ * 64;
    const int t0w = 256 * qb + 32 * wave, t = t0w + r32;
    h8 q[4];
#pragma unroll
    for (int d0 = 0; d0 < 4; ++d0) q[d0] = *(const GAS h8*)(Qg + (size_t)t * 64 + 16 * d0 + 8 * hi);
    float carry = 0.f; f16v o[2] = {ATT_Z16(), ATT_Z16()};
    LAS unsigned char* myV = lds + L_K + wave * KT_BYTES;
    for (int kt = (t0w + 31) >> 6; kt >= 0; --kt) {
        h8 ka[4], kb[4]; u4v vv[8];
        { const u16* kp = Kg + ((size_t)64 * kt + r32) * 64 + 8 * hi;
#pragma unroll
          for (int d0 = 0; d0 < 4; ++d0) { ka[d0] = *(const GAS h8*)(kp + 16 * d0); kb[d0] = *(const GAS h8*)(kp + 32 * 64 + 16 * d0); }
          const GAS u4v* vp = (const GAS u4v*)(Vg + (size_t)kt * 4096) + lane;
#pragma unroll
          for (int i = 0; i < 8; ++i) vv[i] = vp[64 * i]; }
#pragma unroll
        for (int i = 0; i < 8; ++i) { const int idx = lane + 64 * i, key = idx >> 3, c = idx & 7; *(LAS u4v*)(myV + key * 128 + ((c * 16) ^ (((key >> 1) & 1) << 6))) = vv[i]; }
        f16v p0 = ATT_Z16(), p1 = ATT_Z16();
#pragma unroll
        for (int d0 = 0; d0 < 4; ++d0) { p0 = __builtin_amdgcn_mfma_f32_32x32x16_f16(ka[d0], q[d0], p0, 0, 0, 0); p1 = __builtin_amdgcn_mfma_f32_32x32x16_f16(kb[d0], q[d0], p1, 0, 0, 0); }
        {
            f16v L0, L1;
            const bool diag = 64 * kt + 63 >= t0w;
            int tt = diag ? t - 64 * kt : 1000; asm volatile("" : "+v"(tt));
#pragma unroll
            for (int r = 0; r < 16; ++r) { const int c = crow(r, hi);
                L0[r] = -softplus_(p0[r]); L1[r] = -softplus_(p1[r]);
                if (c >= tt) L0[r] = 0.f; if (c + 32 >= tt) L1[r] = 0.f; }
            float gt[8];
#pragma unroll
            for (int i = 0; i < 4; ++i) { gt[i] = (L0[4 * i] + L0[4 * i + 1]) + (L0[4 * i + 2] + L0[4 * i + 3]); gt[4 + i] = (L1[4 * i] + L1[4 * i + 1]) + (L1[4 * i + 2] + L1[4 * i + 3]); }
            float og[8];
#pragma unroll
            for (int i = 0; i < 8; ++i) og[i] = pair_other(gt[i], hi);
            float T[8]; float run = 0.f;
#pragma unroll
            for (int i = 7; i >= 0; --i) {
                if (hi == 0) { run += og[i]; T[i] = run; run += gt[i]; }
                else { T[i] = run; run += gt[i]; run += og[i]; }
            }
            const float total = run;
#pragma unroll
            for (int i = 0; i < 4; ++i) {
                {   const float b = carry + T[i];
                    const float w3 = b, w2 = w3 + L0[4 * i + 3], w1 = w2 + L0[4 * i + 2], w0 = w1 + L0[4 * i + 1];
                    p0[4 * i] += L0[4 * i] + w0; p0[4 * i + 1] += L0[4 * i + 1] + w1; p0[4 * i + 2] += L0[4 * i + 2] + w2; p0[4 * i + 3] += L0[4 * i + 3] + w3; }
                {   const float b = carry + T[4 + i];
                    const float w3 = b, w2 = w3 + L1[4 * i + 3], w1 = w2 + L1[4 * i + 2], w0 = w1 + L1[4 * i + 1];
                    p1[4 * i] += L1[4 * i] + w0; p1[4 * i + 1] += L1[4 * i + 1] + w1; p1[4 * i + 2] += L1[4 * i + 2] + w2; p1[4 * i + 3] += L1[4 * i + 3] + w3; }
            }
#pragma unroll
            for (int r = 0; r < 16; ++r) { const int c = crow(r, hi);
                p0[r] = (c >= tt) ? 0.f : __builtin_amdgcn_exp2f(p0[r] * 1.4426950408889634f);
                p1[r] = (c + 32 >= tt) ? 0.f : __builtin_amdgcn_exp2f(p1[r] * 1.4426950408889634f); }
            carry += total;
        }
        h8 pf[4]; pack_p(pf, p0, p1);
        pv(o, myV, pf, lane);
        if (__all(carry < SB_STOP)) break;
    }
    __syncthreads();
    const int b = bh >> 2, h = bh & 3;
    norm_store(o, [&](int r) { return (u16*)(ws + WS_O16) + ((size_t)b * SEQ + t0w + r) * 1024 + (NSA_H + FOX_H + h) * 64; }, lds + L_K + wave * KT_BYTES, lane);
}

__device__ __forceinline__ void nsa_unit(unsigned char* ws, LAS unsigned char* lds, int bg, int cur, int wave, int) {
#define NSA_IDS const int lane = lane_id_fresh(), tid = wave * 64 + lane, r32 = lane & 31, hi = lane >> 5, tl = r32 >> 2, hh = r32 & 3; \
    const int b = bg >> 1, g = bg & 1, tloc = 8 * wave + tl, tok = 64 * cur + tloc, head = 4 * g + hh; const size_t row = (size_t)b * SEQ + tok; \
    (void)tid; (void)tl; (void)hh; (void)tok; (void)head; (void)row; (void)tloc; (void)b; (void)g; (void)hi; (void)r32; \
    LAS float* const ot = (LAS float*)(lds + L_OT) + tid; LAS float* const imp_lds = (LAS float*)(lds + L_IMP); LAS unsigned* const mask_lds = (LAS unsigned*)(lds + L_MASK); \
    const GAS float* const gt = (const GAS float*)(ws + WS_GATES) + row * 24 + head * 3; (void)ot; (void)imp_lds; (void)mask_lds; (void)gt;
    h8 q[4];
    { NSA_IDS
      const u16* Qg = (const u16*)(ws + WS_NQ) + (row * 8 + head) * 64;
#pragma unroll
      for (int d0 = 0; d0 < 4; ++d0) q[d0] = *(const GAS h8*)(Qg + 16 * d0 + 8 * hi); }
    float m = NEG_BIG, l = 0.f;
    {   NSA_IDS
    const u16* kcg = (const u16*)(ws + WS_KC) + (size_t)bg * NCMP_PAD * 64; const u16* vcg = (const u16*)(ws + WS_VC) + (size_t)bg * NCMP_PAD * 64;
    const int nct = (4 * cur + 3 + 63) >> 6;
    const int nlim = tok >= 31 ? ((tok - 31) >> 4) : -1;
    {
        f16v o[2] = {ATT_Z16(), ATT_Z16()}; float carry_last = 0.f;
        float rk0 = 0.f, rk1 = 0.f, rk2 = 0.f, rk3 = 0.f;
        tile_walk<1>(kcg, vcg, 0, nct, lds, tid, [&](int kt, const LAS unsigned char* bK, const LAS unsigned char* bV) {
            const float rb = sm_ref(m);
            f16v p0 = splat16(-rb), p1 = p0; qk(p0, p1, bK, q, r32, hi);
            int nl = nlim - 64 * kt; asm volatile("" : "+v"(nl));
#pragma unroll
            for (int r = 0; r < 16; ++r) { const int n = crow(r, hi); if (n > nl) p0[r] = -INFINITY; if (n + 32 > nl) p1[r] = -INFINITY; }
            softmax_step(p0, p1, m, l, o);
            const float ra = sm_ref(m), cs = __builtin_amdgcn_exp2f(rb - ra);
            rk0 = kt == 0 ? ra : rk0; rk1 = kt == 1 ? ra : rk1; rk2 = kt == 2 ? ra : rk2; rk3 = kt == 3 ? ra : rk3;
            float imp[8], last[8];
#pragma unroll
            for (int i = 0; i < 4; ++i) { imp[i] = (p0[4 * i] + p0[4 * i + 1]) + (p0[4 * i + 2] + p0[4 * i + 3]); last[i] = p0[4 * i + 3];
                                          imp[4 + i] = (p1[4 * i] + p1[4 * i + 1]) + (p1[4 * i + 2] + p1[4 * i + 3]); last[4 + i] = p1[4 * i + 3]; }
            float recv[8];
#pragma unroll
            for (int i = 0; i < 8; ++i) recv[i] = pair_other(last[i], hi);
#pragma unroll
            for (int i = 0; i < 8; ++i) { const float below = hi ? recv[i] : (i > 0 ? recv[i > 0 ? i - 1 : 0] : carry_last * cs); imp[i] += below; }
            carry_last = recv[7];
#pragma unroll
            for (int i = 0; i < 8; ++i) ot[(8 * kt + i) * 512] = imp[i];
            h8 pf[4]; pack_p(pf, p0, p1);
            pv(o, bV, pf, lane);
        });
        l = pair_sum(l);
        const float invl = 1.f / fmaxf(l, 1e-20f), rf = sm_ref(m);
#pragma unroll
        for (int kt = 0; kt < 4; ++kt) if (kt < nct) {
            const float fac = __builtin_amdgcn_exp2f((kt == 0 ? rk0 : kt == 1 ? rk1 : kt == 2 ? rk2 : rk3) - rf) * invl;
#pragma unroll
            for (int i = 0; i < 8; ++i) { float v = ot[(8 * kt + i) * 512] * fac; v += lx<1>(v); v += lx<2>(v);
                if (hh == 0) imp_lds[tloc * 65 + 16 * kt + 2 * i + hi] = v; }
        }
        const float g_c = gt[0] * invl;
#pragma unroll
        for (int r = 0; r < 16; ++r) { ot[r * 512] = g_c * o[0][r]; ot[(16 + r) * 512] = g_c * o[1][r]; }
    }
    }
    { NSA_IDS
    if (cur < 16) {
        if (tid < 64) { const unsigned long long mk = (2ull << cur) - 1ull; mask_lds[2 * tid] = (unsigned)mk; mask_lds[2 * tid + 1] = (unsigned)(mk >> 32); }
    } else {
        __syncthreads();
        const int tk = tid >> 3, sub = tid & 7;
        LAS unsigned* keys = (LAS unsigned*)imp_lds;
        unsigned ks[8];
#pragma unroll
        for (int e = 0; e < 8; ++e) { const int j = 8 * sub + e; const bool forced = (j == 0) || (j == cur) || (j == cur - 1);
            const unsigned nb = __float_as_uint(imp_lds[tk * 65 + j]) | 0x80000000u;
            ks[e] = forced ? (0xFFFFFFC0u | (unsigned)(63 - j)) : (j <= cur ? nb : (unsigned)(63 - j)); }
#pragma unroll
        for (int e = 0; e < 8; ++e) keys[tk * 65 + 8 * sub + e] = ks[e];
        __syncthreads();
        int rank[8] = {0, 0, 0, 0, 0, 0, 0, 0};
        for (int jj = 0; jj < 64; ++jj) { const unsigned ko = keys[tk * 65 + jj];
#pragma unroll
            for (int e = 0; e < 8; ++e) rank[e] += (ko > ks[e]) ? 1 : 0; }
        int rs = ((rank[0] + rank[1]) + (rank[2] + rank[3])) + ((rank[4] + rank[5]) + (rank[6] + rank[7]));
        rs += (int)lxu<1>((unsigned)rs); rs += (int)lxu<2>((unsigned)rs); rs += (int)lxu<4>((unsigned)rs);
        if (__any(rs != 2016)) {
#pragma unroll
            for (int e = 0; e < 8; ++e) rank[e] = 0;
            for (int jj = 0; jj < 64; ++jj) { const unsigned ko = keys[tk * 65 + jj];
#pragma unroll
                for (int e = 0; e < 8; ++e) rank[e] += ((ko > ks[e]) || (ko == ks[e] && jj < 8 * sub + e)) ? 1 : 0; }
        }
        unsigned byte = 0u;
#pragma unroll
        for (int e = 0; e < 8; ++e) if (rank[e] < 16 && (8 * sub + e) <= cur) byte |= 1u << e;
        unsigned lo = sub < 4 ? byte << (8 * sub) : 0u, hi32 = sub >= 4 ? byte << (8 * (sub - 4)) : 0u;
        lo |= lxu<1>(lo); hi32 |= lxu<1>(hi32); lo |= lxu<2>(lo); hi32 |= lxu<2>(hi32); lo |= lxu<4>(lo); hi32 |= lxu<4>(hi32);
        if (sub == 0) { mask_lds[2 * tk] = lo; mask_lds[2 * tk + 1] = hi32; }
    }
    }
    __syncthreads();
    f16v o[2];
    {   NSA_IDS
    unsigned long long rowmask = ((unsigned long long)mask_lds[2 * tloc + 1] << 32) | mask_lds[2 * tloc];
    unsigned long long wmask = rowmask;
    { unsigned wl = (unsigned)wmask, wh = (unsigned)(wmask >> 32);
      wl |= lxu<4>(wl); wh |= lxu<4>(wh); wl |= lxu<8>(wl); wh |= lxu<8>(wh); wl |= lxu<16>(wl); wh |= lxu<16>(wh);
      wmask = ((unsigned long long)(unsigned)__builtin_amdgcn_readfirstlane((int)wh) << 32) | (unsigned)__builtin_amdgcn_readfirstlane((int)wl); }
        const u16* ksg = (const u16*)(ws + WS_KS) + (size_t)bg * SEQ * 64; const u16* vsg = (const u16*)(ws + WS_VS) + (size_t)bg * SEQ * 64;
        m = NEG_BIG; l = 0.f; o[0] = ATT_Z16(); o[1] = ATT_Z16();
        pipe_walk<false>(cur + 1, lds, tid, lane, q, m, l, o,
            [&](int v, const u16*& Kp, const u16*& Vp, const float*& Cp) { Kp = ksg + (size_t)v * 4096; Vp = vsg + (size_t)v * 4096; Cp = nullptr; },
            [&](int v) { return (bool)((wmask >> v) & 1ull); },
            [&](int v, f16v& Ci0, f16v& Ci1) { const bool selrow = (rowmask >> v) & 1ull;
                Ci0 = splat16(selrow ? -sm_ref(m) : -INFINITY); Ci1 = Ci0; },
            [&](int v, f16v& C0, f16v& C1) {
                if (v == cur) {
                    int tq = tloc - 4 * hi; asm volatile("" : "+v"(tq));
#pragma unroll
                    for (int r = 0; r < 16; ++r) { const int c = crow(r, 0); if (c > tq) C0[r] = -INFINITY; if (c + 32 > tq) C1[r] = -INFINITY; } } },
            [](int) {}, [](int) { return false; });
    }
    {   NSA_IDS
        l = pair_sum(l); const float sc_ = gt[1] / fmaxf(l, 1e-20f);
#pragma unroll
        for (int r = 0; r < 16; ++r) { ot[r * 512] += sc_ * o[0][r]; ot[(16 + r) * 512] += sc_ * o[1][r]; }
    }
    {   NSA_IDS
        const u16* kwg = (const u16*)(ws + WS_KW) + (size_t)bg * SEQ * 64; const u16* vwg = (const u16*)(ws + WS_VW) + (size_t)bg * SEQ * 64;
        m = NEG_BIG; l = 0.f; o[0] = ATT_Z16(); o[1] = ATT_Z16();
        const int k0 = cur >= 8 ? cur - 8 : 0;
        auto mask_win = [&](int kt, f16v& p0, f16v& p1) {
            if (kt == cur) {
                int tq = tloc - 4 * hi; asm volatile("" : "+v"(tq));
#pragma unroll
                for (int r = 0; r < 16; ++r) { const int c = crow(r, 0); if (c > tq) p0[r] = -INFINITY; if (c + 32 > tq) p1[r] = -INFINITY; }
            } else if (kt == cur - 8) {
                int tq = tloc - 4 * hi; asm volatile("" : "+v"(tq));
#pragma unroll
                for (int r = 0; r < 16; ++r) { const int c = crow(r, 0); if (c <= tq) p0[r] = -INFINITY; if (c + 32 <= tq) p1[r] = -INFINITY; }
            } };
        tile_walk<1>(kwg, vwg, k0, cur + 1, lds, tid, [&](int kt, const LAS unsigned char* bK, const LAS unsigned char* bV) {
            attn_one(kt, bK, bV, q, m, l, o, r32, hi, lane, mask_win);
        });
    }
    {   NSA_IDS
        l = pair_sum(l); const float sc_ = gt[2] / fmaxf(l, 1e-20f);
#pragma unroll
        for (int r = 0; r < 16; ++r) { o[0][r] = ot[r * 512] + sc_ * o[0][r]; o[1][r] = ot[(16 + r) * 512] + sc_ * o[1][r]; }
        norm_store(o, [&](int r) { return (u16*)(ws + WS_O16) + ((size_t)b * SEQ + 64 * cur + 8 * wave + (r >> 2)) * 1024 + (4 * g + (r & 3)) * 64; }, lds + L_K + wave * KT_BYTES, lane);
    }
#undef NSA_IDS
}
__device__ __forceinline__ void glds16(const void* g, unsigned lds_base) {
    unsigned sv; asm volatile("s_mov_b32 %0, m0\n\ts_mov_b32 m0, %2\n\ts_nop 0\n\tglobal_load_lds_dwordx4 %1, off\n\ts_mov_b32 m0, %0" : "=&s"(sv) : "v"(g), "s"(lds_base) : "memory"); }
__device__ __forceinline__ float gelu_tanh_(float x) { const float u = 0.7978845608028654f * (x + 0.044715f * x * x * x); const float e = __expf(2.f * u); return 0.5f * x * (2.f - 2.f / (1.f + e)); }
__device__ __forceinline__ void compress_unit(const u16* kin  , const u16* w1t  , const float* bias1  , const u16* w2t  ,
                                              u16* out  , int n0, int wave, int lane, LAS unsigned char* lds) {
    const int r32 = lane & 31, hi = lane >> 5;
    f16v acc[4] = {ATT_Z16(), ATT_Z16(), ATT_Z16(), ATT_Z16()};
    const u16* wrow = kin + (size_t)(16 * (n0 + r32)) * 64 + 8 * hi + 256 * wave;
    LAS unsigned char* wimg = lds + wave * 16384; const unsigned wl = (unsigned)(size_t)wimg;
    const int dx = lane >> 3, dc = lane & 7;
    const unsigned srcE = (unsigned)(dx * 4096 + ((dc ^ (dx >> 1)) << 4)), srcO = (unsigned)(dx * 4096 + ((dc ^ (4 + (dx >> 1))) << 4));
    const char* w1b = (const char*)(w1t + 256 * wave);
#pragma unroll 1
    for (int ch = 0; ch < 4; ++ch) {
        h8 bfr[4];
#pragma unroll
        for (int dd = 0; dd < 4; ++dd) bfr[dd] = *(const GAS h8*)(wrow + 64 * ch + 16 * dd);
#pragma unroll
        for (int i = 0; i < 16; ++i) glds16(w1b + ch * 128 + (size_t)i * (8 * 4096) + ((i & 1) ? srcO : srcE), wl + i * 1024);
        asm volatile("s_waitcnt vmcnt(0)" ::: "memory");
#pragma unroll
        for (int dd = 0; dd < 4; ++dd)
#pragma unroll
            for (int hb = 0; hb < 4; ++hb) { const h8 afr = *(const LAS h8*)(wimg + (hb * 32 + r32) * 128 + (((2 * dd + hi) ^ ((r32 >> 1) & 7)) << 4));
                acc[hb] = __builtin_amdgcn_mfma_f32_32x32x16_f16(afr, bfr[dd], acc[hb], 0, 0, 0); }
        asm volatile("s_waitcnt lgkmcnt(0)" ::: "memory");
    }
    LAS float* part = (LAS float*)lds;
#pragma unroll
    for (int hb = 0; hb < 4; ++hb)
#pragma unroll
        for (int r = 0; r < 16; ++r) part[((wave * 64) + hb * 16 + r) * 64 + lane] = acc[hb][r];
    __syncthreads();
    const int hb = wave >> 1, s2 = wave & 1;
    h8 gf;
#pragma unroll
    for (int j = 0; j < 8; ++j) { const int i = hb * 16 + 8 * s2 + j; float v = 0.f;
#pragma unroll
        for (int w = 0; w < 8; ++w) v += part[((w * 64) + i) * 64 + lane];
        gf[j] = (_Float16)gelu_tanh_(v + ((const GAS float*)bias1)[32 * hb + crow(8 * s2 + j, hi)]); }
    f16v oacc[2] = {ATT_Z16(), ATT_Z16()};
    { const int s = wave;
#pragma unroll
      for (int eh = 0; eh < 2; ++eh) { const u16* wp = w2t + (size_t)(32 * eh + r32) * 128 + 16 * s + 4 * hi;
          const h4 a0 = *(const GAS h4*)wp, a1 = *(const GAS h4*)(wp + 8); const h8 af = {a0[0], a0[1], a0[2], a0[3], a1[0], a1[1], a1[2], a1[3]};
          oacc[eh] = __builtin_amdgcn_mfma_f32_32x32x16_f16(af, gf, oacc[eh], 0, 0, 0); } }
    __syncthreads();
#pragma unroll
    for (int eh = 0; eh < 2; ++eh)
#pragma unroll
        for (int r = 0; r < 16; ++r) part[((wave * 32) + eh * 16 + r) * 64 + lane] = oacc[eh][r];
    __syncthreads();
    { const int eh = wave >> 2, g = wave & 3; float v[4];
#pragma unroll
      for (int e = 0; e < 4; ++e) { v[e] = 0.f;
#pragma unroll
          for (int w = 0; w < 8; ++w) v[e] += part[((w * 32) + eh * 16 + 4 * g + e) * 64 + lane]; }
      const int n = n0 + r32;
      h4 o = {(_Float16)v[0], (_Float16)v[1], (_Float16)v[2], (_Float16)v[3]};
      if (n >= NCMP) o = (h4){(_Float16)0.f, (_Float16)0.f, (_Float16)0.f, (_Float16)0.f};
      *(GAS h4*)(out + (size_t)n * 64 + 32 * eh + 8 * g + 4 * hi) = o; }
    __syncthreads();
}
}


constexpr int NWAVES = 8;
constexpr int RING_OFF = 0, RING_BYTES = 153600;
constexpr int LDSCTL_OFF = RING_BYTES, MISC_OFF = LDSCTL_OFF + 320;
constexpr int LDS_BYTES = 155648;
constexpr int CW_TMO = 0, CW_BAR = 4096;
constexpr int CW_QUEUE = 32768;
constexpr int N_BAR_REGIONS = 4;
static_assert((CW_BAR + N_BAR_REGIONS * XCD_BAR_WORDS) <= CW_QUEUE && (CW_QUEUE + 64 * 16) * 4 <= (int)(1 * MiB), "control words");
constexpr size_t WS_P16 = WS_H16B + 64 * MiB;
constexpr size_t WS_W = WS_P16 + 32 * MiB;
constexpr size_t W_IN = 0, W_OUT = 6 * MiB, W_GU = 8 * MiB, W_DN = 19 * MiB, W_PG = W_DN + 5632 * 1024, W_PP = W_PG + 2 * MiB, W_LAYER = 27 * MiB;
constexpr size_t WS_CW = WS_W + 2 * W_LAYER;
constexpr size_t WS_END2 = WS_CW + 4 * MiB;
static_assert(W_PP + 512 * 1024 <= W_LAYER && WS_END2 <= 512 * MiB, "weights map");
constexpr size_t CW_W1T = 0, CW_W2T = 2 * MiB, CW_B1 = 2 * MiB + 64 * 1024;
constexpr size_t WS_UTAB = 2 * MiB - 16384;
constexpr int NIN_PAD = 3072;

#ifndef MK_MASK
#define MK_MASK 0xFFFF
#endif
#ifndef MK_REPEAT
#define MK_REPEAT 0
#endif
#define REPS(k) ((((MK_REPEAT) >> (k)) & 1) ? 2 : 1)
struct Args { const void* in[23]; float* out; unsigned char* ws; int ph_lo, ph_hi, bar_region, rep_mask, fuse_final; };

struct RepOrder { pg8::StaticOrder b; int R;
    __device__ bool next(int i, pg8::Unit& u) const { if (i >= 2 * R) return false; return b.next(i >= R ? i - R : i, u); }
    __device__ __forceinline__ void a_ready(const pg8::Unit&) const {}
    __device__ __forceinline__ void done(const pg8::Unit&) const {} };
struct RangeOrder { pg8::StaticOrder b; int i0, cnt;
    __device__ bool next(int i, pg8::Unit& u) const { if (i >= cnt) return false; return b.next(i0 + i, u); }
    __device__ __forceinline__ void a_ready(const pg8::Unit&) const {}
    __device__ __forceinline__ void done(const pg8::Unit&) const {} };
struct ColSrc { const float* W; int col; };
template <int NI, class Map>
__device__ __forceinline__ void transpose_items(const Map& map, int ldw, int K, const float* gain, u16* WT, int nblk, LAS float* scr, int item0, int lane) {
    float tv[NI][32];
#pragma unroll
    for (int q = 0; q < NI; ++q) { const int item = item0 + q, kb = item / nblk, nb = item % nblk, k0 = 64 * kb, n0 = 32 * nb;
        const ColSrc cs = map(n0 + (lane & 31));
        if (cs.W) { const GAS float* wp = (const GAS float*)cs.W + (size_t)(k0 + (lane >> 5)) * ldw + cs.col;
#pragma unroll
            for (int i = 0; i < 32; ++i) tv[q][i] = wp[(size_t)(2 * i) * ldw]; }
        else {
#pragma unroll
            for (int i = 0; i < 32; ++i) tv[q][i] = 0.f; } }
#pragma unroll
    for (int q = 0; q < NI; ++q) { const int item = item0 + q, kb = item / nblk, nb = item % nblk, k0 = 64 * kb, n0 = 32 * nb;
        if (gain) { const GAS float* gp = (const GAS float*)gain + k0 + (lane >> 5);
#pragma unroll
            for (int i = 0; i < 32; ++i) tv[q][i] *= gp[2 * i]; }
#pragma unroll
        for (int i = 0; i < 32; ++i) scr[(2 * i + (lane >> 5)) * 33 + (lane & 31)] = tv[q][i];
        LDS_WAIT(); asm volatile("" ::: "memory");
        const int c = lane & 7;
#pragma unroll
        for (int j = 0; j < 4; ++j) { const int n = (lane >> 3) + 8 * j; const LAS float* s = scr + (8 * c) * 33 + n;
            pg8::h16x8 o;
#pragma unroll
            for (int e = 0; e < 8; ++e) o[e] = (_Float16)s[e * 33];
            *(pg8::h16x8*)(WT + (size_t)(n0 + n) * K + k0 + 8 * c) = o; }
        LDS_WAIT(); asm volatile("" ::: "memory"); }
}
template <class Map>
__device__ __forceinline__ void transpose_item(const Map& map, int ldw, int K, const float* gain, u16* WT, int nblk, LAS float* scr, int item, int lane) { transpose_items<1>(map, ldw, K, gain, WT, nblk, scr, item, lane); }
struct MapIdent { const float* W; __device__ __forceinline__ ColSrc operator()(int n) const { return ColSrc{W, n}; } };
struct MapGU { const float* Wg; const float* Wu; __device__ __forceinline__ ColSrc operator()(int n) const { const int tile = n >> 8, w = n & 255; return w < 128 ? ColSrc{Wg, tile * 128 + w} : ColSrc{Wu, tile * 128 + w - 128}; } };
struct MapInProj { const float* W; __device__ __forceinline__ ColSrc operator()(int n) const {
    const int tile = n >> 8, w = n & 255, bj = w >> 7, wc = (w & 127) >> 5, dd = w & 31, slot = tile * 4 + wc, d = dd + 32 * bj;
    int base;
    if (slot < 8) base = C_NQ + slot * 64;
    else if (slot < 14) { const int t = slot - 8; base = (t < 2 ? C_KC : (t < 4 ? C_KS : C_KW)) + (t & 1) * 64; }
    else if (slot < 20) { const int t = slot - 14; base = (t < 2 ? C_VC : (t < 4 ? C_VS : C_VW)) + (t & 1) * 64; }
    else if (slot < 44) { const int t = slot - 20, which = t >> 2; base = (which == 0 ? C_FQ : which == 1 ? C_FK : which == 2 ? C_FV : which == 3 ? C_SQ : which == 4 ? C_SK : C_SV) + (t & 3) * 64; }
    else if (slot == 44) { if (bj == 1 || dd >= 28) return ColSrc{nullptr, 0}; return ColSrc{W, dd < 24 ? C_GATE + dd : C_FF + (dd - 24)}; }
    else return ColSrc{nullptr, 0};
    return ColSrc{W, base + d}; } };

__global__ void __launch_bounds__(NWAVES * 64, 2) mk_fwd(Args args) {
    extern __shared__ __attribute__((aligned(16))) unsigned char lds_raw[];
    LAS unsigned char* lds = (LAS unsigned char*)lds_raw;
    const int wave = __builtin_amdgcn_readfirstlane(threadIdx.x >> 6), G = gridDim.x;
#define LANE_ID() lane_id_fresh()
    volatile LAS unsigned* MISC = (volatile LAS unsigned*)(lds + MISC_OFF);
    unsigned char* ws = args.ws;
    gu32* ctl = (gu32*)(ws + WS_CTL);
    for (int u = threadIdx.x; u < (LDS_BYTES - LDSCTL_OFF) / 4; u += NWAVES * 64) ((LAS unsigned*)(lds + LDSCTL_OFF))[u] = 0u;
    __syncthreads();
    XcdBarrier bar = xcd_barrier_post((unsigned*)(ctl + CW_BAR) + args.bar_region * XCD_BAR_WORDS, MISC + 8);
    const int lo = args.ph_lo, hi = args.ph_hi;
#define IN(k) (lo <= (k) && (k) < hi)
#if defined(PROBE_BAR2)
#define SEAM(k) do { if (IN(k) && IN((k) + 1)) { xcd_barrier(bar, wave == 0 && LANE_ID() == 0); xcd_barrier(bar, wave == 0 && LANE_ID() == 0); } } while (0)
#else
#define SEAM(k) do { if (IN(k) && IN((k) + 1)) xcd_barrier(bar, wave == 0 && LANE_ID() == 0); } while (0)
#endif
    const int gw = blockIdx.x * NWAVES + wave, NGW = G * NWAVES;

    constexpr int I_IN = 16 * (NIN_PAD / 32), I_OUT = 16 * 32, I_GU = 16 * (5632 / 32), I_DN = 44 * 32, I_PG = 16 * 32, I_PP = 4 * 32, I_LAYER = I_IN + I_OUT + I_GU + I_DN + I_PG + I_PP;
    constexpr int DEF_W_UNITS0 = I_LAYER / 32, DEF_W_UNITS1 = (I_LAYER - I_IN) / 32, DEF_P_UNITS = (int)((size_t)DEPTH * T * PLE / 8 / 8192);
    static_assert(DEPTH == 2 && I_LAYER % 32 == 0 && (I_LAYER - I_IN) % 32 == 0 && (size_t)DEF_P_UNITS * 8192 * 8 == (size_t)DEPTH * T * PLE, "deferred units");
    auto weight_items = [&](auto ni_tag, int Lw, int r, LAS float* scr, int lane) __attribute__((always_inline)) {
        constexpr int NI = decltype(ni_tag)::value;
        u16* wl = (u16*)(ws + WS_W + (size_t)Lw * W_LAYER);
        if (r < I_IN) { transpose_items<NI>(MapInProj{(const float*)args.in[4] + (size_t)Lw * DM * IN_W}, IN_W, DM, (const float*)args.in[3] + Lw * DM, (u16*)((unsigned char*)wl + W_IN), NIN_PAD / 32, scr, r, lane); return; } r -= I_IN;
        if (r < I_OUT) { transpose_items<NI>(MapIdent{(const float*)args.in[14] + (size_t)Lw * DM * DM}, DM, DM, (const float*)args.in[13] + Lw * DM, (u16*)((unsigned char*)wl + W_OUT), 32, scr, r, lane); return; } r -= I_OUT;
        if (r < I_GU) { transpose_items<NI>(MapGU{(const float*)args.in[16] + (size_t)Lw * DM * DFF, (const float*)args.in[17] + (size_t)Lw * DM * DFF}, DFF, DM, (const float*)args.in[15] + Lw * DM, (u16*)((unsigned char*)wl + W_GU), 5632 / 32, scr, r, lane); return; } r -= I_GU;
        if (r < I_DN) { transpose_items<NI>(MapIdent{(const float*)args.in[18] + (size_t)Lw * DFF * DM}, DM, DFF, nullptr, (u16*)((unsigned char*)wl + W_DN), 32, scr, r, lane); return; } r -= I_DN;
        if (r < I_PG) { transpose_items<NI>(MapIdent{(const float*)args.in[21] + (size_t)Lw * DM * DM}, DM, DM, (const float*)args.in[19] + Lw * DM, (u16*)((unsigned char*)wl + W_PG), 32, scr, r, lane); return; } r -= I_PG;
        transpose_items<NI>(MapIdent{(const float*)args.in[20] + (size_t)Lw * PLE * DM}, DM, PLE, nullptr, (u16*)((unsigned char*)wl + W_PP), 32, scr, r, lane);
    };
    if (MK_MASK & 1) if (IN(0))
_Pragma("unroll") for (int rep = 0; rep < REPS(0); ++rep) {
        const int lane = LANE_ID(), tid = wave * 64 + lane;
        float* ss = (float*)(ws + WS_SS); u16* H16A = (u16*)(ws + WS_H16); float2* rope = (float2*)(ws + WS_ROPE);
        LAS float* scr = (LAS float*)(lds + RING_OFF + wave * 16384);
        for (int it = gw; it < I_IN; it += NGW) weight_items(std::integral_constant<int, 1>{}, 0, it, scr, lane);
        for (int it = gw; it < 4 * (128 + 4); it += NGW) {
            const int c = it / 132, r = it % 132, L = c >> 1, kv = c & 1;
            const float* w1 = (const float*)args.in[kv ? 11 : 8] + (size_t)L * 2048 * 128; const float* w2 = (const float*)args.in[kv ? 12 : 9] + (size_t)L * 128 * 64;
            if (r < 128) transpose_item(MapIdent{w1}, 128, 2048, nullptr, (u16*)(ws + WS_CW + CW_W1T + (size_t)c * 524288), 4, scr, r, lane);
            else transpose_item(MapIdent{w2}, 64, 128, nullptr, (u16*)(ws + WS_CW + CW_W2T + (size_t)c * 16384), 2, scr, r - 128, lane);
        }
        for (int it = gw; it < 512; it += NGW) {
            const int c = it >> 7, hid = it & 127, L = c >> 1, kv = c & 1;
            const float* w1 = (const float*)args.in[kv ? 11 : 8] + (size_t)L * 2048 * 128; const float* pe = (const float*)args.in[kv ? 10 : 7] + (size_t)L * 2048;
            float s = 0.f; { float a_[32], b_[32];
#pragma unroll
              for (int i = 0; i < 32; ++i) { a_[i] = ((const GAS float*)pe)[lane + 64 * i]; b_[i] = ((const GAS float*)w1)[(size_t)(lane + 64 * i) * 128 + hid]; }
#pragma unroll
              for (int i = 0; i < 32; ++i) s += a_[i] * b_[i]; }
            s = wsum64(s); if (lane == 0) ((float*)(ws + WS_CW + CW_B1))[c * 128 + hid] = s;
        }
        {
            auto cost = [](int id) { if (id < 1024) { const int cur = id >> 4, nct = (4 * cur + 66) >> 6; return 150 + 18 * (2 * nct + cur + 1 + (cur + 1 < 9 ? cur + 1 : 9)); }
                                     if (id < 1536) { const int q = 4 * (((id - 1024) >> 5) + 1); return 100 + 18 * (q < 15 ? q : 15); } return 200 + ((id - 1536) * 11) / 4; };
            for (int id = gw; id < 2048; id += NGW) { const int c = cost(id); float rank = 0.f;
                for (int o = lane; o < 2048; o += 64) { const int co = cost(o); rank += (co > c || (co == c && o < id)) ? 1.f : 0.f; }
                rank = wsum64(rank);
                if (lane == 0) ((u16*)(ws + WS_UTAB))[(int)rank] = (u16)id; }
        }
        const float* x = (const float*)args.in[0]; const int* pos = (const int*)args.in[2];
        const float inv_freq = powf(10000.f, -(float)(lane & 31) / 32.f);
        for (int m0 = gw; m0 < T; m0 += 8 * NGW) {
            f32x4 v[8][4];
#pragma unroll
            for (int rr = 0; rr < 8; ++rr) { const int mr = m0 + rr * NGW < T ? m0 + rr * NGW : T - 1; const GAS f32x4* xr = (const GAS f32x4*)(x + (size_t)mr * DM) + lane;
#pragma unroll
                for (int j = 0; j < 4; ++j) v[rr][j] = xr[64 * j]; }
#pragma unroll
            for (int rr = 0; rr < 8; ++rr) { const int m = m0 + rr * NGW; float s = 0.f; if (m >= T) break;
                GAS unsigned long long* o8 = (GAS unsigned long long*)(H16A + (size_t)m * DM) + lane;
#pragma unroll
                for (int j = 0; j < 4; ++j) { const f32x4 w = v[rr][j]; s += (w[0] * w[0] + w[1] * w[1]) + (w[2] * w[2] + w[3] * w[3]);
                    typedef _Float16 h4 __attribute__((ext_vector_type(4))); h4 hv = {(_Float16)w[0], (_Float16)w[1], (_Float16)w[2], (_Float16)w[3]};
                    o8[64 * j] = __builtin_bit_cast(unsigned long long, hv); }
                s = wsum64(s);
                if (lane == 0) ss[m] = s;
                if (lane < 32) { const float ang = (float)pos[m] * inv_freq;
                    const float kq = rintf(ang * 0.15915494309189535f); float rr = fmaf(-kq, 6.28125f, ang); rr = fmaf(-kq, 1.9353071795864769e-3f, rr);
                    const float rev = rr * 0.15915494309189535f;
                    rope[(size_t)m * 32 + lane] = make_float2(__builtin_amdgcn_cosf(rev), __builtin_amdgcn_sinf(rev)); } }
        }
        if (blockIdx.x == 0 && tid < 64) { const int L = tid >> 5, c = tid & 31; float v = 0.f; if (c < 24) v = ((const float*)args.in[5])[L * 24 + c]; else if (c < 28) v = ((const float*)args.in[6])[L * 4 + c - 24]; ((float*)(ws + WS_BIAS))[tid] = v; }
    }
    SEAM(0);

#pragma unroll 1
    for (int L = 0; L < DEPTH; ++L) {
        const int pb = 1 + 7 * L;
#define PH_LOCALS unsigned char* wsl = args.ws; asm volatile("" : "+s"(wsl)); \
        u16* hcur = (u16*)(wsl + ((L & 1) ? WS_H16B : WS_H16)); (void)hcur; float* ssL = (float*)(wsl + WS_SS) + (size_t)(3 * L) * T; (void)ssL; \
        const unsigned char* wl = wsl + WS_W + (size_t)L * W_LAYER; (void)wl;
        if ((MK_MASK >> 1) & 1) if (IN(pb + 0))
_Pragma("unroll") for (int rep = 0; rep < REPS(1); ++rep) { PH_LOCALS
            pg8::Gemm g{hcur, (const u16*)(wl + W_IN), T, NIN_PAD, DM}; pg8::StaticOrder S; S.init(T, NIN_PAD, G, (int)blockIdx.x);
            pg8::EpiInProj E{wsl, L};
            if constexpr ((MK_REPEAT) & 0x800) { RepOrder S2{S, (S.nwg + G - 1) / G}; pg8::gemm_phase<pg8::EpiInProj, RepOrder, true, true>(lds + RING_OFF, g, S2, E, wave); }
            else
            pg8::gemm_phase<pg8::EpiInProj, pg8::StaticOrder, true, true>(lds + RING_OFF, g, S, E, wave);
        }
        SEAM(pb + 0);
        if ((MK_MASK >> 2) & 1) if (IN(pb + 1))
_Pragma("unroll") for (int rep = 0; rep < REPS(2); ++rep) {
            unsigned char* wsl = args.ws; asm volatile("" : "+s"(wsl));
            const int lane = LANE_ID(); const int gw = (int)blockIdx.x * NWAVES + wave, NGW = G * NWAVES;
            for (int it = gw; it < 2048; it += NGW) {
                const GAS att::h8* kr = (const GAS att::h8*)((const u16*)(wsl + WS_FK) + ((size_t)it * 64 + lane) * 64); float s = 0.f;
#pragma unroll
                for (int c = 0; c < 8; ++c) { const att::h8 v = kr[c];
#pragma unroll
                    for (int j = 0; j < 8; ++j) { const float x = (float)v[j]; s += x * x; } }
                s = fmaxf(s, lx<1>(s)); s = fmaxf(s, lx<2>(s)); s = fmaxf(s, lx<4>(s)); s = fmaxf(s, lx<8>(s)); s = fmaxf(s, lx<16>(s)); s = pair_max(s);
                if (lane == 0) ((GAS float*)(wsl + WS_KN))[it] = sqrtf(s);
            }
            for (int u = (int)blockIdx.x; u < 256; u += G) {
                const int kv = u >> 7, bg = (u >> 3) & 15, n0 = (u & 7) * 32, c = 2 * L + kv;
                att::compress_unit((const u16*)(wsl + (kv ? WS_VC_IN : WS_KC_IN)) + (size_t)bg * SEQ * 64, (const u16*)(wsl + WS_CW + CW_W1T + (size_t)c * 524288),
                                   (const float*)(wsl + WS_CW + CW_B1) + c * 128, (const u16*)(wsl + WS_CW + CW_W2T + (size_t)c * 16384),
                                   (u16*)(wsl + (kv ? WS_VC : WS_KC)) + (size_t)bg * NCMP_PAD * 64, n0, wave, lane, lds);
            }
            if ((int)blockIdx.x < 32) {
                const int bh = (int)blockIdx.x, tid = wave * 64 + lane;
                const GAS f32x4* fp = (const GAS f32x4*)((const float*)(wsl + WS_FLOG) + (size_t)bh * SEQ) + 2 * tid; const f32x4 xa = fp[0], xb = fp[1];
                const float tot = ((xa[0] + xa[1]) + (xa[2] + xa[3])) + ((xb[0] + xb[1]) + (xb[2] + xb[3]));
                float inc = tot;
#pragma unroll
                for (int d = 1; d < 64; d <<= 1) { const float v = __int_as_float(__builtin_amdgcn_ds_bpermute(4 * (lane - d), __float_as_int(inc))); if (lane >= d) inc += v; }
                LAS float* wt = (LAS float*)(lds + att::L_FLAG);
                if (lane == 63) wt[wave] = inc;
                __syncthreads();
                float acc = inc - tot;
                for (int w = 0; w < 8; ++w) acc += (w < wave) ? wt[w] : 0.f;
                f32x4 oa, ob;
                acc += xa[0]; oa[0] = acc * LOG2E; acc += xa[1]; oa[1] = acc * LOG2E; acc += xa[2]; oa[2] = acc * LOG2E; acc += xa[3]; oa[3] = acc * LOG2E;
                acc += xb[0]; ob[0] = acc * LOG2E; acc += xb[1]; ob[1] = acc * LOG2E; acc += xb[2]; ob[2] = acc * LOG2E; acc += xb[3]; ob[3] = acc * LOG2E;
                GAS f32x4* op = (GAS f32x4*)((float*)(wsl + WS_CFOX) + (size_t)bh * SEQ) + 2 * tid; op[0] = oa; op[1] = ob;
                __syncthreads();
            }
        }
        SEAM(pb + 1);
        if ((MK_MASK >> 3) & 1) if (IN(pb + 2))
{ constexpr int rep = 0; constexpr int NQ = ((MK_REPEAT) & 0x708) ? 4096 : 2048;
            unsigned char* wsl = args.ws; asm volatile("" : "+s"(wsl));
            const int lane = LANE_ID();
            gu32* head = (gu32*)(wsl + WS_CTL) + CW_QUEUE + 64 * (L + 2 * rep);
            volatile LAS unsigned* slot = (volatile LAS unsigned*)(lds + att::L_SLOT);
            (void)NQ;
            const int def_w = (L == 0) ? DEF_W_UNITS0 : DEF_W_UNITS1, nq = 2048 + def_w + ((L == 0) ? DEF_P_UNITS : 0);
            for (;;) {
                const int u = att::fetch_unit(head, slot, wave == 0 && lane == 0);
                if (u >= nq) break;
                if (u >= 2048) {
                    const int d = u - 2048;
                    if (d < def_w) {
                        LAS float* scr = (LAS float*)(lds + att::L_OT + wave * 8704);
                        { const int j = d * 32 + wave * 4; const bool own = (L == 1) || j < I_LAYER - I_IN;
                            weight_items(std::integral_constant<int, 4>{}, (L == 1 || !own) ? 1 : 0, own ? I_IN + j : j - (I_LAYER - I_IN), scr, lane); }
                    } else {
                        const float* p = (const float*)args.in[1]; u16* p16 = (u16*)(wsl + WS_P16);
                        const size_t i0 = (size_t)(d - def_w) * 8192 + (size_t)(wave * 64 + lane);
#pragma unroll 1
                        for (int rnd = 0; rnd < 4; ++rnd) { f32x4 pa[4], pb[4];
#pragma unroll
                            for (int k = 0; k < 4; ++k) { const size_t i = i0 + (size_t)(4 * rnd + k) * 512; pa[k] = ((const GAS f32x4*)p)[2 * i]; pb[k] = ((const GAS f32x4*)p)[2 * i + 1]; }
#pragma unroll
                            for (int k = 0; k < 4; ++k) { const size_t i = i0 + (size_t)(4 * rnd + k) * 512;
                                pg8::h16x8 o = {(_Float16)pa[k][0], (_Float16)pa[k][1], (_Float16)pa[k][2], (_Float16)pa[k][3], (_Float16)pb[k][0], (_Float16)pb[k][1], (_Float16)pb[k][2], (_Float16)pb[k][3]};
                                ((GAS pg8::h16x8*)p16)[i] = o; } }
                    }
                    continue;
                }
                const int id = ((const GAS u16*)(wsl + WS_UTAB))[u];
#ifndef MK_UNITS
#define MK_UNITS 7
#endif
                if (id < 1024) { if (MK_UNITS & 1) att::nsa_unit(wsl, lds, id & 15, id >> 4, wave, lane); }
                else { const int v = (id - 1024) & 511, qb = v >> 5, bh = v & 31;
                    if (id < 1536) { if (MK_UNITS & 2) att::fox_unit(wsl, lds, bh, qb, wave, lane); } else { if (MK_UNITS & 4) att::sb_unit(wsl, lds, bh, qb, wave, lane); } }
            }
        }
        SEAM(pb + 2);
        if ((MK_MASK >> 4) & 1) if (IN(pb + 3))
_Pragma("unroll") for (int rep = 0; rep < REPS(4); ++rep) { PH_LOCALS
            pg8::Gemm g{(const u16*)(wsl + WS_O16), (const u16*)(wl + W_OUT), T, DM, DM}; pg8::StaticOrder S; S.init(T, DM, G, (int)blockIdx.x);
            if (REPS(4) == 2 && rep == 0) { pg8::EpiStore E{(u16*)(wsl + WS_ACT)}; pg8::gemm_phase<pg8::EpiStore, pg8::StaticOrder, true, true>(lds + RING_OFF, g, S, E, wave); }
            else { pg8::EpiResid E{hcur, ssL + T};
            pg8::gemm_phase<pg8::EpiResid, pg8::StaticOrder, true, true>(lds + RING_OFF, g, S, E, wave); }
        }
        SEAM(pb + 3);
        if ((MK_MASK >> 5) & 1) if (IN(pb + 4))
_Pragma("unroll") for (int rep = 0; rep < REPS(5); ++rep) { PH_LOCALS
            const int grp = ((int)blockIdx.x >> 3) & 1;
#pragma nounroll
            for (int part = 0; part < 3; ++part) {
                if (part == 1) { pg8::Gemm g{hcur, (const u16*)(wl + W_GU), T, 2 * DFF, DM}; pg8::StaticOrder S; S.init(T, 2 * DFF, G, (int)blockIdx.x);
                    pg8::EpiSwiglu E{ssL + T, (u16*)(wsl + WS_ACT)};
                    pg8::gemm_phase<pg8::EpiSwiglu, pg8::StaticOrder, true, true>(lds + RING_OFF, g, S, E, wave); }
                else { pg8::Gemm g{(const u16*)(wsl + WS_P16) + (size_t)L * T * PLE, (const u16*)(wl + W_PP), T, DM, PLE};
                    RangeOrder S; S.b.init(T, DM, G, (int)blockIdx.x); S.i0 = part == 0 ? 0 : grp; S.cnt = part == 0 ? grp : 2 - grp;
                    pg8::EpiStore E{(u16*)(wsl + WS_O16)};
                    pg8::gemm_phase<pg8::EpiStore, RangeOrder, true, true>(lds + RING_OFF, g, S, E, wave); }
            }
        }
        SEAM(pb + 4);
        if ((MK_MASK >> 6) & 1) if (IN(pb + 5))
_Pragma("unroll") for (int rep = 0; rep < REPS(6); ++rep) { PH_LOCALS
            pg8::Gemm g{(const u16*)(wsl + WS_ACT), (const u16*)(wl + W_DN), T, DM, DFF}; pg8::StaticOrder S; S.init(T, DM, G, (int)blockIdx.x);
            if (REPS(6) == 2 && rep == 0) { pg8::EpiStore E{(u16*)(wsl + ((L & 1) ? WS_H16 : WS_H16B))}; pg8::gemm_phase<pg8::EpiStore, pg8::StaticOrder, true, true>(lds + RING_OFF, g, S, E, wave); }
            else { pg8::EpiResid E{hcur, ssL + 2 * T};
            pg8::gemm_phase<pg8::EpiResid, pg8::StaticOrder, true, true>(lds + RING_OFF, g, S, E, wave); }
        }
        SEAM(pb + 5);
        if ((MK_MASK >> 7) & 1) if (IN(pb + 6))
_Pragma("unroll") for (int rep = 0; rep < REPS(7); ++rep) { PH_LOCALS
            pg8::Gemm g{hcur, (const u16*)(wl + W_PG), T, DM, DM}; pg8::StaticOrder S; S.init(T, DM, G, (int)blockIdx.x);
            if (REPS(7) == 2 && rep == 0) { pg8::EpiStore E{(u16*)(wsl + ((L & 1) ? WS_H16 : WS_H16B))}; pg8::gemm_phase<pg8::EpiStore, pg8::StaticOrder, true, true>(lds + RING_OFF, g, S, E, wave); }
            else if (L == DEPTH - 1 && args.fuse_final) { pg8::EpiPleFinal E{wsl, args.out, (const float*)args.in[22], L};
            pg8::gemm_phase<pg8::EpiPleFinal, pg8::StaticOrder, true, true>(lds + RING_OFF, g, S, E, wave); }
            else { pg8::EpiPle E{wsl, L};
            pg8::gemm_phase<pg8::EpiPle, pg8::StaticOrder, true, true>(lds + RING_OFF, g, S, E, wave); }
        }
        if (L < DEPTH - 1 || !args.fuse_final) SEAM(pb + 6);
    }
    if (!args.fuse_final) if ((MK_MASK >> 15) & 1) if (IN(15))
_Pragma("unroll") for (int rep = 0; rep < REPS(15); ++rep) {
        const int lane = LANE_ID();
        const float* ssF = (const float*)(ws + WS_SS) + (size_t)6 * T; const float* gf = (const float*)args.in[22]; const u16* hf = (const u16*)(ws + WS_H16);
        for (int m = gw; m < T; m += NGW) {
            const float rstd = rsqrtf(ssF[m] * (1.f / DM) + RMS_EPS);
            const unsigned long long* h8 = (const unsigned long long*)(hf + (size_t)m * DM) + lane; f32x4* o = (f32x4*)(args.out + (size_t)m * DM) + lane;
#pragma unroll
            for (int j = 0; j < 4; ++j) { typedef _Float16 h4 __attribute__((ext_vector_type(4))); const h4 hv = __builtin_bit_cast(h4, h8[64 * j]); const f32x4 gv = ((const f32x4*)gf)[64 * j + lane];
                o[64 * j] = (f32x4){(float)hv[0] * rstd * gv[0], (float)hv[1] * rstd * gv[1], (float)hv[2] * rstd * gv[2], (float)hv[3] * rstd * gv[3]}; }
        }
    }
#undef IN
#undef SEAM
}


extern "C" void kernel_launch(void* const* d_in, const int* in_sizes, int n_in, void* d_out, int out_size, void* d_ws, size_t ws_size, hipStream_t stream) {
    static int grid = 0;
    if (grid == 0) {
        if (n_in != 23 || ws_size < WS_END2 || out_size != T * DM) { fprintf(stderr, "kernel_launch: unexpected inputs (n_in %d, ws %zu < %zu, out %d)\n", n_in, ws_size, (size_t)WS_END2, out_size); grid = -1; return; }
        int dev = 0, cus = 0, per_cu = 0;
        if (hipGetDevice(&dev) != hipSuccess || hipDeviceGetAttribute(&cus, hipDeviceAttributeMultiprocessorCount, dev) != hipSuccess) { grid = -1; return; }
        if (hipFuncSetAttribute((const void*)mk_fwd, hipFuncAttributeMaxDynamicSharedMemorySize, LDS_BYTES) != hipSuccess) { fprintf(stderr, "kernel_launch: hipFuncSetAttribute failed\n"); grid = -1; return; }
        if (hipOccupancyMaxActiveBlocksPerMultiprocessor(&per_cu, (const void*)mk_fwd, NWAVES * 64, LDS_BYTES) != hipSuccess || per_cu < 1) { fprintf(stderr, "kernel_launch: occupancy query says %d blocks per CU\n", per_cu); }
        (void)hipGetLastError();
        grid = cus;
    }
    if (grid < 0) return;
    unsigned char* ws = (unsigned char*)d_ws;
    (void)hipMemsetAsync(ws, 0, ZERO_BYTES, stream);
    Args a{};
    for (int i = 0; i < 23; ++i) a.in[i] = d_in[i];
    a.out = (float*)d_out; a.ws = ws; a.ph_lo = 0; a.ph_hi = 16; a.bar_region = 0; a.rep_mask = 0;
    a.fuse_final = (grid % 256 == 0) ? 1 : 0;
    hipLaunchKernelGGL(mk_fwd, dim3(grid), dim3(NWAVES * 64), LDS_BYTES, stream, a);
}
```

```cpp
#include <hip/hip_runtime.h>
#include <cstdio>
#include <cstdint>
#include <cmath>

typedef _Float16 half_t;
typedef _Float16 half8 __attribute__((ext_vector_type(8)));
typedef float f32x16 __attribute__((ext_vector_type(16)));
typedef float f32x4 __attribute__((ext_vector_type(4)));

constexpr int BATCH = 8, SEQ = 4096, DM = 1024, DEPTH = 2, T = BATCH * SEQ;
constexpr int HD = 64, NSA_H = 8, FOX_H = 4, SB_H = 4, NSA_G = 2;
constexpr int IN_W = 2844, DFF = 2816, PLE = 256;
constexpr int NCMP = 255, NCMP_PAD = 256, CMP_HID = 128;
constexpr float RMS_EPS = 1e-6f, TINY = 1e-20f;
constexpr float LOG2E = 1.4426950408889634f;
constexpr float QSCALE2 = 0.125f * LOG2E;
constexpr int C_NQ = 0, C_KC = 512, C_VC = 640, C_KS = 768, C_VS = 896, C_KW = 1024, C_VW = 1152, C_GATE = 1280,
              C_FQ = 1304, C_FK = 1560, C_FV = 1816, C_FF = 2072, C_SQ = 2076, C_SK = 2332, C_SV = 2588;

constexpr size_t MiB = 1u << 20;
constexpr size_t WS_CTL = 0;
constexpr size_t WS_SS = 1 * MiB;
constexpr size_t ZERO_BYTES = 2 * MiB;
constexpr size_t WS_BIAS = 2 * MiB - 4096;
constexpr size_t WS_ROPE = 2 * MiB;
constexpr size_t WS_H16 = 10 * MiB;
constexpr size_t WS_PROJ = 74 * MiB;
constexpr size_t WS_NQ = WS_PROJ;
constexpr size_t WS_KC_IN = WS_NQ + 32 * MiB;
constexpr size_t WS_VC_IN = WS_KC_IN + 8 * MiB;
constexpr size_t WS_KS = WS_VC_IN + 8 * MiB;
constexpr size_t WS_VS = WS_KS + 8 * MiB;
constexpr size_t WS_KW = WS_VS + 8 * MiB;
constexpr size_t WS_VW = WS_KW + 8 * MiB;
constexpr size_t WS_FQ = WS_VW + 8 * MiB;
constexpr size_t WS_FK = WS_FQ + 16 * MiB;
constexpr size_t WS_FV = WS_FK + 16 * MiB;
constexpr size_t WS_SQ = WS_FV + 16 * MiB;
constexpr size_t WS_SK = WS_SQ + 16 * MiB;
constexpr size_t WS_SV = WS_SK + 16 * MiB;
constexpr size_t WS_ACT = WS_PROJ;
constexpr size_t WS_GATES = WS_PROJ + 176 * MiB;
constexpr size_t WS_FLOG = WS_GATES + 3 * MiB;
constexpr size_t WS_CFOX = WS_FLOG + 1 * MiB;
constexpr size_t WS_KN = WS_CFOX + 512 * 1024;
constexpr size_t WS_KC = WS_CFOX + 1 * MiB;
constexpr size_t WS_VC = WS_KC + 1 * MiB;
constexpr size_t WS_O16 = WS_VC + 1 * MiB;
constexpr size_t WS_H16B = WS_O16 + 64 * MiB;
constexpr size_t WS_END = WS_H16B + 64 * MiB;
static_assert(WS_SV + 16 * MiB == WS_PROJ + 176 * MiB, "proj map");
static_assert((size_t)T * DFF * 2 == 176 * MiB, "act overlay");

__device__ __forceinline__ float wave_sum(float v) {
#pragma unroll
    for (int o = 1; o < 64; o <<= 1) v += __shfl_xor(v, o);
    return v;
}

typedef unsigned short u16;
#define GAS __attribute__((address_space(1)))
#define LAS __attribute__((address_space(3)))
template <int M> __device__ __forceinline__ float lx(float v) {
    static_assert(M >= 1 && M <= 16, "lx"); return __int_as_float(__builtin_amdgcn_ds_swizzle(__float_as_int(v), (M << 10) | 0x1F)); }
template <int M> __device__ __forceinline__ unsigned lxu(unsigned v) { return (unsigned)__builtin_amdgcn_ds_swizzle((int)v, (M << 10) | 0x1F); }
__device__ __forceinline__ float pair_sum(float v) { const unsigned u = __float_as_uint(v); const auto r = __builtin_amdgcn_permlane32_swap(u, u, false, false); return __uint_as_float(r[0]) + __uint_as_float(r[1]); }
__device__ __forceinline__ float pair_max(float v) { const unsigned u = __float_as_uint(v); const auto r = __builtin_amdgcn_permlane32_swap(u, u, false, false); return fmaxf(__uint_as_float(r[0]), __uint_as_float(r[1])); }
__device__ __forceinline__ float pair_other(float v, int hi) { const unsigned u = __float_as_uint(v); const auto r = __builtin_amdgcn_permlane32_swap(u, u, false, false); return __uint_as_float(hi ? r[0] : r[1]); }
__device__ __forceinline__ float wsum64(float v) { v += lx<1>(v); v += lx<2>(v); v += lx<4>(v); v += lx<8>(v); v += lx<16>(v); return pair_sum(v); }
__device__ __forceinline__ int lane_id_fresh() { int l; asm volatile("v_mbcnt_lo_u32_b32 %0, -1, 0\n\tv_mbcnt_hi_u32_b32 %0, -1, %0" : "=v"(l)); return l; }

namespace pg8 {
#define PG8_LAS __attribute__((address_space(3)))
typedef unsigned short bf16_t;
typedef _Float16 bf16x8 __attribute__((ext_vector_type(8)));
typedef float f32x4 __attribute__((ext_vector_type(4)));
typedef unsigned u32x4 __attribute__((ext_vector_type(4)));
constexpr int BM = 256, BK = 64, HALF = 128, HTB = HALF * BK * 2  , STAGE_BYTES = 8 * HTB, NXCD = 8, WGM = 8;

__host__ __device__ __forceinline__ int lds_byte(int r, int c) { const int st = (r >> 4) * 2 + (c >> 5), rr = r & 15, cc = c & 31, ob = rr * 64 + cc * 2; return st * 1024 + (ob ^ (((ob >> 9) & 1) << 5)); }
__host__ __device__ __forceinline__ void stage_rc(int b, int& R, int& C) { const int st = b / 1024, sb = b % 1024, swz = sb ^ (((sb >> 9) & 1) << 5); R = (st >> 1) * 16 + swz / 64; C = (st & 1) * 32 + (swz % 64) / 2; }
__host__ __device__ __forceinline__ int perm32(int rho) { const int n = rho >> 4, i = rho & 15; return 8 * (i >> 2) + 4 * n + (i & 3); }

struct Unit { int pm, pn; };
struct Gemm { const bf16_t* A; const bf16_t* Bt; int M, N, K; };

struct StaticOrder {
    int nM, nN, nwg, G, c;
    __host__ __device__ void init(int M, int N, int G_, int c_) { nM = M / BM; nN = N / BM; nwg = nM * nN; G = G_; c = c_; }
    __host__ __device__ bool next(int i, Unit& u) const {
        const long L = (long)i * G + c; if (L >= nwg) return false;
        int wgid = (int)L; { const int q = nwg / NXCD, r = nwg % NXCD, xcd = wgid % NXCD, off = wgid / NXCD; wgid = (xcd < r ? xcd * (q + 1) : r * (q + 1) + (xcd - r) * q) + off; }
        const int nig = WGM * nN, gid = wgid / nig, fm = gid * WGM, gsz = (nM - fm) < WGM ? (nM - fm) : WGM;
        u.pm = fm + ((wgid % nig) % gsz); u.pn = (wgid % nig) / gsz; return true;
    }
    __device__ __forceinline__ void a_ready(const Unit&) const {}
    __device__ __forceinline__ void done(const Unit&) const {}
};


typedef _Float16 h16x8 __attribute__((ext_vector_type(8)));
__device__ __forceinline__ float rstd_of(const float* ss, int row) { return rsqrtf(((const GAS float*)ss)[row] * (1.f / 1024.f) + 1e-6f); }
__device__ __forceinline__ float fast_sigmoid(float x) { return __builtin_amdgcn_rcpf(1.f + __expf(-x)); }
__device__ unsigned pg8_sink_words[16 * 32];
__device__ __forceinline__ void pg8_pad16() {
#pragma unroll
    for (int i = 0; i < 16; ++i) ((GAS unsigned*)pg8_sink_words)[i * 32] = 0u; }
#define PG8_ACCV(ai, bj, m, j) (acc[ai][bj][m][(j) >> 2][(j) & 3])

__device__ __forceinline__ void pg8_rowsum_add(const float (&sq)[8], float* ssn, LAS float* xch, const Unit& u, int wr, int wc, int fr, int fq) {
    if (fq == 0) {
#pragma unroll
        for (int g = 0; g < 8; ++g) xch[((wr * 4 + wc) * 8 + g) * 16 + fr] = sq[g]; }
    asm volatile("s_waitcnt lgkmcnt(0)" ::: "memory"); __builtin_amdgcn_s_barrier(); asm volatile("" ::: "memory");
    if (fq < 2) { const int gg = 2 * wc + fq; float t = 0.f;
#pragma unroll
        for (int w = 0; w < 4; ++w) t += xch[((wr * 4 + w) * 8 + gg) * 16 + fr];
        __builtin_amdgcn_global_atomic_fadd_f32((GAS float*)(ssn + u.pm * BM + (gg >> 2) * HALF + wr * 64 + (gg & 3) * 16 + fr), t); }
}
struct EpiResid {
    static constexpr bool PERM = true, AFTER_DRAIN = false, IDEMPOTENT = false, NEEDS_ALIGN_EPI = true;
    bf16_t* h; float* ssn; LAS float* xch;
    __device__ __forceinline__ void operator()(const f32x4 (&acc)[2][2][4][2], const Unit& u, int wr, int wc, int fr, int fq) const {
        { int l_; asm volatile("v_mbcnt_lo_u32_b32 %0, -1, 0\n\tv_mbcnt_hi_u32_b32 %0, -1, %0" : "=v"(l_)); fr = l_ & 15; fq = l_ >> 4; }
        const int col0 = u.pn * BM + wc * 32 + 8 * fq;
        h16x8 hv[8][2];
#pragma unroll
        for (int g_ = 0; g_ < 8; ++g_) { const int row = u.pm * BM + (g_ >> 2) * HALF + wr * 64 + (g_ & 3) * 16 + fr;
#pragma unroll
            for (int bj = 0; bj < 2; ++bj) hv[g_][bj] = *(const GAS h16x8*)(h + (size_t)row * 1024 + col0 + bj * HALF); }
        float sq[8];
        asm volatile("" ::: "memory");
#pragma unroll
        for (int ai = 0; ai < 2; ++ai)
#pragma unroll
            for (int m = 0; m < 4; ++m) {
                const int row = u.pm * BM + ai * HALF + wr * 64 + m * 16 + fr; float s = 0.f;
#pragma unroll
                for (int bj = 0; bj < 2; ++bj) {
                    GAS h16x8* p = (GAS h16x8*)(h + (size_t)row * 1024 + col0 + bj * HALF); h16x8 o = hv[ai * 4 + m][bj];
#pragma unroll
                    for (int j = 0; j < 8; ++j) { const _Float16 r = (_Float16)((float)o[j] + PG8_ACCV(ai, bj, m, j)); o[j] = r; const float rf = (float)r; s += rf * rf; }
                    *p = o;
                }
                s += lx<16>(s); sq[ai * 4 + m] = pair_sum(s);
            }
        pg8_rowsum_add(sq, ssn, xch, u, wr, wc, fr, fq);
    }
};
struct EpiSwiglu {
    static constexpr bool PERM = true, AFTER_DRAIN = false, IDEMPOTENT = true, NEEDS_ALIGN_EPI = false;
    const float* ss; bf16_t* act;
    __device__ __forceinline__ void operator()(const f32x4 (&acc)[2][2][4][2], const Unit& u, int wr, int wc, int fr, int fq) const {
        { int l_; asm volatile("v_mbcnt_lo_u32_b32 %0, -1, 0\n\tv_mbcnt_hi_u32_b32 %0, -1, %0" : "=v"(l_)); fr = l_ & 15; fq = l_ >> 4; }
        const int col0 = u.pn * HALF + wc * 32 + 8 * fq;
        float rsv[8];
#pragma unroll
        for (int i = 0; i < 8; ++i) rsv[i] = ((const GAS float*)ss)[u.pm * BM + (i >> 2) * HALF + wr * 64 + (i & 3) * 16 + fr];
        asm volatile("" ::: "memory");
#pragma unroll
        for (int ai = 0; ai < 2; ++ai)
#pragma unroll
            for (int m = 0; m < 4; ++m) {
                const int row = u.pm * BM + ai * HALF + wr * 64 + m * 16 + fr; const float rstd = rsqrtf(rsv[ai * 4 + m] * (1.f / 1024.f) + 1e-6f), r2 = rstd * rstd, rl = rstd * 1.4426950408889634f;
                h16x8 o;
                float ex[8], nu[8];
#pragma unroll
                for (int j = 0; j < 8; ++j) ex[j] = __builtin_amdgcn_exp2f(-(PG8_ACCV(ai, 0, m, j) * rl));
#pragma unroll
                for (int j = 0; j < 8; ++j) nu[j] = (PG8_ACCV(ai, 0, m, j) * r2) * PG8_ACCV(ai, 1, m, j);
#pragma unroll
                for (int j = 0; j < 8; ++j) ex[j] = __builtin_amdgcn_rcpf(1.f + ex[j]);
#pragma unroll
                for (int j = 0; j < 8; ++j) o[j] = (_Float16)(nu[j] * ex[j]);
                *(GAS h16x8*)(act + (size_t)row * 2816 + col0) = o;

            }
    }
};
struct EpiStore {
    static constexpr bool PERM = true, AFTER_DRAIN = false, IDEMPOTENT = true, NEEDS_ALIGN_EPI = false;
    bf16_t* o;
    __device__ __forceinline__ void operator()(const f32x4 (&acc)[2][2][4][2], const Unit& u, int wr, int wc, int fr, int fq) const {
        { int l_; asm volatile("v_mbcnt_lo_u32_b32 %0, -1, 0\n\tv_mbcnt_hi_u32_b32 %0, -1, %0" : "=v"(l_)); fr = l_ & 15; fq = l_ >> 4; }
        const int col0 = u.pn * BM + wc * 32 + 8 * fq;
#pragma unroll
        for (int ai = 0; ai < 2; ++ai)
#pragma unroll
            for (int m = 0; m < 4; ++m) {
                const int row = u.pm * BM + ai * HALF + wr * 64 + m * 16 + fr;
#pragma unroll
                for (int bj = 0; bj < 2; ++bj) { h16x8 v;
#pragma unroll
                    for (int j = 0; j < 8; ++j) v[j] = (_Float16)PG8_ACCV(ai, bj, m, j);
                    *(GAS h16x8*)(o + (size_t)row * 1024 + col0 + bj * HALF) = v; }
            }
    }
};
struct EpiPle {
    static constexpr bool PERM = true, AFTER_DRAIN = false, IDEMPOTENT = false, NEEDS_ALIGN_EPI = true;
    unsigned char* ws; int L; LAS float* xch;
    __device__ __forceinline__ void operator()(const f32x4 (&acc)[2][2][4][2], const Unit& u, int wr, int wc, int fr, int fq) const {
        { int l_; asm volatile("v_mbcnt_lo_u32_b32 %0, -1, 0\n\tv_mbcnt_hi_u32_b32 %0, -1, %0" : "=v"(l_)); fr = l_ & 15; fq = l_ >> 4; }
        const float* ss = (const float*)(ws + WS_SS) + (size_t)(3 * L + 2) * 32768; float* ssn = (float*)(ws + WS_SS) + (size_t)(3 * L + 3) * 32768;
        const bf16_t* pp = (const bf16_t*)(ws + WS_O16); const bf16_t* hin = (const bf16_t*)(ws + ((L & 1) ? WS_H16B : WS_H16)); bf16_t* hout = (bf16_t*)(ws + ((L & 1) ? WS_H16 : WS_H16B));
        const int col0 = u.pn * BM + wc * 32 + 8 * fq;
        float rsv[8];
#pragma unroll
        for (int i = 0; i < 8; ++i) rsv[i] = ((const GAS float*)ss)[u.pm * BM + (i >> 2) * HALF + wr * 64 + (i & 3) * 16 + fr];
        h16x8 so[8][2]; float sq[8];
#pragma unroll
        for (int ai = 0; ai < 2; ++ai) {
            h16x8 hv[4][2], pv[4][2];
#pragma unroll
            for (int m = 0; m < 4; ++m) { const int row = u.pm * BM + ai * HALF + wr * 64 + m * 16 + fr;
#pragma unroll
                for (int bj = 0; bj < 2; ++bj) { const size_t off = (size_t)row * 1024 + col0 + bj * HALF; hv[m][bj] = *(const GAS h16x8*)(hin + off); pv[m][bj] = *(const GAS h16x8*)(pp + off); } }
            asm volatile("" ::: "memory");
#pragma unroll
            for (int m = 0; m < 4; ++m) { const float rstd = rsqrtf(rsv[ai * 4 + m] * (1.f / 1024.f) + 1e-6f); float s = 0.f;
#pragma unroll
                for (int bj = 0; bj < 2; ++bj) { h16x8 o;
#pragma unroll
                    for (int j = 0; j < 8; ++j) { const _Float16 r = (_Float16)((float)hv[m][bj][j] + (float)pv[m][bj][j] * fast_sigmoid(PG8_ACCV(ai, bj, m, j) * rstd)); o[j] = r; const float rf = (float)r; s += rf * rf; }
                    so[ai * 4 + m][bj] = o; }
                s += lx<16>(s); sq[ai * 4 + m] = pair_sum(s); }
            asm volatile("" ::: "memory");
        }
#pragma unroll
        for (int g_ = 0; g_ < 8; ++g_) { const int row = u.pm * BM + (g_ >> 2) * HALF + wr * 64 + (g_ & 3) * 16 + fr;
#pragma unroll
            for (int bj = 0; bj < 2; ++bj) *(GAS h16x8*)(hout + (size_t)row * 1024 + col0 + bj * HALF) = so[g_][bj];
        }
        pg8_rowsum_add(sq, ssn, xch, u, wr, wc, fr, fq);
    }
};
struct EpiPleFinal {
    static constexpr bool PERM = true, AFTER_DRAIN = false, IDEMPOTENT = false, NEEDS_ALIGN_EPI = true;
    unsigned char* ws; float* out; const float* gain; int L; LAS float* xch;
    __device__ __forceinline__ void operator()(const f32x4 (&acc)[2][2][4][2], const Unit& u, int wr, int wc, int fr, int fq) const {
        { int l_; asm volatile("v_mbcnt_lo_u32_b32 %0, -1, 0\n\tv_mbcnt_hi_u32_b32 %0, -1, %0" : "=v"(l_)); fr = l_ & 15; fq = l_ >> 4; }
        const float* ss = (const float*)(ws + WS_SS) + (size_t)(3 * L + 2) * 32768; float* ssn = (float*)(ws + WS_SS) + (size_t)(3 * L + 3) * 32768;
        const bf16_t* pp = (const bf16_t*)(ws + WS_O16); const bf16_t* hin = (const bf16_t*)(ws + ((L & 1) ? WS_H16B : WS_H16));
        unsigned* ctr = (unsigned*)(ws + WS_CTL) + 65536 + 64 * u.pm;
        const int col0 = u.pn * BM + wc * 32 + 8 * fq;
        float rsv[8];
#pragma unroll
        for (int i = 0; i < 8; ++i) rsv[i] = ((const GAS float*)ss)[u.pm * BM + (i >> 2) * HALF + wr * 64 + (i & 3) * 16 + fr];
        float res[8][2][8]; float sq[8];
#pragma unroll
        for (int ai = 0; ai < 2; ++ai) {
            h16x8 hv[4][2], pv[4][2];
#pragma unroll
            for (int m = 0; m < 4; ++m) { const int row = u.pm * BM + ai * HALF + wr * 64 + m * 16 + fr;
#pragma unroll
                for (int bj = 0; bj < 2; ++bj) { const size_t off = (size_t)row * 1024 + col0 + bj * HALF; hv[m][bj] = *(const GAS h16x8*)(hin + off); pv[m][bj] = *(const GAS h16x8*)(pp + off); } }
            asm volatile("" ::: "memory");
#pragma unroll
            for (int m = 0; m < 4; ++m) { const float rstd = rsqrtf(rsv[ai * 4 + m] * (1.f / 1024.f) + 1e-6f); float s = 0.f;
#pragma unroll
                for (int bj = 0; bj < 2; ++bj)
#pragma unroll
                    for (int j = 0; j < 8; ++j) { const float r = (float)hv[m][bj][j] + (float)pv[m][bj][j] * fast_sigmoid(PG8_ACCV(ai, bj, m, j) * rstd); res[ai * 4 + m][bj][j] = r; s += r * r; }
                s += lx<16>(s); sq[ai * 4 + m] = pair_sum(s); }
            asm volatile("" ::: "memory");
        }
        pg8_rowsum_add(sq, ssn, xch, u, wr, wc, fr, fq);
        asm volatile("s_waitcnt vmcnt(0)" ::: "memory");
        if (fq == 0 && fr == 0) __hip_atomic_fetch_add(ctr, 1u, __ATOMIC_RELAXED, __HIP_MEMORY_SCOPE_AGENT);
        while (__hip_atomic_load(ctr, __ATOMIC_RELAXED, __HIP_MEMORY_SCOPE_AGENT) < 32u) __builtin_amdgcn_s_sleep(2);
        asm volatile("" ::: "memory");
        f32x4 gv[2][2];
#pragma unroll
        for (int bj = 0; bj < 2; ++bj) { gv[bj][0] = *(const GAS f32x4*)(gain + col0 + bj * HALF); gv[bj][1] = *(const GAS f32x4*)(gain + col0 + bj * HALF + 4); }
        float rf[8];
#pragma unroll
        for (int g_ = 0; g_ < 8; ++g_) rf[g_] = __hip_atomic_load(ssn + u.pm * BM + (g_ >> 2) * HALF + wr * 64 + (g_ & 3) * 16 + fr, __ATOMIC_RELAXED, __HIP_MEMORY_SCOPE_AGENT);
#pragma unroll
        for (int g_ = 0; g_ < 8; ++g_) { const int row = u.pm * BM + (g_ >> 2) * HALF + wr * 64 + (g_ & 3) * 16 + fr; const float rstd = rsqrtf(rf[g_] * (1.f / 1024.f) + 1e-6f);
#pragma unroll
            for (int bj = 0; bj < 2; ++bj) { GAS f32x4* o = (GAS f32x4*)(out + (size_t)row * 1024 + col0 + bj * HALF); f32x4 a, b;
#pragma unroll
                for (int j = 0; j < 4; ++j) { a[j] = res[g_][bj][j] * rstd * gv[bj][0][j]; b[j] = res[g_][bj][4 + j] * rstd * gv[bj][1][j]; }
                o[0] = a; o[1] = b; } }
    }
};
struct EpiInProj {
    static constexpr bool PERM = true, AFTER_DRAIN = false, IDEMPOTENT = true, NEEDS_ALIGN_EPI = false;
    unsigned char* ws; int L;
    __device__ __forceinline__ void operator()(const f32x4 (&acc)[2][2][4][2], const Unit& u, int wr, int wc, int fr, int fq) const {
        { int l_; asm volatile("v_mbcnt_lo_u32_b32 %0, -1, 0\n\tv_mbcnt_hi_u32_b32 %0, -1, %0" : "=v"(l_)); fr = l_ & 15; fq = l_ >> 4; }
        const float* ss = (const float*)(ws + WS_SS) + (size_t)(3 * L) * 32768; const float2* rope = (const float2*)(ws + WS_ROPE);
        const float* b_gate = (const float*)(ws + WS_BIAS) + L * 32; const float* b_forget = b_gate + 24;
        bf16_t* const nq = (bf16_t*)(ws + WS_NQ); float* const gates = (float*)(ws + WS_GATES); float* const flog = (float*)(ws + WS_FLOG);
        const int slot = u.pn * 4 + wc;
        if (slot > 44) { pg8_pad16(); return; }
        bf16_t* base = nq; int nh = 8, hidx = slot; bool tokmajor = false, rope_on = false; float scale = 1.f;
        if (slot < 8) { tokmajor = true; rope_on = true; scale = 0.125f * 1.4426950408889634f; }
        else if (slot < 14) { const int t = slot - 8; base = (bf16_t*)(ws + (t < 2 ? WS_KC_IN : (t < 4 ? WS_KS : WS_KW))); nh = 2; hidx = t & 1; rope_on = true; }
        else if (slot < 20) { const int t = slot - 14; base = (bf16_t*)(ws + (t < 2 ? WS_VC_IN : (t < 4 ? WS_VS : WS_VW))); nh = 2; hidx = t & 1; }
        else if (slot < 44) { const int t = slot - 20, which = t >> 2; hidx = t & 3; nh = 4;
            base = (bf16_t*)(ws + WS_FQ + (size_t)which * (16u << 20));
            scale = which == 0 ? 0.125f * 1.4426950408889634f : (which == 3 ? 0.125f : 1.f); }
        float rsv[8];
#pragma unroll
        for (int i = 0; i < 8; ++i) rsv[i] = ((const GAS float*)ss)[u.pm * BM + (i >> 2) * HALF + wr * 64 + (i & 3) * 16 + fr];
        h16x8 so1[8], so2[8];
        f32x4 rb[2][4];
        const int rrow0 = u.pm * BM + wr * 64 + fr;
        f32x4 bg0 = {0.f, 0.f, 0.f, 0.f}, bg1 = bg0;
        if (slot == 44) { if (fq < 3) { bg0 = *(const GAS f32x4*)(b_gate + 8 * fq); bg1 = *(const GAS f32x4*)(b_gate + 8 * fq + 4); } else bg0 = *(const GAS f32x4*)b_forget; }
#pragma unroll
        for (int ai = 0; ai < 2; ++ai) {
#pragma unroll
            for (int m = 0; m < 4; ++m) {
                if (rope_on && (m & 1) == 0) {
#pragma unroll
                    for (int mm = m; mm < m + 2; ++mm) { const GAS f32x4* cs = (const GAS f32x4*)(rope + (size_t)(rrow0 + ai * HALF + mm * 16) * 32 + 8 * fq);
#pragma unroll
                        for (int jj = 0; jj < 4; ++jj) rb[mm & 1][jj] = cs[jj]; }
                    asm volatile("" ::: "memory"); }
                const int row = u.pm * BM + ai * HALF + wr * 64 + m * 16 + fr; const float rs = rsqrtf(rsv[ai * 4 + m] * (1.f / 1024.f) + 1e-6f) * scale;
                const int b = row >> 12, s = row & 4095;
                constexpr int dummy_ = 0; (void)dummy_;
                const int g_ = ai * 4 + m;
                if (slot == 44) {
                    float v[8];
#pragma unroll
                    for (int j = 0; j < 8; ++j) v[j] = PG8_ACCV(ai, 0, m, j) * rs;
                    if (fq < 3) { const f32x4 b0 = bg0, b1 = bg1; f32x4 o0, o1;
#pragma unroll
                        for (int j = 0; j < 4; ++j) { o0[j] = 1.f / (1.f + expf(-(v[j] + b0[j]))); o1[j] = 1.f / (1.f + expf(-(v[4 + j] + b1[j]))); }
                        float* gp = gates + (size_t)row * 24 + 8 * fq; *(GAS f32x4*)gp = o0; *(GAS f32x4*)(gp + 4) = o1; }
                    else { const f32x4 bf = bg0; GAS float* fp = (GAS float*)(flog + (size_t)b * 4 * 4096 + s);
#pragma unroll
                        for (int j = 0; j < 4; ++j) { const float xx = v[j] + bf[j]; fp[(size_t)j * 4096] = fminf(xx, 0.f) - log1pf(expf(-fabsf(xx))); } }
                    asm volatile("" ::: "memory");
                    continue;
                }
                float x1[8], x2[8];
#pragma unroll
                for (int j = 0; j < 8; ++j) { x1[j] = PG8_ACCV(ai, 0, m, j) * rs; x2[j] = PG8_ACCV(ai, 1, m, j) * rs; }
                if (rope_on) {
#pragma unroll
                    for (int jj = 0; jj < 4; ++jj) { const f32x4 t = rb[m & 1][jj];
                        { const float a = x1[2 * jj], bb = x2[2 * jj]; x1[2 * jj] = a * t[0] - bb * t[1]; x2[2 * jj] = bb * t[0] + a * t[1]; }
                        { const float a = x1[2 * jj + 1], bb = x2[2 * jj + 1]; x1[2 * jj + 1] = a * t[2] - bb * t[3]; x2[2 * jj + 1] = bb * t[2] + a * t[3]; } }
                }
#pragma unroll
                for (int j = 0; j < 8; ++j) { so1[g_][j] = (_Float16)x1[j]; so2[g_][j] = (_Float16)x2[j]; }
                if (m & 1) asm volatile("" ::: "memory");
            }
        }
        if (slot != 44) {
#pragma unroll
            for (int g_ = 0; g_ < 8; ++g_) {
                const int row = u.pm * BM + (g_ >> 2) * HALF + wr * 64 + (g_ & 3) * 16 + fr, b = row >> 12, s = row & 4095;
                bf16_t* dst = tokmajor ? base + ((size_t)row * 8 + hidx) * 64 : base + (((size_t)b * nh + hidx) * 4096 + s) * 64;
                *(GAS h16x8*)(dst + 8 * fq) = so1[g_]; *(GAS h16x8*)(dst + 32 + 8 * fq) = so2[g_]; }
        }
    }
};
#undef PG8_ACCV

template <class Epi, class Sched, bool ALIGN_EPI = false, bool SP2 = false>
__device__ __forceinline__ void gemm_phase(PG8_LAS unsigned char* lds, const Gemm g, const Sched& S, const Epi& E, const int wave_idx  ) {
    static_assert(ALIGN_EPI || !Epi::NEEDS_ALIGN_EPI, "this epilogue waits for other workgroups: all eight waves must enter it together");
    int lane_; asm volatile("v_mbcnt_lo_u32_b32 %0, -1, 0\n\tv_mbcnt_hi_u32_b32 %0, -1, %0" : "=v"(lane_));
    int wid_ = wave_idx; asm volatile("" : "+s"(wid_));
    const int wid = wid_, lane = lane_, tid = wid * 64 + lane, wr = wid >> 2, wc = wid & 3, fr = lane & 15, fq = lane >> 4;
    const int K = g.K, nt = K / BK;
    unsigned voffA[2], voffB[2];
#pragma unroll
    for (int i = 0; i < 2; ++i) { int R, C; stage_rc(tid * 16 + i * 8192, R, C); const int Rb = Epi::PERM ? ((R & ~31) + perm32(R & 31)) : R;
        voffA[i] = (unsigned)(R * K + C) * 2u; voffB[i] = (unsigned)(Rb * K + C) * 2u; }
    const size_t kstep = (size_t)(BK * 2);
    const size_t hstep = (size_t)HALF * K * 2;
    const size_t tstep = 2 * hstep;
    const unsigned ldsw = (unsigned)wid * 1024u;
    const int aoff = lds_byte(wr * 64 + fr, fq * 8), boff = lds_byte(wc * 32 + fr, fq * 8);
#define PG8_SA(b, h) (((b) * 2 + (h)) * HTB)
#define PG8_SB(b, h) ((4 + (b) * 2 + (h)) * HTB)
#define PG8_STAGE(bufoff, gbase, voff) do { _Pragma("unroll") for (int _i = 0; _i < 2; ++_i) \
        __builtin_amdgcn_global_load_lds((const unsigned*)((const char*)(gbase) + (voff)[_i]), (PG8_LAS unsigned*)(lds + (bufoff) + ldsw + _i * 8192), 16, 0, 0); } while (0)
#define PG8_LDA(dst, b, h) do { _Pragma("unroll") for (int m = 0; m < 4; ++m) _Pragma("unroll") for (int k = 0; k < 2; ++k) dst[m][k] = *(const PG8_LAS bf16x8*)(lds + PG8_SA(b, h) + aoff + m * 2048 + k * 1024); } while (0)
#define PG8_LDB(dst, b, h) do { _Pragma("unroll") for (int n = 0; n < 2; ++n) _Pragma("unroll") for (int k = 0; k < 2; ++k) dst[n][k] = *(const PG8_LAS bf16x8*)(lds + PG8_SB(b, h) + boff + n * 2048 + k * 1024); } while (0)
#define PG8_MMA(ai, bj, At, Bt) do { __builtin_amdgcn_s_setprio(1); _Pragma("unroll") for (int m = 0; m < 4; ++m) _Pragma("unroll") for (int n = 0; n < 2; ++n) _Pragma("unroll") for (int k = 0; k < 2; ++k) \
        acc[ai][bj][m][n] = __builtin_amdgcn_mfma_f32_16x16x32_f16(Bt[n][k], At[m][k], acc[ai][bj][m][n], 0, 0, 0); __builtin_amdgcn_s_setprio(0); } while (0)
#define PG8_WAIT_V(n) asm volatile("s_waitcnt vmcnt(" #n ")" ::: "memory")
#define PG8_WAIT_V8_OR_24(tt) asm volatile("s_waitcnt vmcnt(24)\n\ts_cmp_eq_u32 %0, 0\n\ts_cbranch_scc1 .Lpg8w%=\n\ts_waitcnt vmcnt(8)\n.Lpg8w%=:" :: "s"(tt) : "memory", "scc")
#define PG8_WAIT_L(n) asm volatile("s_waitcnt lgkmcnt(" #n ")" ::: "memory")
#define PG8_BAR __builtin_amdgcn_s_barrier()
#define PG8_SCHED __builtin_amdgcn_sched_barrier(0)
    Unit cur, nxt; int ui = 0;
    if (!S.next(0, cur)) return;
    __builtin_amdgcn_s_waitcnt(0x0F70);
    f32x4 acc[2][2][4][2];
#pragma unroll
    for (int a = 0; a < 2; ++a)
#pragma unroll
        for (int b = 0; b < 2; ++b)
#pragma unroll
            for (int m = 0; m < 4; ++m)
#pragma unroll
                for (int n = 0; n < 2; ++n) acc[a][b][m][n] = (f32x4){0.f, 0.f, 0.f, 0.f};
    bf16x8 At[4][2], B0[2][2], B1[2][2];
    const char* cA = (const char*)g.A + (size_t)cur.pm * tstep; const char* cB = (const char*)g.Bt + (size_t)cur.pn * tstep;
    S.a_ready(cur);
    if constexpr (SP2) {
        PG8_STAGE(PG8_SB(0, 0), cB, voffB); PG8_STAGE(PG8_SB(0, 1), cB + hstep, voffB); PG8_STAGE(PG8_SA(0, 0), cA, voffA); PG8_STAGE(PG8_SA(0, 1), cA + hstep, voffA);
        if (wr == 1) PG8_BAR;
        PG8_WAIT_V(2); PG8_BAR;
        PG8_STAGE(PG8_SB(1, 0), cB + kstep, voffB); PG8_STAGE(PG8_SA(1, 0), cA + kstep, voffA); PG8_STAGE(PG8_SB(1, 1), cB + hstep + kstep, voffB);
        PG8_WAIT_V(6); PG8_BAR;
        pg8_pad16();
    } else {
        PG8_STAGE(PG8_SB(0, 0), cB, voffB); PG8_STAGE(PG8_SA(0, 0), cA, voffA); PG8_STAGE(PG8_SB(0, 1), cB + hstep, voffB); PG8_STAGE(PG8_SA(0, 1), cA + hstep, voffA);
        if (wr == 1) PG8_BAR;
        PG8_WAIT_V(4); PG8_BAR;
        PG8_STAGE(PG8_SB(1, 0), cB + kstep, voffB); PG8_STAGE(PG8_SA(1, 0), cA + kstep, voffA); PG8_STAGE(PG8_SB(1, 1), cB + hstep + kstep, voffB);
        PG8_WAIT_V(6); PG8_BAR;
    }
    for (;;) {
        const bool has_next = S.next(ui + 1, nxt);
        const char* nA = has_next ? (const char*)g.A + (size_t)nxt.pm * tstep : cA; const char* nB = has_next ? (const char*)g.Bt + (size_t)nxt.pn * tstep : cB;
        for (int t = 0; t < nt; t += 2) {
            const bool last = (t == nt - 2);
            const char* a1 = cA + (size_t)(t + 1) * kstep;
            const char* a2 = last ? nA : cA + (size_t)(t + 2) * kstep; const char* b2 = last ? nB : cB + (size_t)(t + 2) * kstep;
            const char* a3 = a2 + kstep; const char* b3 = b2 + kstep;
            if (last && has_next) S.a_ready(nxt);
            if constexpr (SP2) {
            PG8_LDB(B0, 0, 0); PG8_LDB(B1, 0, 1); PG8_SCHED; PG8_LDA(At, 0, 0); PG8_STAGE(PG8_SA(1, 1), a1 + hstep, voffA);
            PG8_WAIT_V8_OR_24(t);
            PG8_WAIT_L(0); PG8_BAR; PG8_MMA(0, 0, At, B0); PG8_MMA(0, 1, At, B1); PG8_BAR; PG8_SCHED;
            PG8_LDA(At, 0, 1); PG8_STAGE(PG8_SB(0, 0), b2, voffB); PG8_STAGE(PG8_SB(0, 1), b2 + hstep, voffB); PG8_STAGE(PG8_SA(0, 0), a2, voffA);
            PG8_WAIT_V8_OR_24(t);
            PG8_WAIT_L(0); PG8_BAR; PG8_MMA(1, 0, At, B0); PG8_MMA(1, 1, At, B1); PG8_BAR; PG8_SCHED;
            PG8_LDB(B0, 1, 0); PG8_LDB(B1, 1, 1); PG8_SCHED; PG8_LDA(At, 1, 0); PG8_STAGE(PG8_SA(0, 1), a2 + hstep, voffA);
            PG8_WAIT_V(8); PG8_WAIT_L(0); PG8_BAR; PG8_MMA(0, 0, At, B0); PG8_MMA(0, 1, At, B1); PG8_BAR; PG8_SCHED;
            PG8_LDA(At, 1, 1); PG8_STAGE(PG8_SB(1, 0), b3, voffB); PG8_STAGE(PG8_SB(1, 1), b3 + hstep, voffB); PG8_STAGE(PG8_SA(1, 0), a3, voffA);
            PG8_WAIT_V(8); PG8_WAIT_L(0); PG8_BAR; PG8_MMA(1, 0, At, B0); PG8_MMA(1, 1, At, B1); PG8_BAR; PG8_SCHED;
            } else {
            PG8_LDB(B0, 0, 0); PG8_SCHED; PG8_LDA(At, 0, 0); PG8_STAGE(PG8_SA(1, 1), a1 + hstep, voffA);
            PG8_WAIT_L(8); PG8_BAR; PG8_WAIT_L(0); PG8_MMA(0, 0, At, B0); PG8_BAR; PG8_SCHED;
            PG8_LDB(B1, 0, 1); PG8_STAGE(PG8_SB(0, 0), b2, voffB);
            PG8_BAR; PG8_WAIT_L(0); PG8_MMA(0, 1, At, B1); PG8_BAR;
            PG8_LDA(At, 0, 1); PG8_STAGE(PG8_SA(0, 0), a2, voffA);
            PG8_BAR; PG8_WAIT_L(0); PG8_MMA(1, 0, At, B0); PG8_BAR; PG8_SCHED;
            PG8_STAGE(PG8_SB(0, 1), b2 + hstep, voffB);
            PG8_WAIT_V(6); PG8_BAR; PG8_MMA(1, 1, At, B1); PG8_BAR;
            PG8_LDB(B0, 1, 0); PG8_SCHED; PG8_LDA(At, 1, 0); PG8_STAGE(PG8_SA(0, 1), a2 + hstep, voffA);
            PG8_WAIT_L(8); PG8_BAR; PG8_WAIT_L(0); PG8_MMA(0, 0, At, B0); PG8_BAR; PG8_SCHED;
            PG8_LDB(B1, 1, 1); PG8_STAGE(PG8_SB(1, 0), b3, voffB);
            PG8_BAR; PG8_WAIT_L(0); PG8_MMA(0, 1, At, B1); PG8_BAR;
            PG8_LDA(At, 1, 1); PG8_STAGE(PG8_SA(1, 0), a3, voffA);
            PG8_BAR; PG8_WAIT_L(0); PG8_MMA(1, 0, At, B0); PG8_BAR; PG8_SCHED;
            PG8_STAGE(PG8_SB(1, 1), b3 + hstep, voffB);
            PG8_WAIT_V(6); PG8_BAR; PG8_MMA(1, 1, At, B1); PG8_BAR;
            }
        }
        if constexpr (ALIGN_EPI) { if (wr == 0) PG8_BAR; }
        if constexpr (!Epi::AFTER_DRAIN) { E(acc, cur, wr, wc, fr, fq);
#if defined(PROBE_EPI)
            if constexpr (Epi::IDEMPOTENT) { asm volatile("" ::: "memory"); E(acc, cur, wr, wc, fr, fq); }
#endif
            S.done(cur); }
        if (!has_next) break;
#pragma unroll
        for (int a = 0; a < 2; ++a)
#pragma unroll
            for (int b = 0; b < 2; ++b)
#pragma unroll
                for (int m = 0; m < 4; ++m)
#pragma unroll
                    for (int n = 0; n < 2; ++n) acc[a][b][m][n] = (f32x4){0.f, 0.f, 0.f, 0.f};
        cur = nxt; cA = nA; cB = nB; ++ui;
        if constexpr (ALIGN_EPI) { if (wr == 1) PG8_BAR; }
    }
    PG8_WAIT_V(0);
    if constexpr (!ALIGN_EPI) { if (wr == 0) PG8_BAR; }
    PG8_BAR;
    if constexpr (Epi::AFTER_DRAIN) { E.fused(acc, cur, wr, wc, fr, fq, lds, wid, lane); S.done(cur); }
#undef PG8_SA
#undef PG8_SB
#undef PG8_STAGE
#undef PG8_LDA
#undef PG8_LDB
#undef PG8_MMA
#undef PG8_WAIT_V
#undef PG8_WAIT_V8_OR_24
#undef PG8_WAIT_L
#undef PG8_BAR
#undef PG8_SCHED
}
}

#define GAS __attribute__((address_space(1)))
#define LAS __attribute__((address_space(3)))
typedef unsigned v4u __attribute__((ext_vector_type(4)));
typedef GAS unsigned gu32;
typedef GAS unsigned long long gu64;
#define RLX_AGENT __ATOMIC_RELAXED, __HIP_MEMORY_SCOPE_AGENT
#define LDS_WAIT() asm volatile("s_waitcnt lgkmcnt(0)" ::: "memory")
#define VM_WAIT() asm volatile("s_waitcnt vmcnt(0)" ::: "memory")
__device__ __forceinline__ unsigned long long rt() { return __builtin_amdgcn_s_memrealtime(); }
__device__ __forceinline__ unsigned f2bf(float f) { unsigned u = __builtin_bit_cast(unsigned, f); return (u + 0x7fffu + ((u >> 16) & 1u)) >> 16; }
__device__ __forceinline__ unsigned pk2(float lo, float hi) { return f2bf(lo) | (f2bf(hi) << 16); }
#define XB_TMO      128
#define XB_XCNT(j)  (256  + 64 * (j))
#define XB_XSUB(j)  (1280 + 64 * (j))
#define XB_XGEN(j)  (2304 + 64 * (j))
#define XB_TOP      3328
#define XB_TOPGEN   3392
#define XCD_BAR_WORDS 3456
#define XB_SPIN_CAP (1u << 18)

__device__ __forceinline__ unsigned xb_ld(unsigned* p)              { return __hip_atomic_load(p, __ATOMIC_RELAXED, __HIP_MEMORY_SCOPE_AGENT); }
__device__ __forceinline__ unsigned xb_add(unsigned* p, unsigned v) { return __hip_atomic_fetch_add(p, v, __ATOMIC_RELAXED, __HIP_MEMORY_SCOPE_AGENT); }
__device__ __forceinline__ unsigned xb_xcc_id() { return (unsigned)__builtin_amdgcn_s_getreg((3 << 11) | 20) & 0xFu; }
#define XB_SPIN(cond, bar) do { unsigned _sp = 0; while (cond) { __builtin_amdgcn_s_sleep(1); \
    if ((++_sp & 255u) == 0u) { if (xb_ld(&(bar)[XB_TMO])) break; if (_sp > XB_SPIN_CAP) { atomicAdd(&(bar)[XB_TMO], 1u); break; } } } } while (0)

struct XcdBarrier {
    unsigned* bar; unsigned x;
    volatile LAS unsigned* st;
};

__device__ __forceinline__ XcdBarrier xcd_barrier_post(unsigned* bar, volatile LAS unsigned* st) {
    XcdBarrier b; b.bar = bar; b.x = xb_xcc_id(); b.st = st;
    if (threadIdx.x == 0) (void)xb_add(&bar[XB_XCNT(b.x)], 1u);
    return b;
}
__device__ __forceinline__ void xcd_barrier_complete(unsigned* bar, unsigned x, unsigned& nloc, unsigned& nx) {
    const unsigned G = gridDim.x * gridDim.y * gridDim.z;
    unsigned sum, cnt, mine, sp = 0u;
    for (;;) {
        sum = 0u; cnt = 0u; mine = 0u;
#pragma unroll
        for (unsigned j = 0; j < 16; ++j) { const unsigned c = xb_ld(&bar[XB_XCNT(j)]); sum += c; cnt += (c > 0u) ? 1u : 0u; mine = (j == x) ? c : mine; }
        if (sum == G) break;
        __builtin_amdgcn_s_sleep(1);
        if ((++sp & 255u) == 0u) { if (xb_ld(&bar[XB_TMO])) break; if (sp > XB_SPIN_CAP) { atomicAdd(&bar[XB_TMO], 1u); break; } }
    }
    nloc = mine > 0u ? mine : 1u; nx = cnt > 0u ? cnt : 1u;
}

__device__ __forceinline__ void xcd_barrier(const XcdBarrier& b, const bool is_thread0  ) {
    asm volatile("s_waitcnt vmcnt(0)" ::: "memory");
    __syncthreads();
    if (is_thread0) {
        unsigned* bar = b.bar;
        __builtin_amdgcn_s_waitcnt(0);
        unsigned nloc = b.st[0], nx = b.st[1];
        if (nloc == 0u) { xcd_barrier_complete(bar, b.x, nloc, nx); b.st[0] = nloc; b.st[1] = nx; }
        const unsigned old = xb_add(&bar[XB_XSUB(b.x)], 1u);
        const unsigned gen = old / nloc;
        if (old + 1u == (gen + 1u) * nloc) {
            __builtin_amdgcn_fence(__ATOMIC_RELEASE, "agent");
            asm volatile("s_waitcnt vmcnt(0)" ::: "memory");
            const unsigned og = xb_add(&bar[XB_TOP], 1u);
            const unsigned tg = og / nx;
            if (og + 1u == (tg + 1u) * nx) xb_add(&bar[XB_TOPGEN], 1u);
            else XB_SPIN(xb_ld(&bar[XB_TOPGEN]) == tg, bar);
            __builtin_amdgcn_fence(__ATOMIC_ACQUIRE, "agent");
            xb_add(&bar[XB_XGEN(b.x)], 1u);
            asm volatile("s_waitcnt vmcnt(0)" ::: "memory");
        } else {
            XB_SPIN(xb_ld(&bar[XB_XGEN(b.x)]) == gen, bar);
            __builtin_amdgcn_fence(__ATOMIC_ACQUIRE, "agent");
            asm volatile("s_waitcnt vmcnt(0)" ::: "memory");
        }
    }
    __syncthreads();
}


namespace att {
typedef _Float16 h8 __attribute__((ext_vector_type(8)));
typedef _Float16 h4 __attribute__((ext_vector_type(4)));
typedef float f16v __attribute__((ext_vector_type(16)));
typedef short s16x4 __attribute__((ext_vector_type(4)));
#define ATT_ZERO16 {0.f,0.f,0.f,0.f,0.f,0.f,0.f,0.f,0.f,0.f,0.f,0.f,0.f,0.f,0.f,0.f}
constexpr float NEG_BIG = -1e30f;
__device__ __forceinline__ float lz_() { float z = 0.f; asm volatile("" : "+v"(z)); return z; }
#define ATT_Z16() att::splat16(att::lz_())
constexpr int KT_BYTES = 8192;
constexpr int L_K = 0, L_V = 4 * KT_BYTES, L_C = 8 * KT_BYTES,
              L_FLAG = L_C + 1024, L_SLOT = L_FLAG + 64, L_PM = L_C + 1024 + 4096  , L_IMP = L_SLOT + 64, L_MASK = L_IMP + 64 * 65 * 4, L_CALL = L_MASK + 64 * 8, L_OT = L_CALL  , L_END = L_OT + 32 * 512 * 4;
static_assert(L_END <= 153600, "attention LDS map");
__device__ __forceinline__ f16v splat16(float z) { return (f16v){z,z,z,z,z,z,z,z,z,z,z,z,z,z,z,z}; }
__device__ __forceinline__ int crow(int r, int hi) { return (r & 3) + 8 * (r >> 2) + 4 * hi; }

typedef unsigned u4v __attribute__((ext_vector_type(4)));
struct TileRegs { u4v k, v; };
__device__ __forceinline__ void tile_load(TileRegs& r, const u16* Kg, const u16* Vg, int tid) { r.k = ((const GAS u4v*)Kg)[tid]; r.v = ((const GAS u4v*)Vg)[tid]; }
__device__ __forceinline__ void tile_store(const TileRegs& r, LAS unsigned char* bufK, LAS unsigned char* bufV, int tid) {
    const int key = tid >> 3, c = tid & 7;
    *(LAS u4v*)(bufK + key * 128 + ((c ^ ((key >> 1) & 7)) << 4)) = r.k;
    *(LAS u4v*)(bufV + key * 128 + ((c * 16) ^ (((key >> 1) & 1) << 6))) = r.v;
}
__device__ __forceinline__ void qk(f16v& p0, f16v& p1, const LAS unsigned char* bufK, const h8 (&q)[4], int r32, int hi) {
    const LAS unsigned char* kp = bufK + r32 * 128; const int sw = (r32 >> 1) & 7;
    h8 a0[4], a1[4];
#pragma unroll
    for (int d0 = 0; d0 < 4; ++d0) { const int off = ((2 * d0 + hi) ^ sw) << 4; a0[d0] = *(const LAS h8*)(kp + off); a1[d0] = *(const LAS h8*)(kp + 32 * 128 + off); }
    asm volatile("" : "+v"(a0[0]), "+v"(a0[1]), "+v"(a0[2]), "+v"(a0[3]), "+v"(a1[0]), "+v"(a1[1]), "+v"(a1[2]), "+v"(a1[3]));
#pragma unroll
    for (int d0 = 0; d0 < 4; ++d0) { p0 = __builtin_amdgcn_mfma_f32_32x32x16_f16(a0[d0], q[d0], p0, 0, 0, 0); p1 = __builtin_amdgcn_mfma_f32_32x32x16_f16(a1[d0], q[d0], p1, 0, 0, 0); }
}
__device__ __forceinline__ h4 tr_read(const LAS unsigned char* p) { return __builtin_bit_cast(h4, __builtin_amdgcn_ds_read_tr16_b64_v4i16((LAS s16x4*)p)); }
__device__ __forceinline__ void pv(f16v (&o)[2], const LAS unsigned char* bufV, const h8 (&pf)[4], int lane) {
    const int li = lane & 15, g = lane >> 4, hi = g >> 1;
    const int rowA = 4 * hi + (li >> 2);
    const int colb = (16 * (g & 1) + 4 * (li & 3)) * 2;
    const LAS unsigned char* base = bufV + rowA * 128;
    const int x = ((rowA >> 1) & 1) << 6;
#pragma unroll
    for (int dh = 0; dh < 2; ++dh) {
        h8 vf[4];
#pragma unroll
        for (int s = 0; s < 4; ++s) {
            const LAS unsigned char* a = base + s * 16 * 128 + ((colb + 64 * dh) ^ x);
            const h4 lo = tr_read(a), hi4 = tr_read(a + 8 * 128);
            vf[s] = (h8){lo[0], lo[1], lo[2], lo[3], hi4[0], hi4[1], hi4[2], hi4[3]};
        }
        asm volatile("" : "+v"(vf[0]), "+v"(vf[1]), "+v"(vf[2]), "+v"(vf[3]));
#pragma unroll
        for (int s = 0; s < 4; ++s) o[dh] = __builtin_amdgcn_mfma_f32_32x32x16_f16(vf[s], pf[s], o[dh], 0, 0, 0);
    }
}
typedef __fp16 fp16x2_t __attribute__((ext_vector_type(2)));
__device__ __forceinline__ void pack_p(h8 (&pf)[4], const f16v& p0, const f16v& p1) {
    typedef unsigned u4_ __attribute__((ext_vector_type(4)));
#pragma unroll
    for (int s = 0; s < 2; ++s) { u4_ a, b;
#pragma unroll
        for (int j = 0; j < 4; ++j) { a[j] = __builtin_bit_cast(unsigned, __builtin_amdgcn_cvt_pkrtz(p0[8 * s + 2 * j], p0[8 * s + 2 * j + 1])); b[j] = __builtin_bit_cast(unsigned, __builtin_amdgcn_cvt_pkrtz(p1[8 * s + 2 * j], p1[8 * s + 2 * j + 1])); }
        pf[s] = __builtin_bit_cast(h8, a); pf[2 + s] = __builtin_bit_cast(h8, b); }
}
constexpr float SM_THR = 8.f;
__device__ __forceinline__ float sm_ref(float m) { return m == NEG_BIG ? 0.f : m; }
template <bool NEGM = false>
__device__ __forceinline__ void softmax_step(f16v& p0, f16v& p1, float& m, float& l, f16v (&o)[2], f16v* negm = nullptr) {
    float mx = fmaxf(p0[0], p1[0]);
#pragma unroll
    for (int r = 1; r < 16; ++r) mx = fmaxf(fmaxf(mx, p0[r]), p1[r]);
    mx = pair_max(mx);
    const bool first = (m == NEG_BIG) && (mx != -INFINITY);
    const bool move = first || (mx > SM_THR);
    if (__any(move)) {
        const float d = move ? mx : 0.f, alpha = first ? 1.f : __builtin_amdgcn_exp2f(-d);
        if (move) m = sm_ref(m) + d;
        l *= alpha;
#pragma unroll
        for (int r = 0; r < 16; ++r) { o[0][r] *= alpha; o[1][r] *= alpha; p0[r] -= d; p1[r] -= d; }
        if constexpr (NEGM) { const float nm = -sm_ref(m);
#pragma unroll
            for (int r = 0; r < 16; ++r) (*negm)[r] = nm; }
    }
    typedef float f2_ __attribute__((ext_vector_type(2)));
    f2_ ls = {0.f, 0.f};
#pragma unroll
    for (int r = 0; r < 16; r += 2) { p0[r] = __builtin_amdgcn_exp2f(p0[r]); p0[r + 1] = __builtin_amdgcn_exp2f(p0[r + 1]); p1[r] = __builtin_amdgcn_exp2f(p1[r]); p1[r + 1] = __builtin_amdgcn_exp2f(p1[r + 1]);
        ls += (f2_){p0[r], p0[r + 1]} + (f2_){p1[r], p1[r + 1]}; }
    l += ls[0] + ls[1];
}
template <class RowPtr>
__device__ __forceinline__ void norm_store(const f16v (&o)[2], const RowPtr& rowp, LAS unsigned char* stage, int lane) {
    const int r32 = lane & 31, hi = lane >> 5;
    float ss = 0.f;
#pragma unroll
    for (int r = 0; r < 16; ++r) ss += o[0][r] * o[0][r] + o[1][r] * o[1][r];
    ss = pair_sum(ss);
    const float rs = rsqrtf(ss * (1.f / 64.f) + 1e-6f);
#pragma unroll
    for (int dh = 0; dh < 2; ++dh)
#pragma unroll
        for (int g = 0; g < 4; ++g) { const h4 v = {(_Float16)(o[dh][4 * g] * rs), (_Float16)(o[dh][4 * g + 1] * rs), (_Float16)(o[dh][4 * g + 2] * rs), (_Float16)(o[dh][4 * g + 3] * rs)};
            *(LAS h4*)(stage + r32 * 136 + (32 * dh + 8 * g + 4 * hi) * 2) = v; }
    asm volatile("s_waitcnt lgkmcnt(0)" ::: "memory");
    const int c = lane & 7;
#pragma unroll
    for (int j = 0; j < 4; ++j) { const int row = (lane >> 3) + 8 * j; const LAS unsigned char* sp = stage + row * 136 + c * 16;
        const h4 lo = *(const LAS h4*)sp, hi4 = *(const LAS h4*)(sp + 8);
        const h8 v = {lo[0], lo[1], lo[2], lo[3], hi4[0], hi4[1], hi4[2], hi4[3]};
        *(GAS h8*)(rowp(row) + 8 * c) = v; }
    asm volatile("s_waitcnt lgkmcnt(0)" ::: "memory");
}
__device__ __forceinline__ int fetch_unit(gu32* head, volatile LAS unsigned* slot, bool leader) {
    if (leader) *slot = __hip_atomic_fetch_add(head, 1u, __ATOMIC_RELAXED, __HIP_MEMORY_SCOPE_AGENT);
    __syncthreads(); const int u = (int)*slot; __syncthreads(); return u;
}

template <int DEPTH, class Body>
__device__ __forceinline__ void tile_walk(const u16* Kg, const u16* Vg, int kt0, int kt1, LAS unsigned char* lds, int tid, const Body& body) {
    if (kt0 >= kt1) return;
    if constexpr (DEPTH == 2) {
        TileRegs rA, rB;
        tile_load(rA, Kg + (size_t)kt0 * 4096, Vg + (size_t)kt0 * 4096, tid);
        if (kt0 + 1 < kt1) tile_load(rB, Kg + (size_t)(kt0 + 1) * 4096, Vg + (size_t)(kt0 + 1) * 4096, tid);
        tile_store(rA, lds + L_K, lds + L_V, tid);
        if (kt0 + 2 < kt1) tile_load(rA, Kg + (size_t)(kt0 + 2) * 4096, Vg + (size_t)(kt0 + 2) * 4096, tid);
        __syncthreads();
        int kt = kt0;
        for (;;) {
            body(kt, lds + L_K, lds + L_V);
            if (kt + 1 < kt1) tile_store(rB, lds + L_K + KT_BYTES, lds + L_V + KT_BYTES, tid);
            if (kt + 3 < kt1) tile_load(rB, Kg + (size_t)(kt + 3) * 4096, Vg + (size_t)(kt + 3) * 4096, tid);
            __syncthreads();
            if (++kt >= kt1) break;
            body(kt, lds + L_K + KT_BYTES, lds + L_V + KT_BYTES);
            if (kt + 1 < kt1) tile_store(rA, lds + L_K, lds + L_V, tid);
            if (kt + 3 < kt1) tile_load(rA, Kg + (size_t)(kt + 3) * 4096, Vg + (size_t)(kt + 3) * 4096, tid);
            __syncthreads();
            if (++kt >= kt1) break;
        }
    } else {
        TileRegs tr;
        tile_load(tr, Kg + (size_t)kt0 * 4096, Vg + (size_t)kt0 * 4096, tid);
        tile_store(tr, lds + L_K, lds + L_V, tid);
        __syncthreads();
        int it = 0;
        for (int kt = kt0; kt < kt1; ++kt, ++it) {
            const int cur = it & 1, nxt = cur ^ 1; const bool more = kt + 1 < kt1;
            if (more) tile_load(tr, Kg + (size_t)(kt + 1) * 4096, Vg + (size_t)(kt + 1) * 4096, tid);
            body(kt, lds + L_K + cur * KT_BYTES, lds + L_V + cur * KT_BYTES);
            if (more) tile_store(tr, lds + L_K + nxt * KT_BYTES, lds + L_V + nxt * KT_BYTES, tid);
            __syncthreads();
        }
    }
}

template <class Src, class Body>
__device__ __forceinline__ void tile_walk_src(int n, LAS unsigned char* lds, int tid, const Src& src, const Body& body) {
    if (n <= 0) return;
    TileRegs tr; const u16* Kp; const u16* Vp;
    src(0, Kp, Vp); tile_load(tr, Kp, Vp, tid);
    tile_store(tr, lds + L_K, lds + L_V, tid);
    __syncthreads();
    for (int v = 0; v < n; ++v) {
        const int cur = v & 1, nxt = cur ^ 1; const bool more = v + 1 < n;
        if (more) { src(v + 1, Kp, Vp); tile_load(tr, Kp, Vp, tid); }
        body(v, lds + L_K + cur * KT_BYTES, lds + L_V + cur * KT_BYTES);
        if (more) tile_store(tr, lds + L_K + nxt * KT_BYTES, lds + L_V + nxt * KT_BYTES, tid);
        __syncthreads();
    }
}

template <class Body>
__device__ __forceinline__ void tile_walk_pair(const u16* Kg, const u16* Vg, int kt0, int kt1, LAS unsigned char* lds, int tid, const Body& body) {
    if (kt0 >= kt1) return;
    TileRegs ra, rb;
    tile_load(ra, Kg + (size_t)kt0 * 4096, Vg + (size_t)kt0 * 4096, tid);
    if (kt0 + 1 < kt1) tile_load(rb, Kg + (size_t)(kt0 + 1) * 4096, Vg + (size_t)(kt0 + 1) * 4096, tid);
    tile_store(ra, lds + L_K, lds + L_V, tid);
    if (kt0 + 1 < kt1) tile_store(rb, lds + L_K + KT_BYTES, lds + L_V + KT_BYTES, tid);
    __syncthreads();
    int it = 0;
    for (int kt = kt0; kt < kt1; kt += 2, ++it) {
        const int cb = (it & 1) * 2 * KT_BYTES, nb = cb ^ (2 * KT_BYTES); const bool m1 = kt + 2 < kt1, m2 = kt + 3 < kt1;
        if (m1) tile_load(ra, Kg + (size_t)(kt + 2) * 4096, Vg + (size_t)(kt + 2) * 4096, tid);
        if (m2) tile_load(rb, Kg + (size_t)(kt + 3) * 4096, Vg + (size_t)(kt + 3) * 4096, tid);
        body(kt, lds + L_K + cb, lds + L_V + cb);
        if (kt + 1 < kt1) body(kt + 1, lds + L_K + cb + KT_BYTES, lds + L_V + cb + KT_BYTES);
        if (m1) tile_store(ra, lds + L_K + nb, lds + L_V + nb, tid);
        if (m2) tile_store(rb, lds + L_K + nb + KT_BYTES, lds + L_V + nb + KT_BYTES, tid);
        __syncthreads();
    }
}

template <class Body2>
__device__ __forceinline__ void tile_walk_pair2(const u16* Kg, const u16* Vg, int kt0, int kt1, LAS unsigned char* lds, int tid, const Body2& body2) {
    if (kt0 >= kt1) return;
    TileRegs ra, rb;
    tile_load(ra, Kg + (size_t)kt0 * 4096, Vg + (size_t)kt0 * 4096, tid);
    if (kt0 + 1 < kt1) tile_load(rb, Kg + (size_t)(kt0 + 1) * 4096, Vg + (size_t)(kt0 + 1) * 4096, tid);
    tile_store(ra, lds + L_K, lds + L_V, tid);
    if (kt0 + 1 < kt1) tile_store(rb, lds + L_K + KT_BYTES, lds + L_V + KT_BYTES, tid);
    __syncthreads();
    int it = 0;
    for (int kt = kt0; kt < kt1; kt += 2, ++it) {
        const int cb = (it & 1) * 2 * KT_BYTES, nb = cb ^ (2 * KT_BYTES); const bool m1 = kt + 2 < kt1, m2 = kt + 3 < kt1;
        if (m1) tile_load(ra, Kg + (size_t)(kt + 2) * 4096, Vg + (size_t)(kt + 2) * 4096, tid);
        if (m2) tile_load(rb, Kg + (size_t)(kt + 3) * 4096, Vg + (size_t)(kt + 3) * 4096, tid);
        body2(kt, kt + 1 < kt1, lds + L_K + cb, lds + L_V + cb, lds + L_K + cb + KT_BYTES, lds + L_V + cb + KT_BYTES);
        if (m1) tile_store(ra, lds + L_K + nb, lds + L_V + nb, tid);
        if (m2) tile_store(rb, lds + L_K + nb + KT_BYTES, lds + L_V + nb + KT_BYTES, tid);
        __syncthreads();
    }
}
template <class Mask>
__device__ __forceinline__ void attn_two(int kta, int ktb, const LAS unsigned char* bKa, const LAS unsigned char* bVa, const LAS unsigned char* bKb, const LAS unsigned char* bVb,
                                         const h8 (&q)[4], float& m, float& l, f16v (&o)[2], int r32, int hi, int lane, const Mask& mask) {
    const float ref0 = sm_ref(m), ci = -ref0;
    f16v a0 = splat16(ci), a1 = a0, b0 = a0, b1 = a0;
    qk(a0, a1, bKa, q, r32, hi);
    qk(b0, b1, bKb, q, r32, hi);
    mask(kta, a0, a1);
    softmax_step(a0, a1, m, l, o);
    { h8 pf[4]; pack_p(pf, a0, a1); pv(o, bVa, pf, lane); }
    const float dref = sm_ref(m) - ref0;
    if (__any(dref != 0.f)) {
#pragma unroll
        for (int r = 0; r < 16; ++r) { b0[r] -= dref; b1[r] -= dref; } }
    mask(ktb, b0, b1);
    softmax_step(b0, b1, m, l, o);
    { h8 pf[4]; pack_p(pf, b0, b1); pv(o, bVb, pf, lane); }
}
template <class Mask>
__device__ __forceinline__ void attn_one(int kt, const LAS unsigned char* bK, const LAS unsigned char* bV, const h8 (&q)[4], float& m, float& l, f16v (&o)[2], int r32, int hi, int lane, const Mask& mask) {
    const float ci = -sm_ref(m); f16v p0 = splat16(ci), p1 = p0; qk(p0, p1, bK, q, r32, hi);
    mask(kt, p0, p1);
    softmax_step(p0, p1, m, l, o);
    h8 pf[4]; pack_p(pf, p0, p1); pv(o, bV, pf, lane);
}

#define SBAR() __builtin_amdgcn_sched_barrier(0)
#define PIN(x) asm volatile("" : "+v"(x))
typedef unsigned u4w __attribute__((ext_vector_type(4)));
__device__ __forceinline__ unsigned pk2h(float a, float b) { return __builtin_bit_cast(unsigned, __builtin_amdgcn_cvt_pkrtz(a, b)); }
__device__ __forceinline__ bool sm_decide(f16v& C0, f16v& C1, float& m, float& l, float& alpha) {
    float mx = fmaxf(C0[0], C1[0]);
#pragma unroll
    for (int r = 1; r < 16; ++r) mx = fmaxf(fmaxf(mx, C0[r]), C1[r]);
    mx = pair_max(mx);
    const bool first = (m == NEG_BIG) && (mx != -INFINITY);
    const bool move = first || (mx > SM_THR);
    alpha = 1.f;
    if (__any(move)) {
        const float d = move ? mx : 0.f; alpha = first ? 1.f : __builtin_amdgcn_exp2f(-d);
        if (move) m = sm_ref(m) + d;
        l *= alpha;
#pragma unroll
        for (int r = 0; r < 16; ++r) { C0[r] -= d; C1[r] -= d; }
        return true;
    }
    return false;
}
#define PIPE_MF(a, b, c) __builtin_amdgcn_mfma_f32_32x32x16_f16(a, b, c, 0, 0, 0)
#define PIPE_KADDR(kslot, i) ((kslot) + r32 * 128 + ((i) & 1) * 4096 + ((((i) & ~1) + hi) ^ ((r32 >> 1) & 7)) * 16)
template <class CInit, class Mask>
__device__ __forceinline__ void pipe_step(f16v& C0, f16v& C1, const f16v& P0, const f16v& P1, const h8 (&q)[4], float& m, float& l, f16v (&o)[2],
                                          const LAS unsigned char* kcur, const LAS unsigned char* vprev, int kt, int r32, int hi, int lane, const CInit& cinit, const Mask& mask) {
    const int li = lane & 15, g = lane >> 4, rowA = 4 * hi + (li >> 2), colb = (16 * (g & 1) + 4 * (li & 3)) * 2, x = ((rowA >> 1) & 1) << 6;
    const LAS unsigned char* vb = vprev + rowA * 128; const int c0 = colb ^ x, c1 = (colb + 64) ^ x;
    h8 vf[8], kf[8]; u4w pw0, pw1, pw2, pw3;
#define PIPE_VRD(f) do { const LAS unsigned char* a_ = vb + ((f) & 3) * 2048 + (((f) >> 2) ? c1 : c0); const h4 lo_ = tr_read(a_), hi_ = tr_read(a_ + 8 * 128); \
        vf[f] = (h8){lo_[0], lo_[1], lo_[2], lo_[3], hi_[0], hi_[1], hi_[2], hi_[3]}; } while (0)
#define PIPE_KRD(i) do { kf[i] = *(const LAS h8*)PIPE_KADDR(kcur, i); } while (0)
#define PIPE_GAPA(MF, A0, A1, A2, A3, W0, W1, PW) do { MF; sacc += A0; sacc += A1; sacc += A2; sacc += A3; PIN(sacc); W0; W1; PIN(PW); SBAR(); } while (0)
#define PIPE_GAPB(MF, X, B) do { MF; X[B] = __builtin_amdgcn_exp2f(X[B]); X[B + 1] = __builtin_amdgcn_exp2f(X[B + 1]); X[B + 2] = __builtin_amdgcn_exp2f(X[B + 2]); X[B + 3] = __builtin_amdgcn_exp2f(X[B + 3]); PIN(X); SBAR(); } while (0)
    PIPE_KRD(0); PIPE_KRD(1);
    f16v Ci0, Ci1; cinit(kt, Ci0, Ci1);
    SBAR();
    float sacc = P0[0] + P0[1];
    PIPE_KRD(2); PIPE_GAPA(C0 = PIPE_MF(kf[0], q[0], Ci0), P0[2], P0[3], P0[4], P0[5],     pw0[0] = pk2h(P0[0], P0[1]),   pw0[1] = pk2h(P0[2], P0[3]),   pw0);
    PIPE_KRD(3); PIPE_GAPA(C1 = PIPE_MF(kf[1], q[0], Ci1), P0[6], P0[7], P0[8], P0[9],     pw0[2] = pk2h(P0[4], P0[5]),   pw0[3] = pk2h(P0[6], P0[7]),   pw0);
    PIPE_KRD(4); PIPE_GAPA(C0 = PIPE_MF(kf[2], q[1], C0),  P0[10], P0[11], P0[12], P0[13], pw1[0] = pk2h(P0[8], P0[9]),   pw1[1] = pk2h(P0[10], P0[11]), pw1);
    PIPE_KRD(5); PIPE_GAPA(C1 = PIPE_MF(kf[3], q[1], C1),  P0[14], P0[15], P1[0], P1[1],   pw1[2] = pk2h(P0[12], P0[13]), pw1[3] = pk2h(P0[14], P0[15]), pw1);
    PIPE_KRD(6); PIPE_GAPA(C0 = PIPE_MF(kf[4], q[2], C0),  P1[2], P1[3], P1[4], P1[5],     pw2[0] = pk2h(P1[0], P1[1]),   pw2[1] = pk2h(P1[2], P1[3]),   pw2);
    PIPE_KRD(7); PIPE_GAPA(C1 = PIPE_MF(kf[5], q[2], C1),  P1[6], P1[7], P1[8], P1[9],     pw2[2] = pk2h(P1[4], P1[5]),   pw2[3] = pk2h(P1[6], P1[7]),   pw2);
    PIPE_GAPA(C0 = PIPE_MF(kf[6], q[3], C0),  P1[10], P1[11], P1[12], P1[13], pw3[0] = pk2h(P1[8], P1[9]),   pw3[1] = pk2h(P1[10], P1[11]), pw3);
    PIPE_GAPA(C1 = PIPE_MF(kf[7], q[3], C1),  P1[14], P1[15], 0.f, 0.f,       pw3[2] = pk2h(P1[12], P1[13]), pw3[3] = pk2h(P1[14], P1[15]), pw3);
    l += sacc;
    PIPE_VRD(0); PIPE_VRD(4); SBAR();
    mask(kt, C0, C1);
    float alpha; const bool resc = sm_decide(C0, C1, m, l, alpha);
    SBAR();
    PIPE_VRD(1); PIPE_GAPB(o[0] = PIPE_MF(vf[0], __builtin_bit_cast(h8, pw0), o[0]), C0, 0);
    PIPE_VRD(5); PIPE_GAPB(o[1] = PIPE_MF(vf[4], __builtin_bit_cast(h8, pw0), o[1]), C0, 4);
    PIPE_VRD(2); PIPE_GAPB(o[0] = PIPE_MF(vf[1], __builtin_bit_cast(h8, pw1), o[0]), C0, 8);
    PIPE_VRD(6); PIPE_GAPB(o[1] = PIPE_MF(vf[5], __builtin_bit_cast(h8, pw1), o[1]), C0, 12);
    PIPE_VRD(3); PIPE_GAPB(o[0] = PIPE_MF(vf[2], __builtin_bit_cast(h8, pw2), o[0]), C1, 0);
    PIPE_VRD(7); PIPE_GAPB(o[1] = PIPE_MF(vf[6], __builtin_bit_cast(h8, pw2), o[1]), C1, 4);
    PIPE_GAPB(o[0] = PIPE_MF(vf[3], __builtin_bit_cast(h8, pw3), o[0]), C1, 8);
    PIPE_GAPB(o[1] = PIPE_MF(vf[7], __builtin_bit_cast(h8, pw3), o[1]), C1, 12);
    if (resc) {
#pragma unroll
        for (int r = 0; r < 16; ++r) { o[0][r] *= alpha; o[1][r] *= alpha; } }
#undef PIPE_VRD
#undef PIPE_KRD
#undef PIPE_GAPA
#undef PIPE_GAPB
}
template <class CInit, class Mask>
__device__ __forceinline__ void pipe_first(f16v& C0, f16v& C1, const h8 (&q)[4], float& m, float& l, f16v (&o)[2], const LAS unsigned char* kcur, int kt, int r32, int hi, const CInit& cinit, const Mask& mask) {
    cinit(kt, C0, C1);
    qk(C0, C1, kcur, q, r32, hi);
    mask(kt, C0, C1);
    float alpha; const bool resc = sm_decide(C0, C1, m, l, alpha);
    if (resc) {
#pragma unroll
        for (int r = 0; r < 16; ++r) { o[0][r] *= alpha; o[1][r] *= alpha; } }
#pragma unroll
    for (int r = 0; r < 16; ++r) { C0[r] = __builtin_amdgcn_exp2f(C0[r]); C1[r] = __builtin_amdgcn_exp2f(C1[r]); }
}
__device__ __forceinline__ void pipe_drain(const f16v& P0, const f16v& P1, float& l, f16v (&o)[2], const LAS unsigned char* vslot, int lane) {
    float s = 0.f;
#pragma unroll
    for (int r = 0; r < 16; ++r) s += P0[r] + P1[r];
    l += s;
    h8 pf[4]; pack_p(pf, P0, P1);
    pv(o, vslot, pf, lane);
}
template <bool HASC, class Src, class Active, class CInit, class Mask, class PreBar, class PostBar>
__device__ __forceinline__ void pipe_walk(int n, LAS unsigned char* lds, int tid, int lane, const h8 (&q)[4], float& m, float& l, f16v (&o)[2],
                                          const Src& src, const Active& active, const CInit& cinit, const Mask& mask, const PreBar& prebar, const PostBar& postbar) {
    if (n <= 0) return;
    const int r32 = lane & 31, hi = lane >> 5, key = tid >> 3, ch = tid & 7;
    const int kst = key * 128 + ((ch ^ ((key >> 1) & 7)) << 4), vst = key * 128 + ((ch * 16) ^ (((key >> 1) & 1) << 6));
    u4v rk, rv; float cpre = 0.f; const u16* Kp; const u16* Vp; const float* Cp;
    src(0, Kp, Vp, Cp); rk = ((const GAS u4v*)Kp)[tid]; if (HASC && tid < 64) cpre = ((const GAS float*)Cp)[tid];
    *(LAS u4v*)(lds + L_K + kst) = rk; if (HASC && tid < 64) ((LAS float*)(lds + L_C))[tid] = cpre;
    __syncthreads();
    f16v pA0, pA1, pB0, pB1;
    bool pending = false; int v = 0;
#define PIPE_ITER(CN0, CN1, PP0, PP1) { \
        const bool k1 = v + 1 < n; \
        if (k1) { src(v + 1, Kp, Vp, Cp); rk = ((const GAS u4v*)Kp)[tid]; if (HASC && tid < 64) cpre = ((const GAS float*)Cp)[tid]; } \
        src(v, Kp, Vp, Cp); rv = ((const GAS u4v*)Vp)[tid]; \
        const LAS unsigned char* kcur = lds + L_K + (v & 1) * KT_BYTES; \
        const LAS unsigned char* vprev = lds + L_V + ((v + 1) & 1) * KT_BYTES; \
        if (active(v)) { \
            if (pending) pipe_step(CN0, CN1, PP0, PP1, q, m, l, o, kcur, vprev, v, r32, hi, lane, cinit, mask); \
            else { pipe_first(CN0, CN1, q, m, l, o, kcur, v, r32, hi, cinit, mask); pending = true; } \
        } else if (pending) { pipe_drain(PP0, PP1, l, o, vprev, lane); pending = false; } \
        prebar(v); \
        if (k1) { *(LAS u4v*)(lds + L_K + ((v + 1) & 1) * KT_BYTES + kst) = rk; if (HASC && tid < 64) ((LAS float*)(lds + L_C + ((v + 1) & 1) * 256))[tid] = cpre; } \
        *(LAS u4v*)(lds + L_V + (v & 1) * KT_BYTES + vst) = rv; \
        __syncthreads(); }
    bool lastodd = false;
    for (;;) {
        PIPE_ITER(pB0, pB1, pA0, pA1); lastodd = false;
        { const bool stop = postbar(v); ++v; if (stop || v >= n) break; }
        PIPE_ITER(pA0, pA1, pB0, pB1); lastodd = true;
        { const bool stop = postbar(v); ++v; if (stop || v >= n) break; }
    }
#undef PIPE_ITER
    if (pending) { const LAS unsigned char* vlast = lds + L_V + ((v + 1) & 1) * KT_BYTES; if (lastodd) pipe_drain(pA0, pA1, l, o, vlast, lane); else pipe_drain(pB0, pB1, l, o, vlast, lane); }
}

constexpr float FOX_DEAD = -152.f;
__device__ __forceinline__ void fox_unit(unsigned char* ws, LAS unsigned char* lds, int bh, int qb, int wave, int lane) {
    asm volatile("" : "+v"(lane));
    const int tid = wave * 64 + lane, r32 = lane & 31, hi = lane >> 5;
    const u16* Qg = (const u16*)(ws + WS_FQ) + (size_t)bh * SEQ * 64; const u16* Kg = (const u16*)(ws + WS_FK) + (size_t)bh * SEQ * 64; const u16* Vg = (const u16*)(ws + WS_FV) + (size_t)bh * SEQ * 64;
    const GAS float* cg = (const GAS float*)(ws + WS_CFOX) + (size_t)bh * SEQ;
    const int t0w = 256 * qb + 32 * wave, t = t0w + r32;
    h8 q[4]; float qn = 0.f;
#pragma unroll
    for (int d0 = 0; d0 < 4; ++d0) { q[d0] = *(const GAS h8*)(Qg + (size_t)t * 64 + 16 * d0 + 8 * hi);
#pragma unroll
        for (int j = 0; j < 8; ++j) { const float v = (float)q[d0][j]; qn += v * v; } }
    qn = sqrtf(pair_sum(qn)) * 1.001f;
    const float ct = cg[t];
    float m = NEG_BIG, l = 0.f; f16v o[2] = {ATT_Z16(), ATT_Z16()};
    const int ktop = 4 * qb + 3;
    volatile LAS unsigned* flags = (volatile LAS unsigned*)(lds + L_FLAG);
    LAS float* pm = (LAS float*)(lds + L_PM);
    if (wave == 0) { float v = lane <= ktop ? ((const GAS float*)(ws + WS_KN))[bh * 64 + lane] : 0.f;
        int ln = lane; asm volatile("" : "+v"(ln));
#pragma unroll
        for (int d = 1; d < 64; d <<= 1) { const float u = __int_as_float(__builtin_amdgcn_ds_bpermute(4 * (ln - d), __float_as_int(v))); if (ln >= d) v = fmaxf(v, u); }
        pm[lane] = v * 1.001f; pm[64 + lane] = lane <= ktop ? cg[64 * lane + 63] : 0.f; }
    TileRegs tr; float cpre = 0.f;
    tile_load(tr, Kg + (size_t)ktop * 4096, Vg + (size_t)ktop * 4096, tid); if (tid < 64) cpre = cg[64 * ktop + tid];
    tile_store(tr, lds + L_K, lds + L_V, tid); if (tid < 64) ((LAS float*)(lds + L_C))[tid] = cpre;
    __syncthreads();
    bool wave_done = false; int it = 0;
    for (int kt = ktop; kt >= 0; --kt, ++it) {
        const int cur = it & 1, nxt = cur ^ 1; const bool more = kt > 0;
        if (more) { tile_load(tr, Kg + (size_t)(kt - 1) * 4096, Vg + (size_t)(kt - 1) * 4096, tid); if (tid < 64) cpre = cg[64 * (kt - 1) + tid]; }
        const bool reached = 64 * kt <= t0w + 31;
        if (reached && !wave_done) {
            f16v p0, p1; const float ctm = ct - sm_ref(m);
            const LAS float* cs = (const LAS float*)(lds + L_C + cur * 512);
#pragma unroll
            for (int g = 0; g < 4; ++g) { const f32x4 c0 = *(const LAS f32x4*)(cs + 8 * g + 4 * hi), c1 = *(const LAS f32x4*)(cs + 32 + 8 * g + 4 * hi);
#pragma unroll
                for (int e = 0; e < 4; ++e) { p0[4 * g + e] = ctm - c0[e]; p1[4 * g + e] = ctm - c1[e]; } }
            qk(p0, p1, lds + L_K + cur * KT_BYTES, q, r32, hi);
            if (64 * kt + 63 > t0w) {
                int tt = t - 64 * kt; asm volatile("" : "+v"(tt));
#pragma unroll
                for (int r = 0; r < 16; ++r) { const int c = crow(r, hi); if (c > tt) p0[r] = -INFINITY; if (c + 32 > tt) p1[r] = -INFINITY; }
            }
            softmax_step(p0, p1, m, l, o);
            h8 pf[4]; pack_p(pf, p0, p1);
            pv(o, lds + L_V + cur * KT_BYTES, pf, lane);
            if (more) {
                const float bound = qn * pm[kt - 1] + ct - pm[64 + kt - 1] - m;
                wave_done = __all(m != NEG_BIG && bound < FOX_DEAD);
            }
        }
        if (lane == 0) flags[cur * 8 + wave] = (reached && wave_done) ? 1u : 0u;
        if (more) { tile_store(tr, lds + L_K + nxt * KT_BYTES, lds + L_V + nxt * KT_BYTES, tid); if (tid < 64) ((LAS float*)(lds + L_C + nxt * 512))[tid] = cpre; }
        __syncthreads();
        unsigned alld = 1u;
#pragma unroll
        for (int w = 0; w < 8; ++w) alld &= flags[cur * 8 + w];
        if (alld) break;
    }
    __syncthreads();
    l = pair_sum(l); const float inv = 1.f / fmaxf(l, 1e-20f);
#pragma unroll
    for (int r = 0; r < 16; ++r) { o[0][r] *= inv; o[1][r] *= inv; }
    const int b = bh >> 2, h = bh & 3;
    norm_store(o, [&](int r) { return (u16*)(ws + WS_O16) + ((size_t)b * SEQ + t0w + r) * 1024 + (NSA_H + h) * 64; }, lds + L_K + wave * KT_BYTES, lane);
}

constexpr float SB_STOP = -120.f;
__device__ __forceinline__ float softplus_(float z) { return fmaxf(z, 0.f) + 0.6931471805599453f * __builtin_amdgcn_logf(1.f + __builtin_amdgcn_exp2f(-fabsf(z) * 1.4426950408889634f)); }
__device__ __forceinline__ void sb_unit(unsigned char* ws, LAS unsigned char* lds, int bh, int qb, int wave, int lane) {
    asm volatile("" : "+v"(lane));
    const int r32 = lane & 31, hi = lane >> 5;
    const u16* Qg = (const u16*)(ws + WS_SQ) + (size_t)bh * SEQ * 64; const u16* Kg = (const u16*)(ws + WS_SK) + (size_t)bh * SEQ * 64; const u16* Vg = (const u16*)(ws + WS_SV) + (size_t)bh * SEQ * 64;
    const int t0w = 256 * qb + 32 * wave, t = t0w + r32;
    h8 q[4];
#pragma unroll
    for (int d0 = 0; d0 < 4; ++d0) q[d0] = *(const GAS h8*)(Qg + (size_t)t * 64 + 16 * d0 + 8 * hi);
    float carry = 0.f; f16v o[2] = {ATT_Z16(), ATT_Z16()};
    LAS unsigned char* myV = lds + L_K + wave * KT_BYTES;
    for (int kt = (t0w + 31) >> 6; kt >= 0; --kt) {
        h8 ka[4], kb[4]; u4v vv[8];
        { const u16* kp = Kg + ((size_t)64 * kt + r32) * 64 + 8 * hi;
#pragma unroll
          for (int d0 = 0; d0 < 4; ++d0) { ka[d0] = *(const GAS h8*)(kp + 16 * d0); kb[d0] = *(const GAS h8*)(kp + 32 * 64 + 16 * d0); }
          const GAS u4v* vp = (const GAS u4v*)(Vg + (size_t)kt * 4096) + lane;
#pragma unroll
          for (int i = 0; i < 8; ++i) vv[i] = vp[64 * i]; }
#pragma unroll
        for (int i = 0; i < 8; ++i) { const int idx = lane + 64 * i, key = idx >> 3, c = idx & 7; *(LAS u4v*)(myV + key * 128 + ((c * 16) ^ (((key >> 1) & 1) << 6))) = vv[i]; }
        f16v p0 = ATT_Z16(), p1 = ATT_Z16();
#pragma unroll
        for (int d0 = 0; d0 < 4; ++d0) { p0 = __builtin_amdgcn_mfma_f32_32x32x16_f16(ka[d0], q[d0], p0, 0, 0, 0); p1 = __builtin_amdgcn_mfma_f32_32x32x16_f16(kb[d0], q[d0], p1, 0, 0, 0); }
        {
            f16v L0, L1;
            const bool diag = 64 * kt + 63 >= t0w;
            int tt = diag ? t - 64 * kt : 1000; asm volatile("" : "+v"(tt));
#pragma unroll
            for (int r = 0; r < 16; ++r) { const int c = crow(r, hi);
                L0[r] = -softplus_(p0[r]); L1[r] = -softplus_(p1[r]);
                if (c >= tt) L0[r] = 0.f; if (c + 32 >= tt) L1[r] = 0.f; }
            float gt[8];
#pragma unroll
            for (int i = 0; i < 4; ++i) { gt[i] = (L0[4 * i] + L0[4 * i + 1]) + (L0[4 * i + 2] + L0[4 * i + 3]); gt[4 + i] = (L1[4 * i] + L1[4 * i + 1]) + (L1[4 * i + 2] + L1[4 * i + 3]); }
            float og[8];
#pragma unroll
            for (int i = 0; i < 8; ++i) og[i] = pair_other(gt[i], hi);
            float T[8]; float run = 0.f;
#pragma unroll
            for (int i = 7; i >= 0; --i) {
                if (hi == 0) { run += og[i]; T[i] = run; run += gt[i]; }
                else { T[i] = run; run += gt[i]; run += og[i]; }
            }
            const float total = run;
#pragma unroll
            for (int i = 0; i < 4; ++i) {
                {   const float b = carry + T[i];
                    const float w3 = b, w2 = w3 + L0[4 * i + 3], w1 = w2 + L0[4 * i + 2], w0 = w1 + L0[4 * i + 1];
                    p0[4 * i] += L0[4 * i] + w0; p0[4 * i + 1] += L0[4 * i + 1] + w1; p0[4 * i + 2] += L0[4 * i + 2] + w2; p0[4 * i + 3] += L0[4 * i + 3] + w3; }
                {   const float b = carry + T[4 + i];
                    const float w3 = b, w2 = w3 + L1[4 * i + 3], w1 = w2 + L1[4 * i + 2], w0 = w1 + L1[4 * i + 1];
                    p1[4 * i] += L1[4 * i] + w0; p1[4 * i + 1] += L1[4 * i + 1] + w1; p1[4 * i + 2] += L1[4 * i + 2] + w2; p1[4 * i + 3] += L1[4 * i + 3] + w3; }
            }
#pragma unroll
            for (int r = 0; r < 16; ++r) { const int c = crow(r, hi);
                p0[r] = (c >= tt) ? 0.f : __builtin_amdgcn_exp2f(p0[r] * 1.4426950408889634f);
                p1[r] = (c + 32 >= tt) ? 0.f : __builtin_amdgcn_exp2f(p1[r] * 1.4426950408889634f); }
            carry += total;
        }
        h8 pf[4]; pack_p(pf, p0, p1);
        pv(o, myV, pf, lane);
        if (__all(carry < SB_STOP)) break;
    }
    __syncthreads();
    const int b = bh >> 2, h = bh & 3;
    norm_store(o, [&](int r) { return (u16*)(ws + WS_O16) + ((size_t)b * SEQ + t0w + r) * 1024 + (NSA_H + FOX_H + h) * 64; }, lds + L_K + wave * KT_BYTES, lane);
}

__device__ __forceinline__ void nsa_unit(unsigned char* ws, LAS unsigned char* lds, int bg, int cur, int wave, int) {
#define NSA_IDS const int lane = lane_id_fresh(), tid = wave * 64 + lane, r32 = lane & 31, hi = lane >> 5, tl = r32 >> 2, hh = r32 & 3; \
    const int b = bg >> 1, g = bg & 1, tloc = 8 * wave + tl, tok = 64 * cur + tloc, head = 4 * g + hh; const size_t row = (size_t)b * SEQ + tok; \
    (void)tid; (void)tl; (void)hh; (void)tok; (void)head; (void)row; (void)tloc; (void)b; (void)g; (void)hi; (void)r32; \
    LAS float* const ot = (LAS float*)(lds + L_OT) + tid; LAS float* const imp_lds = (LAS float*)(lds + L_IMP); LAS unsigned* const mask_lds = (LAS unsigned*)(lds + L_MASK); \
    const GAS float* const gt = (const GAS float*)(ws + WS_GATES) + row * 24 + head * 3; (void)ot; (void)imp_lds; (void)mask_lds; (void)gt;
    h8 q[4];
    { NSA_IDS
      const u16* Qg = (const u16*)(ws + WS_NQ) + (row * 8 + head) * 64;
#pragma unroll
      for (int d0 = 0; d0 < 4; ++d0) q[d0] = *(const GAS h8*)(Qg + 16 * d0 + 8 * hi); }
    float m = NEG_BIG, l = 0.f;
    {   NSA_IDS
    const u16* kcg = (const u16*)(ws + WS_KC) + (size_t)bg * NCMP_PAD * 64; const u16* vcg = (const u16*)(ws + WS_VC) + (size_t)bg * NCMP_PAD * 64;
    const int nct = (4 * cur + 3 + 63) >> 6;
    const int nlim = tok >= 31 ? ((tok - 31) >> 4) : -1;
    {
        f16v o[2] = {ATT_Z16(), ATT_Z16()}; float carry_last = 0.f;
        float rk0 = 0.f, rk1 = 0.f, rk2 = 0.f, rk3 = 0.f;
        tile_walk<1>(kcg, vcg, 0, nct, lds, tid, [&](int kt, const LAS unsigned char* bK, const LAS unsigned char* bV) {
            const float rb = sm_ref(m);
            f16v p0 = splat16(-rb), p1 = p0; qk(p0, p1, bK, q, r32, hi);
            int nl = nlim - 64 * kt; asm volatile("" : "+v"(nl));
#pragma unroll
            for (int r = 0; r < 16; ++r) { const int n = crow(r, hi); if (n > nl) p0[r] = -INFINITY; if (n + 32 > nl) p1[r] = -INFINITY; }
            softmax_step(p0, p1, m, l, o);
            const float ra = sm_ref(m), cs = __builtin_amdgcn_exp2f(rb - ra);
            rk0 = kt == 0 ? ra : rk0; rk1 = kt == 1 ? ra : rk1; rk2 = kt == 2 ? ra : rk2; rk3 = kt == 3 ? ra : rk3;
            float imp[8], last[8];
#pragma unroll
            for (int i = 0; i < 4; ++i) { imp[i] = (p0[4 * i] + p0[4 * i + 1]) + (p0[4 * i + 2] + p0[4 * i + 3]); last[i] = p0[4 * i + 3];
                                          imp[4 + i] = (p1[4 * i] + p1[4 * i + 1]) + (p1[4 * i + 2] + p1[4 * i + 3]); last[4 + i] = p1[4 * i + 3]; }
            float recv[8];
#pragma unroll
            for (int i = 0; i < 8; ++i) recv[i] = pair_other(last[i], hi);
#pragma unroll
            for (int i = 0; i < 8; ++i) { const float below = hi ? recv[i] : (i > 0 ? recv[i > 0 ? i - 1 : 0] : carry_last * cs); imp[i] += below; }
            carry_last = recv[7];
#pragma unroll
            for (int i = 0; i < 8; ++i) ot[(8 * kt + i) * 512] = imp[i];
            h8 pf[4]; pack_p(pf, p0, p1);
            pv(o, bV, pf, lane);
        });
        l = pair_sum(l);
        const float invl = 1.f / fmaxf(l, 1e-20f), rf = sm_ref(m);
#pragma unroll
        for (int kt = 0; kt < 4; ++kt) if (kt < nct) {
            const float fac = __builtin_amdgcn_exp2f((kt == 0 ? rk0 : kt == 1 ? rk1 : kt == 2 ? rk2 : rk3) - rf) * invl;
#pragma unroll
            for (int i = 0; i < 8; ++i) { float v = ot[(8 * kt + i) * 512] * fac; v += lx<1>(v); v += lx<2>(v);
                if (hh == 0) imp_lds[tloc * 65 + 16 * kt + 2 * i + hi] = v; }
        }
        const float g_c = gt[0] * invl;
#pragma unroll
        for (int r = 0; r < 16; ++r) { ot[r * 512] = g_c * o[0][r]; ot[(16 + r) * 512] = g_c * o[1][r]; }
    }
    }
    { NSA_IDS
    if (cur < 16) {
        if (tid < 64) { const unsigned long long mk = (2ull << cur) - 1ull; mask_lds[2 * tid] = (unsigned)mk; mask_lds[2 * tid + 1] = (unsigned)(mk >> 32); }
    } else {
        __syncthreads();
        const int tk = tid >> 3, sub = tid & 7;
        LAS unsigned* keys = (LAS unsigned*)imp_lds;
        unsigned ks[8];
#pragma unroll
        for (int e = 0; e < 8; ++e) { const int j = 8 * sub + e; const bool forced = (j == 0) || (j == cur) || (j == cur - 1);
            const unsigned nb = __float_as_uint(imp_lds[tk * 65 + j]) | 0x80000000u;
            ks[e] = forced ? (0xFFFFFFC0u | (unsigned)(63 - j)) : (j <= cur ? nb : (unsigned)(63 - j)); }
#pragma unroll
        for (int e = 0; e < 8; ++e) keys[tk * 65 + 8 * sub + e] = ks[e];
        __syncthreads();
        int rank[8] = {0, 0, 0, 0, 0, 0, 0, 0};
        for (int jj = 0; jj < 64; ++jj) { const unsigned ko = keys[tk * 65 + jj];
#pragma unroll
            for (int e = 0; e < 8; ++e) rank[e] += (ko > ks[e]) ? 1 : 0; }
        int rs = ((rank[0] + rank[1]) + (rank[2] + rank[3])) + ((rank[4] + rank[5]) + (rank[6] + rank[7]));
        rs += (int)lxu<1>((unsigned)rs); rs += (int)lxu<2>((unsigned)rs); rs += (int)lxu<4>((unsigned)rs);
        if (__any(rs != 2016)) {
#pragma unroll
            for (int e = 0; e < 8; ++e) rank[e] = 0;
            for (int jj = 0; jj < 64; ++jj) { const unsigned ko = keys[tk * 65 + jj];
#pragma unroll
                for (int e = 0; e < 8; ++e) rank[e] += ((ko > ks[e]) || (ko == ks[e] && jj < 8 * sub + e)) ? 1 : 0; }
        }
        unsigned byte = 0u;
#pragma unroll
        for (int e = 0; e < 8; ++e) if (rank[e] < 16 && (8 * sub + e) <= cur) byte |= 1u << e;
        unsigned lo = sub < 4 ? byte << (8 * sub) : 0u, hi32 = sub >= 4 ? byte << (8 * (sub - 4)) : 0u;
        lo |= lxu<1>(lo); hi32 |= lxu<1>(hi32); lo |= lxu<2>(lo); hi32 |= lxu<2>(hi32); lo |= lxu<4>(lo); hi32 |= lxu<4>(hi32);
        if (sub == 0) { mask_lds[2 * tk] = lo; mask_lds[2 * tk + 1] = hi32; }
    }
    }
    __syncthreads();
    f16v o[2];
    {   NSA_IDS
    unsigned long long rowmask = ((unsigned long long)mask_lds[2 * tloc + 1] << 32) | mask_lds[2 * tloc];
    unsigned long long wmask = rowmask;
    { unsigned wl = (unsigned)wmask, wh = (unsigned)(wmask >> 32);
      wl |= lxu<4>(wl); wh |= lxu<4>(wh); wl |= lxu<8>(wl); wh |= lxu<8>(wh); wl |= lxu<16>(wl); wh |= lxu<16>(wh);
      wmask = ((unsigned long long)(unsigned)__builtin_amdgcn_readfirstlane((int)wh) << 32) | (unsigned)__builtin_amdgcn_readfirstlane((int)wl); }
        const u16* ksg = (const u16*)(ws + WS_KS) + (size_t)bg * SEQ * 64; const u16* vsg = (const u16*)(ws + WS_VS) + (size_t)bg * SEQ * 64;
        m = NEG_BIG; l = 0.f; o[0] = ATT_Z16(); o[1] = ATT_Z16();
        pipe_walk<false>(cur + 1, lds, tid, lane, q, m, l, o,
            [&](int v, const u16*& Kp, const u16*& Vp, const float*& Cp) { Kp = ksg + (size_t)v * 4096; Vp = vsg + (size_t)v * 4096; Cp = nullptr; },
            [&](int v) { return (bool)((wmask >> v) & 1ull); },
            [&](int v, f16v& Ci0, f16v& Ci1) { const bool selrow = (rowmask >> v) & 1ull;
                Ci0 = splat16(selrow ? -sm_ref(m) : -INFINITY); Ci1 = Ci0; },
            [&](int v, f16v& C0, f16v& C1) {
                if (v == cur) {
                    int tq = tloc - 4 * hi; asm volatile("" : "+v"(tq));
#pragma unroll
                    for (int r = 0; r < 16; ++r) { const int c = crow(r, 0); if (c > tq) C0[r] = -INFINITY; if (c + 32 > tq) C1[r] = -INFINITY; } } },
            [](int) {}, [](int) { return false; });
    }
    {   NSA_IDS
        l = pair_sum(l); const float sc_ = gt[1] / fmaxf(l, 1e-20f);
#pragma unroll
        for (int r = 0; r < 16; ++r) { ot[r * 512] += sc_ * o[0][r]; ot[(16 + r) * 512] += sc_ * o[1][r]; }
    }
    {   NSA_IDS
        const u16* kwg = (const u16*)(ws + WS_KW) + (size_t)bg * SEQ * 64; const u16* vwg = (const u16*)(ws + WS_VW) + (size_t)bg * SEQ * 64;
        m = NEG_BIG; l = 0.f; o[0] = ATT_Z16(); o[1] = ATT_Z16();
        const int k0 = cur >= 8 ? cur - 8 : 0;
        auto mask_win = [&](int kt, f16v& p0, f16v& p1) {
            if (kt == cur) {
                int tq = tloc - 4 * hi; asm volatile("" : "+v"(tq));
#pragma unroll
                for (int r = 0; r < 16; ++r) { const int c = crow(r, 0); if (c > tq) p0[r] = -INFINITY; if (c + 32 > tq) p1[r] = -INFINITY; }
            } else if (kt == cur - 8) {
                int tq = tloc - 4 * hi; asm volatile("" : "+v"(tq));
#pragma unroll
                for (int r = 0; r < 16; ++r) { const int c = crow(r, 0); if (c <= tq) p0[r] = -INFINITY; if (c + 32 <= tq) p1[r] = -INFINITY; }
            } };
        tile_walk<1>(kwg, vwg, k0, cur + 1, lds, tid, [&](int kt, const LAS unsigned char* bK, const LAS unsigned char* bV) {
            attn_one(kt, bK, bV, q, m, l, o, r32, hi, lane, mask_win);
        });
    }
    {   NSA_IDS
        l = pair_sum(l); const float sc_ = gt[2] / fmaxf(l, 1e-20f);
#pragma unroll
        for (int r = 0; r < 16; ++r) { o[0][r] = ot[r * 512] + sc_ * o[0][r]; o[1][r] = ot[(16 + r) * 512] + sc_ * o[1][r]; }
        norm_store(o, [&](int r) { return (u16*)(ws + WS_O16) + ((size_t)b * SEQ + 64 * cur + 8 * wave + (r >> 2)) * 1024 + (4 * g + (r & 3)) * 64; }, lds + L_K + wave * KT_BYTES, lane);
    }
#undef NSA_IDS
}
__device__ __forceinline__ void glds16(const void* g, unsigned lds_base) {
    unsigned sv; asm volatile("s_mov_b32 %0, m0\n\ts_mov_b32 m0, %2\n\ts_nop 0\n\tglobal_load_lds_dwordx4 %1, off\n\ts_mov_b32 m0, %0" : "=&s"(sv) : "v"(g), "s"(lds_base) : "memory"); }
__device__ __forceinline__ float gelu_tanh_(float x) { const float u = 0.7978845608028654f * (x + 0.044715f * x * x * x); const float e = __expf(2.f * u); return 0.5f * x * (2.f - 2.f / (1.f + e)); }
__device__ __forceinline__ void compress_unit(const u16* kin  , const u16* w1t  , const float* bias1  , const u16* w2t  ,
                                              u16* out  , int n0, int wave, int lane, LAS unsigned char* lds) {
    const int r32 = lane & 31, hi = lane >> 5;
    f16v acc[4] = {ATT_Z16(), ATT_Z16(), ATT_Z16(), ATT_Z16()};
    const u16* wrow = kin + (size_t)(16 * (n0 + r32)) * 64 + 8 * hi + 256 * wave;
    LAS unsigned char* wimg = lds + wave * 16384; const unsigned wl = (unsigned)(size_t)wimg;
    const int dx = lane >> 3, dc = lane & 7;
    const unsigned srcE = (unsigned)(dx * 4096 + ((dc ^ (dx >> 1)) << 4)), srcO = (unsigned)(dx * 4096 + ((dc ^ (4 + (dx >> 1))) << 4));
    const char* w1b = (const char*)(w1t + 256 * wave);
#pragma unroll 1
    for (int ch = 0; ch < 4; ++ch) {
        h8 bfr[4];
#pragma unroll
        for (int dd = 0; dd < 4; ++dd) bfr[dd] = *(const GAS h8*)(wrow + 64 * ch + 16 * dd);
#pragma unroll
        for (int i = 0; i < 16; ++i) glds16(w1b + ch * 128 + (size_t)i * (8 * 4096) + ((i & 1) ? srcO : srcE), wl + i * 1024);
        asm volatile("s_waitcnt vmcnt(0)" ::: "memory");
#pragma unroll
        for (int dd = 0; dd < 4; ++dd)
#pragma unroll
            for (int hb = 0; hb < 4; ++hb) { const h8 afr = *(const LAS h8*)(wimg + (hb * 32 + r32) * 128 + (((2 * dd + hi) ^ ((r32 >> 1) & 7)) << 4));
                acc[hb] = __builtin_amdgcn_mfma_f32_32x32x16_f16(afr, bfr[dd], acc[hb], 0, 0, 0); }
        asm volatile("s_waitcnt lgkmcnt(0)" ::: "memory");
    }
    LAS float* part = (LAS float*)lds;
#pragma unroll
    for (int hb = 0; hb < 4; ++hb)
#pragma unroll
        for (int r = 0; r < 16; ++r) part[((wave * 64) + hb * 16 + r) * 64 + lane] = acc[hb][r];
    __syncthreads();
    const int hb = wave >> 1, s2 = wave & 1;
    h8 gf;
#pragma unroll
    for (int j = 0; j < 8; ++j) { const int i = hb * 16 + 8 * s2 + j; float v = 0.f;
#pragma unroll
        for (int w = 0; w < 8; ++w) v += part[((w * 64) + i) * 64 + lane];
        gf[j] = (_Float16)gelu_tanh_(v + ((const GAS float*)bias1)[32 * hb + crow(8 * s2 + j, hi)]); }
    f16v oacc[2] = {ATT_Z16(), ATT_Z16()};
    { const int s = wave;
#pragma unroll
      for (int eh = 0; eh < 2; ++eh) { const u16* wp = w2t + (size_t)(32 * eh + r32) * 128 + 16 * s + 4 * hi;
          const h4 a0 = *(const GAS h4*)wp, a1 = *(const GAS h4*)(wp + 8); const h8 af = {a0[0], a0[1], a0[2], a0[3], a1[0], a1[1], a1[2], a1[3]};
          oacc[eh] = __builtin_amdgcn_mfma_f32_32x32x16_f16(af, gf, oacc[eh], 0, 0, 0); } }
    __syncthreads();
#pragma unroll
    for (int eh = 0; eh < 2; ++eh)
#pragma unroll
        for (int r = 0; r < 16; ++r) part[((wave * 32) + eh * 16 + r) * 64 + lane] = oacc[eh][r];
    __syncthreads();
    { const int eh = wave >> 2, g = wave & 3; float v[4];
#pragma unroll
      for (int e = 0; e < 4; ++e) { v[e] = 0.f;
#pragma unroll
          for (int w = 0; w < 8; ++w) v[e] += part[((w * 32) + eh * 16 + 4 * g + e) * 64 + lane]; }
      const int n = n0 + r32;
      h4 o = {(_Float16)v[0], (_Float16)v[1], (_Float16)v[2], (_Float16)v[3]};
      if (n >= NCMP) o = (h4){(_Float16)0.f, (_Float16)0.f, (_Float16)0.f, (_Float16)0.f};
      *(GAS h4*)(out + (size_t)n * 64 + 32 * eh + 8 * g + 4 * hi) = o; }
    __syncthreads();
}
}


constexpr int NWAVES = 8;
constexpr int RING_OFF = 0, RING_BYTES = 153600;
constexpr int LDSCTL_OFF = RING_BYTES, MISC_OFF = LDSCTL_OFF + 320;
constexpr int LDS_BYTES = 155648;
constexpr int CW_TMO = 0, CW_BAR = 4096;
constexpr int CW_QUEUE = 32768;
constexpr int N_BAR_REGIONS = 4;
static_assert((CW_BAR + N_BAR_REGIONS * XCD_BAR_WORDS) <= CW_QUEUE && (CW_QUEUE + 64 * 16) * 4 <= (int)(1 * MiB), "control words");
constexpr size_t WS_P16 = WS_H16B + 64 * MiB;
constexpr size_t WS_W = WS_P16 + 32 * MiB;
constexpr size_t W_IN = 0, W_OUT = 6 * MiB, W_GU = 8 * MiB, W_DN = 19 * MiB, W_PG = W_DN + 5632 * 1024, W_PP = W_PG + 2 * MiB, W_LAYER = 27 * MiB;
constexpr size_t WS_CW = WS_W + 2 * W_LAYER;
constexpr size_t WS_END2 = WS_CW + 4 * MiB;
static_assert(W_PP + 512 * 1024 <= W_LAYER && WS_END2 <= 512 * MiB, "weights map");
constexpr size_t CW_W1T = 0, CW_W2T = 2 * MiB, CW_B1 = 2 * MiB + 64 * 1024;
constexpr size_t WS_UTAB = 2 * MiB - 16384;
constexpr int NIN_PAD = 3072;

#ifndef MK_MASK
#define MK_MASK 0xFFFF
#endif
#ifndef MK_REPEAT
#define MK_REPEAT 0
#endif
#define REPS(k) ((((MK_REPEAT) >> (k)) & 1) ? 2 : 1)
struct Args { const void* in[23]; float* out; unsigned char* ws; int ph_lo, ph_hi, bar_region, rep_mask, fuse_final; };

struct RepOrder { pg8::StaticOrder b; int R;
    __device__ bool next(int i, pg8::Unit& u) const { if (i >= 2 * R) return false; return b.next(i >= R ? i - R : i, u); }
    __device__ __forceinline__ void a_ready(const pg8::Unit&) const {}
    __device__ __forceinline__ void done(const pg8::Unit&) const {} };
struct RangeOrder { pg8::StaticOrder b; int i0, cnt;
    __device__ bool next(int i, pg8::Unit& u) const { if (i >= cnt) return false; return b.next(i0 + i, u); }
    __device__ __forceinline__ void a_ready(const pg8::Unit&) const {}
    __device__ __forceinline__ void done(const pg8::Unit&) const {} };
struct ColSrc { const float* W; int col; };
template <int NI, class Map>
__device__ __forceinline__ void transpose_items(const Map& map, int ldw, int K, const float* gain, u16* WT, int nblk, LAS float* scr, int item0, int lane) {
    float tv[NI][32];
#pragma unroll
    for (int q = 0; q < NI; ++q) { const int item = item0 + q, kb = item / nblk, nb = item % nblk, k0 = 64 * kb, n0 = 32 * nb;
        const ColSrc cs = map(n0 + (lane & 31));
        if (cs.W) { const GAS float* wp = (const GAS float*)cs.W + (size_t)(k0 + (lane >> 5)) * ldw + cs.col;
#pragma unroll
            for (int i = 0; i < 32; ++i) tv[q][i] = wp[(size_t)(2 * i) * ldw]; }
        else {
#pragma unroll
            for (int i = 0; i < 32; ++i) tv[q][i] = 0.f; } }
#pragma unroll
    for (int q = 0; q < NI; ++q) { const int item = item0 + q, kb = item / nblk, nb = item % nblk, k0 = 64 * kb, n0 = 32 * nb;
        if (gain) { const GAS float* gp = (const GAS float*)gain + k0 + (lane >> 5);
#pragma unroll
            for (int i = 0; i < 32; ++i) tv[q][i] *= gp[2 * i]; }
#pragma unroll
        for (int i = 0; i < 32; ++i) scr[(2 * i + (lane >> 5)) * 33 + (lane & 31)] = tv[q][i];
        LDS_WAIT(); asm volatile("" ::: "memory");
        const int c = lane & 7;
#pragma unroll
        for (int j = 0; j < 4; ++j) { const int n = (lane >> 3) + 8 * j; const LAS float* s = scr + (8 * c) * 33 + n;
            pg8::h16x8 o;
#pragma unroll
            for (int e = 0; e < 8; ++e) o[e] = (_Float16)s[e * 33];
            *(pg8::h16x8*)(WT + (size_t)(n0 + n) * K + k0 + 8 * c) = o; }
        LDS_WAIT(); asm volatile("" ::: "memory"); }
}
template <class Map>
__device__ __forceinline__ void transpose_item(const Map& map, int ldw, int K, const float* gain, u16* WT, int nblk, LAS float* scr, int item, int lane) { transpose_items<1>(map, ldw, K, gain, WT, nblk, scr, item, lane); }
struct MapIdent { const float* W; __device__ __forceinline__ ColSrc operator()(int n) const { return ColSrc{W, n}; } };
struct MapGU { const float* Wg; const float* Wu; __device__ __forceinline__ ColSrc operator()(int n) const { const int tile = n >> 8, w = n & 255; return w < 128 ? ColSrc{Wg, tile * 128 + w} : ColSrc{Wu, tile * 128 + w - 128}; } };
struct MapInProj { const float* W; __device__ __forceinline__ ColSrc operator()(int n) const {
    const int tile = n >> 8, w = n & 255, bj = w >> 7, wc = (w & 127) >> 5, dd = w & 31, slot = tile * 4 + wc, d = dd + 32 * bj;
    int base;
    if (slot < 8) base = C_NQ + slot * 64;
    else if (slot < 14) { const int t = slot - 8; base = (t < 2 ? C_KC : (t < 4 ? C_KS : C_KW)) + (t & 1) * 64; }
    else if (slot < 20) { const int t = slot - 14; base = (t < 2 ? C_VC : (t < 4 ? C_VS : C_VW)) + (t & 1) * 64; }
    else if (slot < 44) { const int t = slot - 20, which = t >> 2; base = (which == 0 ? C_FQ : which == 1 ? C_FK : which == 2 ? C_FV : which == 3 ? C_SQ : which == 4 ? C_SK : C_SV) + (t & 3) * 64; }
    else if (slot == 44) { if (bj == 1 || dd >= 28) return ColSrc{nullptr, 0}; return ColSrc{W, dd < 24 ? C_GATE + dd : C_FF + (dd - 24)}; }
    else return ColSrc{nullptr, 0};
    return ColSrc{W, base + d}; } };

__global__ void __launch_bounds__(NWAVES * 64, 2) mk_fwd(Args args) {
    extern __shared__ __attribute__((aligned(16))) unsigned char lds_raw[];
    LAS unsigned char* lds = (LAS unsigned char*)lds_raw;
    const int wave = __builtin_amdgcn_readfirstlane(threadIdx.x >> 6), G = gridDim.x;
#define LANE_ID() lane_id_fresh()
    volatile LAS unsigned* MISC = (volatile LAS unsigned*)(lds + MISC_OFF);
    unsigned char* ws = args.ws;
    gu32* ctl = (gu32*)(ws + WS_CTL);
    for (int u = threadIdx.x; u < (LDS_BYTES - LDSCTL_OFF) / 4; u += NWAVES * 64) ((LAS unsigned*)(lds + LDSCTL_OFF))[u] = 0u;
    __syncthreads();
    XcdBarrier bar = xcd_barrier_post((unsigned*)(ctl + CW_BAR) + args.bar_region * XCD_BAR_WORDS, MISC + 8);
    const int lo = args.ph_lo, hi = args.ph_hi;
#define IN(k) (lo <= (k) && (k) < hi)
#if defined(PROBE_BAR2)
#define SEAM(k) do { if (IN(k) && IN((k) + 1)) { xcd_barrier(bar, wave == 0 && LANE_ID() == 0); xcd_barrier(bar, wave == 0 && LANE_ID() == 0); } } while (0)
#else
#define SEAM(k) do { if (IN(k) && IN((k) + 1)) xcd_barrier(bar, wave == 0 && LANE_ID() == 0); } while (0)
#endif
    const int gw = blockIdx.x * NWAVES + wave, NGW = G * NWAVES;

    constexpr int I_IN = 16 * (NIN_PAD / 32), I_OUT = 16 * 32, I_GU = 16 * (5632 / 32), I_DN = 44 * 32, I_PG = 16 * 32, I_PP = 4 * 32, I_LAYER = I_IN + I_OUT + I_GU + I_DN + I_PG + I_PP;
    constexpr int DEF_W_UNITS0 = I_LAYER / 32, DEF_W_UNITS1 = (I_LAYER - I_IN) / 32, DEF_P_UNITS = (int)((size_t)DEPTH * T * PLE / 8 / 8192);
    static_assert(DEPTH == 2 && I_LAYER % 32 == 0 && (I_LAYER - I_IN) % 32 == 0 && (size_t)DEF_P_UNITS * 8192 * 8 == (size_t)DEPTH * T * PLE, "deferred units");
    auto weight_items = [&](auto ni_tag, int Lw, int r, LAS float* scr, int lane) __attribute__((always_inline)) {
        constexpr int NI = decltype(ni_tag)::value;
        u16* wl = (u16*)(ws + WS_W + (size_t)Lw * W_LAYER);
        if (r < I_IN) { transpose_items<NI>(MapInProj{(const float*)args.in[4] + (size_t)Lw * DM * IN_W}, IN_W, DM, (const float*)args.in[3] + Lw * DM, (u16*)((unsigned char*)wl + W_IN), NIN_PAD / 32, scr, r, lane); return; } r -= I_IN;
        if (r < I_OUT) { transpose_items<NI>(MapIdent{(const float*)args.in[14] + (size_t)Lw * DM * DM}, DM, DM, (const float*)args.in[13] + Lw * DM, (u16*)((unsigned char*)wl + W_OUT), 32, scr, r, lane); return; } r -= I_OUT;
        if (r < I_GU) { transpose_items<NI>(MapGU{(const float*)args.in[16] + (size_t)Lw * DM * DFF, (const float*)args.in[17] + (size_t)Lw * DM * DFF}, DFF, DM, (const float*)args.in[15] + Lw * DM, (u16*)((unsigned char*)wl + W_GU), 5632 / 32, scr, r, lane); return; } r -= I_GU;
        if (r < I_DN) { transpose_items<NI>(MapIdent{(const float*)args.in[18] + (size_t)Lw * DFF * DM}, DM, DFF, nullptr, (u16*)((unsigned char*)wl + W_DN), 32, scr, r, lane); return; } r -= I_DN;
        if (r < I_PG) { transpose_items<NI>(MapIdent{(const float*)args.in[21] + (size_t)Lw * DM * DM}, DM, DM, (const float*)args.in[19] + Lw * DM, (u16*)((unsigned char*)wl + W_PG), 32, scr, r, lane); return; } r -= I_PG;
        transpose_items<NI>(MapIdent{(const float*)args.in[20] + (size_t)Lw * PLE * DM}, DM, PLE, nullptr, (u16*)((unsigned char*)wl + W_PP), 32, scr, r, lane);
    };
    if (MK_MASK & 1) if (IN(0))
_Pragma("unroll") for (int rep = 0; rep < REPS(0); ++rep) {
        const int lane = LANE_ID(), tid = wave * 64 + lane;
        float* ss = (float*)(ws + WS_SS); u16* H16A = (u16*)(ws + WS_H16); float2* rope = (float2*)(ws + WS_ROPE);
        LAS float* scr = (LAS float*)(lds + RING_OFF + wave * 16384);
        for (int it = gw; it < I_IN; it += NGW) weight_items(std::integral_constant<int, 1>{}, 0, it, scr, lane);
        for (int it = gw; it < 4 * (128 + 4); it += NGW) {
            const int c = it / 132, r = it % 132, L = c >> 1, kv = c & 1;
            const float* w1 = (const float*)args.in[kv ? 11 : 8] + (size_t)L * 2048 * 128; const float* w2 = (const float*)args.in[kv ? 12 : 9] + (size_t)L * 128 * 64;
            if (r < 128) transpose_item(MapIdent{w1}, 128, 2048, nullptr, (u16*)(ws + WS_CW + CW_W1T + (size_t)c * 524288), 4, scr, r, lane);
            else transpose_item(MapIdent{w2}, 64, 128, nullptr, (u16*)(ws + WS_CW + CW_W2T + (size_t)c * 16384), 2, scr, r - 128, lane);
        }
        for (int it = gw; it < 512; it += NGW) {
            const int c = it >> 7, hid = it & 127, L = c >> 1, kv = c & 1;
            const float* w1 = (const float*)args.in[kv ? 11 : 8] + (size_t)L * 2048 * 128; const float* pe = (const float*)args.in[kv ? 10 : 7] + (size_t)L * 2048;
            float s = 0.f; { float a_[32], b_[32];
#pragma unroll
              for (int i = 0; i < 32; ++i) { a_[i] = ((const GAS float*)pe)[lane + 64 * i]; b_[i] = ((const GAS float*)w1)[(size_t)(lane + 64 * i) * 128 + hid]; }
#pragma unroll
              for (int i = 0; i < 32; ++i) s += a_[i] * b_[i]; }
            s = wsum64(s); if (lane == 0) ((float*)(ws + WS_CW + CW_B1))[c * 128 + hid] = s;
        }
        {
            auto cost = [](int id) { if (id < 1024) { const int cur = id >> 4, nct = (4 * cur + 66) >> 6; return 150 + 18 * (2 * nct + cur + 1 + (cur + 1 < 9 ? cur + 1 : 9)); }
                                     if (id < 1536) { const int q = 4 * (((id - 1024) >> 5) + 1); return 100 + 18 * (q < 15 ? q : 15); } return 200 + ((id - 1536) * 11) / 4; };
            for (int id = gw; id < 2048; id += NGW) { const int c = cost(id); float rank = 0.f;
                for (int o = lane; o < 2048; o += 64) { const int co = cost(o); rank += (co > c || (co == c && o < id)) ? 1.f : 0.f; }
                rank = wsum64(rank);
                if (lane == 0) ((u16*)(ws + WS_UTAB))[(int)rank] = (u16)id; }
        }
        const float* x = (const float*)args.in[0]; const int* pos = (const int*)args.in[2];
        for (int m0 = gw; m0 < T; m0 += 8 * NGW) {
            f32x4 v[8][4];
#pragma unroll
            for (int rr = 0; rr < 8; ++rr) { const int mr = m0 + rr * NGW < T ? m0 + rr * NGW : T - 1; const GAS f32x4* xr = (const GAS f32x4*)(x + (size_t)mr * DM) + lane;
#pragma unroll
                for (int j = 0; j < 4; ++j) v[rr][j] = xr[64 * j]; }
#pragma unroll
            for (int rr = 0; rr < 8; ++rr) { const int m = m0 + rr * NGW; float s = 0.f; if (m >= T) break;
                GAS unsigned long long* o8 = (GAS unsigned long long*)(H16A + (size_t)m * DM) + lane;
#pragma unroll
                for (int j = 0; j < 4; ++j) { const f32x4 w = v[rr][j]; s += (w[0] * w[0] + w[1] * w[1]) + (w[2] * w[2] + w[3] * w[3]);
                    typedef _Float16 h4 __attribute__((ext_vector_type(4))); h4 hv = {(_Float16)w[0], (_Float16)w[1], (_Float16)w[2], (_Float16)w[3]};
                    o8[64 * j] = __builtin_bit_cast(unsigned long long, hv); }
                s = wsum64(s);
                if (lane == 0) ss[m] = s;
                if (lane < 32) { const float inv_freq = powf(10000.f, -(float)lane / 32.f); const float ang = (float)pos[m] * inv_freq; rope[(size_t)m * 32 + lane] = make_float2(cosf(ang), sinf(ang)); } }
        }
        if (blockIdx.x == 0 && tid < 64) { const int L = tid >> 5, c = tid & 31; float v = 0.f; if (c < 24) v = ((const float*)args.in[5])[L * 24 + c]; else if (c < 28) v = ((const float*)args.in[6])[L * 4 + c - 24]; ((float*)(ws + WS_BIAS))[tid] = v; }
    }
    SEAM(0);

#pragma unroll 1
    for (int L = 0; L < DEPTH; ++L) {
        const int pb = 1 + 7 * L;
#define PH_LOCALS unsigned char* wsl = args.ws; asm volatile("" : "+s"(wsl)); \
        u16* hcur = (u16*)(wsl + ((L & 1) ? WS_H16B : WS_H16)); (void)hcur; float* ssL = (float*)(wsl + WS_SS) + (size_t)(3 * L) * T; (void)ssL; \
        const unsigned char* wl = wsl + WS_W + (size_t)L * W_LAYER; (void)wl;
        if ((MK_MASK >> 1) & 1) if (IN(pb + 0))
_Pragma("unroll") for (int rep = 0; rep < REPS(1); ++rep) { PH_LOCALS
            pg8::Gemm g{hcur, (const u16*)(wl + W_IN), T, NIN_PAD, DM}; pg8::StaticOrder S; S.init(T, NIN_PAD, G, (int)blockIdx.x);
            pg8::EpiInProj E{wsl, L};
            if constexpr ((MK_REPEAT) & 0x800) { RepOrder S2{S, (S.nwg + G - 1) / G}; pg8::gemm_phase<pg8::EpiInProj, RepOrder, true, true>(lds + RING_OFF, g, S2, E, wave); }
            else
            pg8::gemm_phase<pg8::EpiInProj, pg8::StaticOrder, true, true>(lds + RING_OFF, g, S, E, wave);
        }
        SEAM(pb + 0);
        if ((MK_MASK >> 2) & 1) if (IN(pb + 1))
_Pragma("unroll") for (int rep = 0; rep < REPS(2); ++rep) {
            unsigned char* wsl = args.ws; asm volatile("" : "+s"(wsl));
            const int lane = LANE_ID(); const int gw = (int)blockIdx.x * NWAVES + wave, NGW = G * NWAVES;
            for (int it = gw; it < 2048; it += NGW) {
                const GAS att::h8* kr = (const GAS att::h8*)((const u16*)(wsl + WS_FK) + ((size_t)it * 64 + lane) * 64); float s = 0.f;
#pragma unroll
                for (int c = 0; c < 8; ++c) { const att::h8 v = kr[c];
#pragma unroll
                    for (int j = 0; j < 8; ++j) { const float x = (float)v[j]; s += x * x; } }
                s = fmaxf(s, lx<1>(s)); s = fmaxf(s, lx<2>(s)); s = fmaxf(s, lx<4>(s)); s = fmaxf(s, lx<8>(s)); s = fmaxf(s, lx<16>(s)); s = pair_max(s);
                if (lane == 0) ((GAS float*)(wsl + WS_KN))[it] = sqrtf(s);
            }
            for (int u = (int)blockIdx.x; u < 256; u += G) {
                const int kv = u >> 7, bg = (u >> 3) & 15, n0 = (u & 7) * 32, c = 2 * L + kv;
                att::compress_unit((const u16*)(wsl + (kv ? WS_VC_IN : WS_KC_IN)) + (size_t)bg * SEQ * 64, (const u16*)(wsl + WS_CW + CW_W1T + (size_t)c * 524288),
                                   (const float*)(wsl + WS_CW + CW_B1) + c * 128, (const u16*)(wsl + WS_CW + CW_W2T + (size_t)c * 16384),
                                   (u16*)(wsl + (kv ? WS_VC : WS_KC)) + (size_t)bg * NCMP_PAD * 64, n0, wave, lane, lds);
            }
            if ((int)blockIdx.x < 32) {
                const int bh = (int)blockIdx.x, tid = wave * 64 + lane;
                const GAS f32x4* fp = (const GAS f32x4*)((const float*)(wsl + WS_FLOG) + (size_t)bh * SEQ) + 2 * tid; const f32x4 xa = fp[0], xb = fp[1];
                const float tot = ((xa[0] + xa[1]) + (xa[2] + xa[3])) + ((xb[0] + xb[1]) + (xb[2] + xb[3]));
                float inc = tot;
#pragma unroll
                for (int d = 1; d < 64; d <<= 1) { const float v = __int_as_float(__builtin_amdgcn_ds_bpermute(4 * (lane - d), __float_as_int(inc))); if (lane >= d) inc += v; }
                LAS float* wt = (LAS float*)(lds + att::L_FLAG);
                if (lane == 63) wt[wave] = inc;
                __syncthreads();
                float acc = inc - tot;
                for (int w = 0; w < 8; ++w) acc += (w < wave) ? wt[w] : 0.f;
                f32x4 oa, ob;
                acc += xa[0]; oa[0] = acc * LOG2E; acc += xa[1]; oa[1] = acc * LOG2E; acc += xa[2]; oa[2] = acc * LOG2E; acc += xa[3]; oa[3] = acc * LOG2E;
                acc += xb[0]; ob[0] = acc * LOG2E; acc += xb[1]; ob[1] = acc * LOG2E; acc += xb[2]; ob[2] = acc * LOG2E; acc += xb[3]; ob[3] = acc * LOG2E;
                GAS f32x4* op = (GAS f32x4*)((float*)(wsl + WS_CFOX) + (size_t)bh * SEQ) + 2 * tid; op[0] = oa; op[1] = ob;
                __syncthreads();
            }
        }
        SEAM(pb + 1);
        if ((MK_MASK >> 3) & 1) if (IN(pb + 2))
{ constexpr int rep = 0; constexpr int NQ = ((MK_REPEAT) & 0x708) ? 4096 : 2048;
            unsigned char* wsl = args.ws; asm volatile("" : "+s"(wsl));
            const int lane = LANE_ID();
            gu32* head = (gu32*)(wsl + WS_CTL) + CW_QUEUE + 64 * (L + 2 * rep);
            volatile LAS unsigned* slot = (volatile LAS unsigned*)(lds + att::L_SLOT);
            (void)NQ;
            const int def_w = (L == 0) ? DEF_W_UNITS0 : DEF_W_UNITS1, nq = 2048 + def_w + ((L == 0) ? DEF_P_UNITS : 0);
            for (;;) {
                const int u = att::fetch_unit(head, slot, wave == 0 && lane == 0);
                if (u >= nq) break;
                if (u >= 2048) {
                    const int d = u - 2048;
                    if (d < def_w) {
                        LAS float* scr = (LAS float*)(lds + att::L_OT + wave * 8704);
                        { const int j = d * 32 + wave * 4; const bool own = (L == 1) || j < I_LAYER - I_IN;
                            weight_items(std::integral_constant<int, 4>{}, (L == 1 || !own) ? 1 : 0, own ? I_IN + j : j - (I_LAYER - I_IN), scr, lane); }
                    } else {
                        const float* p = (const float*)args.in[1]; u16* p16 = (u16*)(wsl + WS_P16);
                        const size_t i0 = (size_t)(d - def_w) * 8192 + (size_t)(wave * 64 + lane);
#pragma unroll 1
                        for (int rnd = 0; rnd < 4; ++rnd) { f32x4 pa[4], pb[4];
#pragma unroll
                            for (int k = 0; k < 4; ++k) { const size_t i = i0 + (size_t)(4 * rnd + k) * 512; pa[k] = ((const GAS f32x4*)p)[2 * i]; pb[k] = ((const GAS f32x4*)p)[2 * i + 1]; }
#pragma unroll
                            for (int k = 0; k < 4; ++k) { const size_t i = i0 + (size_t)(4 * rnd + k) * 512;
                                pg8::h16x8 o = {(_Float16)pa[k][0], (_Float16)pa[k][1], (_Float16)pa[k][2], (_Float16)pa[k][3], (_Float16)pb[k][0], (_Float16)pb[k][1], (_Float16)pb[k][2], (_Float16)pb[k][3]};
                                ((GAS pg8::h16x8*)p16)[i] = o; } }
                    }
                    continue;
                }
                const int id = ((const GAS u16*)(wsl + WS_UTAB))[u];
#ifndef MK_UNITS
#define MK_UNITS 7
#endif
                if (id < 1024) { if (MK_UNITS & 1) att::nsa_unit(wsl, lds, id & 15, id >> 4, wave, lane); }
                else { const int v = (id - 1024) & 511, qb = v >> 5, bh = v & 31;
                    if (id < 1536) { if (MK_UNITS & 2) att::fox_unit(wsl, lds, bh, qb, wave, lane); } else { if (MK_UNITS & 4) att::sb_unit(wsl, lds, bh, qb, wave, lane); } }
            }
        }
        SEAM(pb + 2);
        if ((MK_MASK >> 4) & 1) if (IN(pb + 3))
_Pragma("unroll") for (int rep = 0; rep < REPS(4); ++rep) { PH_LOCALS
            pg8::Gemm g{(const u16*)(wsl + WS_O16), (const u16*)(wl + W_OUT), T, DM, DM}; pg8::StaticOrder S; S.init(T, DM, G, (int)blockIdx.x);
            if (REPS(4) == 2 && rep == 0) { pg8::EpiStore E{(u16*)(wsl + WS_ACT)}; pg8::gemm_phase<pg8::EpiStore, pg8::StaticOrder, true, true>(lds + RING_OFF, g, S, E, wave); }
            else { pg8::EpiResid E{hcur, ssL + T, (LAS float*)(lds + pg8::STAGE_BYTES)};
            pg8::gemm_phase<pg8::EpiResid, pg8::StaticOrder, true, true>(lds + RING_OFF, g, S, E, wave); }
        }
        SEAM(pb + 3);
        if ((MK_MASK >> 5) & 1) if (IN(pb + 4))
_Pragma("unroll") for (int rep = 0; rep < REPS(5); ++rep) { PH_LOCALS
            const int grp = ((int)blockIdx.x >> 3) & 1;
#pragma nounroll
            for (int part = 0; part < 3; ++part) {
                if (part == 1) { pg8::Gemm g{hcur, (const u16*)(wl + W_GU), T, 2 * DFF, DM}; pg8::StaticOrder S; S.init(T, 2 * DFF, G, (int)blockIdx.x);
                    pg8::EpiSwiglu E{ssL + T, (u16*)(wsl + WS_ACT)};
                    pg8::gemm_phase<pg8::EpiSwiglu, pg8::StaticOrder, true, true>(lds + RING_OFF, g, S, E, wave); }
                else { pg8::Gemm g{(const u16*)(wsl + WS_P16) + (size_t)L * T * PLE, (const u16*)(wl + W_PP), T, DM, PLE};
                    RangeOrder S; S.b.init(T, DM, G, (int)blockIdx.x); S.i0 = part == 0 ? 0 : grp; S.cnt = part == 0 ? grp : 2 - grp;
                    pg8::EpiStore E{(u16*)(wsl + WS_O16)};
                    pg8::gemm_phase<pg8::EpiStore, RangeOrder, true, true>(lds + RING_OFF, g, S, E, wave); }
            }
        }
        SEAM(pb + 4);
        if ((MK_MASK >> 6) & 1) if (IN(pb + 5))
_Pragma("unroll") for (int rep = 0; rep < REPS(6); ++rep) { PH_LOCALS
            pg8::Gemm g{(const u16*)(wsl + WS_ACT), (const u16*)(wl + W_DN), T, DM, DFF}; pg8::StaticOrder S; S.init(T, DM, G, (int)blockIdx.x);
            if (REPS(6) == 2 && rep == 0) { pg8::EpiStore E{(u16*)(wsl + ((L & 1) ? WS_H16 : WS_H16B))}; pg8::gemm_phase<pg8::EpiStore, pg8::StaticOrder, true, true>(lds + RING_OFF, g, S, E, wave); }
            else { pg8::EpiResid E{hcur, ssL + 2 * T, (LAS float*)(lds + pg8::STAGE_BYTES)};
            pg8::gemm_phase<pg8::EpiResid, pg8::StaticOrder, true, true>(lds + RING_OFF, g, S, E, wave); }
        }
        SEAM(pb + 5);
        if ((MK_MASK >> 7) & 1) if (IN(pb + 6))
_Pragma("unroll") for (int rep = 0; rep < REPS(7); ++rep) { PH_LOCALS
            pg8::Gemm g{hcur, (const u16*)(wl + W_PG), T, DM, DM}; pg8::StaticOrder S; S.init(T, DM, G, (int)blockIdx.x);
            if (REPS(7) == 2 && rep == 0) { pg8::EpiStore E{(u16*)(wsl + ((L & 1) ? WS_H16 : WS_H16B))}; pg8::gemm_phase<pg8::EpiStore, pg8::StaticOrder, true, true>(lds + RING_OFF, g, S, E, wave); }
            else if (L == DEPTH - 1 && args.fuse_final) { pg8::EpiPleFinal E{wsl, args.out, (const float*)args.in[22], L, (LAS float*)(lds + pg8::STAGE_BYTES)};
            pg8::gemm_phase<pg8::EpiPleFinal, pg8::StaticOrder, true, true>(lds + RING_OFF, g, S, E, wave); }
            else { pg8::EpiPle E{wsl, L, (LAS float*)(lds + pg8::STAGE_BYTES)};
            pg8::gemm_phase<pg8::EpiPle, pg8::StaticOrder, true, true>(lds + RING_OFF, g, S, E, wave); }
        }
        if (L < DEPTH - 1 || !args.fuse_final) SEAM(pb + 6);
    }
    if (!args.fuse_final) if ((MK_MASK >> 15) & 1) if (IN(15))
_Pragma("unroll") for (int rep = 0; rep < REPS(15); ++rep) {
        const int lane = LANE_ID();
        const float* ssF = (const float*)(ws + WS_SS) + (size_t)6 * T; const float* gf = (const float*)args.in[22]; const u16* hf = (const u16*)(ws + WS_H16);
        for (int m = gw; m < T; m += NGW) {
            const float rstd = rsqrtf(ssF[m] * (1.f / DM) + RMS_EPS);
            const unsigned long long* h8 = (const unsigned long long*)(hf + (size_t)m * DM) + lane; f32x4* o = (f32x4*)(args.out + (size_t)m * DM) + lane;
#pragma unroll
            for (int j = 0; j < 4; ++j) { typedef _Float16 h4 __attribute__((ext_vector_type(4))); const h4 hv = __builtin_bit_cast(h4, h8[64 * j]); const f32x4 gv = ((const f32x4*)gf)[64 * j + lane];
                o[64 * j] = (f32x4){(float)hv[0] * rstd * gv[0], (float)hv[1] * rstd * gv[1], (float)hv[2] * rstd * gv[2], (float)hv[3] * rstd * gv[3]}; }
        }
    }
#undef IN
#undef SEAM
}


extern "C" void kernel_launch(void* const* d_in, const int* in_sizes, int n_in, void* d_out, int out_size, void* d_ws, size_t ws_size, hipStream_t stream) {
    static int grid = 0;
    if (grid == 0) {
        if (n_in != 23 || ws_size < WS_END2 || out_size != T * DM) { fprintf(stderr, "kernel_launch: unexpected inputs (n_in %d, ws %zu < %zu, out %d)\n", n_in, ws_size, (size_t)WS_END2, out_size); grid = -1; return; }
        int dev = 0, cus = 0, per_cu = 0;
        if (hipGetDevice(&dev) != hipSuccess || hipDeviceGetAttribute(&cus, hipDeviceAttributeMultiprocessorCount, dev) != hipSuccess) { grid = -1; return; }
        if (hipFuncSetAttribute((const void*)mk_fwd, hipFuncAttributeMaxDynamicSharedMemorySize, LDS_BYTES) != hipSuccess) { fprintf(stderr, "kernel_launch: hipFuncSetAttribute failed\n"); grid = -1; return; }
        if (hipOccupancyMaxActiveBlocksPerMultiprocessor(&per_cu, (const void*)mk_fwd, NWAVES * 64, LDS_BYTES) != hipSuccess || per_cu < 1) { fprintf(stderr, "kernel_launch: occupancy query says %d blocks per CU\n", per_cu); }
        (void)hipGetLastError();
        grid = cus;
    }
    if (grid < 0) return;
    unsigned char* ws = (unsigned char*)d_ws;
    (void)hipMemsetAsync(ws, 0, ZERO_BYTES, stream);
    Args a{};
    for (int i = 0; i < 23; ++i) a.in[i] = d_in[i];
    a.out = (float*)d_out; a.ws = ws; a.ph_lo = 0; a.ph_hi = 16; a.bar_region = 0; a.rep_mask = 0;
    a.fuse_final = (grid % 256 == 0) ? 1 : 0;
    hipLaunchKernelGGL(mk_fwd, dim3(grid), dim3(NWAVES * 64), LDS_BYTES, stream, a);
}
```

```cpp
#include <hip/hip_runtime.h>
#include <cstdio>
#include <cstdint>
#include <cmath>

typedef _Float16 half_t;
typedef _Float16 half8 __attribute__((ext_vector_type(8)));
typedef float f32x16 __attribute__((ext_vector_type(16)));
typedef float f32x4 __attribute__((ext_vector_type(4)));

constexpr int BATCH = 8, SEQ = 4096, DM = 1024, DEPTH = 2, T = BATCH * SEQ;
constexpr int HD = 64, NSA_H = 8, FOX_H = 4, SB_H = 4, NSA_G = 2;
constexpr int IN_W = 2844, DFF = 2816, PLE = 256;
constexpr int NCMP = 255, NCMP_PAD = 256, CMP_HID = 128;
constexpr float RMS_EPS = 1e-6f, TINY = 1e-20f;
constexpr float LOG2E = 1.4426950408889634f;
constexpr float QSCALE2 = 0.125f * LOG2E;
constexpr int C_NQ = 0, C_KC = 512, C_VC = 640, C_KS = 768, C_VS = 896, C_KW = 1024, C_VW = 1152, C_GATE = 1280,
              C_FQ = 1304, C_FK = 1560, C_FV = 1816, C_FF = 2072, C_SQ = 2076, C_SK = 2332, C_SV = 2588;

constexpr size_t MiB = 1u << 20;
constexpr size_t WS_CTL = 0;
constexpr size_t WS_SS = 1 * MiB;
constexpr size_t ZERO_BYTES = 320 * 1024;
constexpr size_t WS_BIAS = 2 * MiB - 4096;
constexpr size_t WS_ROPE = 2 * MiB;
constexpr size_t WS_H16 = 10 * MiB;
constexpr size_t WS_PROJ = 74 * MiB;
constexpr size_t WS_NQ = WS_PROJ;
constexpr size_t WS_KC_IN = WS_NQ + 32 * MiB;
constexpr size_t WS_VC_IN = WS_KC_IN + 8 * MiB;
constexpr size_t WS_KS = WS_VC_IN + 8 * MiB;
constexpr size_t WS_VS = WS_KS + 8 * MiB;
constexpr size_t WS_KW = WS_VS + 8 * MiB;
constexpr size_t WS_VW = WS_KW + 8 * MiB;
constexpr size_t WS_FQ = WS_VW + 8 * MiB;
constexpr size_t WS_FK = WS_FQ + 16 * MiB;
constexpr size_t WS_FV = WS_FK + 16 * MiB;
constexpr size_t WS_SQ = WS_FV + 16 * MiB;
constexpr size_t WS_SK = WS_SQ + 16 * MiB;
constexpr size_t WS_SV = WS_SK + 16 * MiB;
constexpr size_t WS_ACT = WS_PROJ;
constexpr size_t WS_GATES = WS_PROJ + 176 * MiB;
constexpr size_t WS_FLOG = WS_GATES + 3 * MiB;
constexpr size_t WS_CFOX = WS_FLOG + 1 * MiB;
constexpr size_t WS_KN = WS_CFOX + 512 * 1024;
constexpr size_t WS_KC = WS_CFOX + 1 * MiB;
constexpr size_t WS_VC = WS_KC + 1 * MiB;
constexpr size_t WS_O16 = WS_VC + 1 * MiB;
constexpr size_t WS_H16B = WS_O16 + 64 * MiB;
constexpr size_t WS_END = WS_H16B + 64 * MiB;
static_assert(WS_SV + 16 * MiB == WS_PROJ + 176 * MiB, "proj map");
static_assert((size_t)T * DFF * 2 == 176 * MiB, "act overlay");

__device__ __forceinline__ float wave_sum(float v) {
#pragma unroll
    for (int o = 1; o < 64; o <<= 1) v += __shfl_xor(v, o);
    return v;
}

typedef unsigned short u16;
#define GAS __attribute__((address_space(1)))
#define LAS __attribute__((address_space(3)))
template <int M> __device__ __forceinline__ float lx(float v) {
    static_assert(M >= 1 && M <= 16, "lx"); return __int_as_float(__builtin_amdgcn_ds_swizzle(__float_as_int(v), (M << 10) | 0x1F)); }
template <int M> __device__ __forceinline__ unsigned lxu(unsigned v) { return (unsigned)__builtin_amdgcn_ds_swizzle((int)v, (M << 10) | 0x1F); }
__device__ __forceinline__ float pair_sum(float v) { const unsigned u = __float_as_uint(v); const auto r = __builtin_amdgcn_permlane32_swap(u, u, false, false); return __uint_as_float(r[0]) + __uint_as_float(r[1]); }
__device__ __forceinline__ float pair_max(float v) { const unsigned u = __float_as_uint(v); const auto r = __builtin_amdgcn_permlane32_swap(u, u, false, false); return fmaxf(__uint_as_float(r[0]), __uint_as_float(r[1])); }
__device__ __forceinline__ float pair_other(float v, int hi) { const unsigned u = __float_as_uint(v); const auto r = __builtin_amdgcn_permlane32_swap(u, u, false, false); return __uint_as_float(hi ? r[0] : r[1]); }
__device__ __forceinline__ float wsum64(float v) { v += lx<1>(v); v += lx<2>(v); v += lx<4>(v); v += lx<8>(v); v += lx<16>(v); return pair_sum(v); }
__device__ __forceinline__ int lane_id_fresh() { int l; asm volatile("v_mbcnt_lo_u32_b32 %0, -1, 0\n\tv_mbcnt_hi_u32_b32 %0, -1, %0" : "=v"(l)); return l; }

namespace pg8 {
#define PG8_LAS __attribute__((address_space(3)))
typedef unsigned short bf16_t;
typedef _Float16 bf16x8 __attribute__((ext_vector_type(8)));
typedef float f32x4 __attribute__((ext_vector_type(4)));
typedef unsigned u32x4 __attribute__((ext_vector_type(4)));
constexpr int BM = 256, BK = 64, HALF = 128, HTB = HALF * BK * 2  , STAGE_BYTES = 8 * HTB, NXCD = 8, WGM = 8;

__host__ __device__ __forceinline__ int lds_byte(int r, int c) { const int st = (r >> 4) * 2 + (c >> 5), rr = r & 15, cc = c & 31, ob = rr * 64 + cc * 2; return st * 1024 + (ob ^ (((ob >> 9) & 1) << 5)); }
__host__ __device__ __forceinline__ void stage_rc(int b, int& R, int& C) { const int st = b / 1024, sb = b % 1024, swz = sb ^ (((sb >> 9) & 1) << 5); R = (st >> 1) * 16 + swz / 64; C = (st & 1) * 32 + (swz % 64) / 2; }
__host__ __device__ __forceinline__ int perm32(int rho) { const int n = rho >> 4, i = rho & 15; return 8 * (i >> 2) + 4 * n + (i & 3); }

struct Unit { int pm, pn; };
struct Gemm { const bf16_t* A; const bf16_t* Bt; int M, N, K; };

struct StaticOrder {
    int nM, nN, nwg, G, c;
    __host__ __device__ void init(int M, int N, int G_, int c_) { nM = M / BM; nN = N / BM; nwg = nM * nN; G = G_; c = c_; }
    __host__ __device__ bool next(int i, Unit& u) const {
        const long L = (long)i * G + c; if (L >= nwg) return false;
        int wgid = (int)L; { const int q = nwg / NXCD, r = nwg % NXCD, xcd = wgid % NXCD, off = wgid / NXCD; wgid = (xcd < r ? xcd * (q + 1) : r * (q + 1) + (xcd - r) * q) + off; }
        const int nig = WGM * nN, gid = wgid / nig, fm = gid * WGM, gsz = (nM - fm) < WGM ? (nM - fm) : WGM;
        u.pm = fm + ((wgid % nig) % gsz); u.pn = (wgid % nig) / gsz; return true;
    }
    __device__ __forceinline__ void a_ready(const Unit&) const {}
    __device__ __forceinline__ void done(const Unit&) const {}
};


typedef _Float16 h16x8 __attribute__((ext_vector_type(8)));
__device__ __forceinline__ float rstd_of(const float* ss, int row) { return __builtin_amdgcn_rsqf(((const GAS float*)ss)[row] * (1.f / 1024.f) + 1e-6f); }
__device__ __forceinline__ float fast_sigmoid(float x) { return __builtin_amdgcn_rcpf(1.f + __expf(-x)); }
__device__ unsigned pg8_sink_words[16 * 32];
__device__ __forceinline__ void pg8_pad16() {
#pragma unroll
    for (int i = 0; i < 16; ++i) ((GAS unsigned*)pg8_sink_words)[i * 32] = 0u; }
#define PG8_ACCV(ai, bj, m, j) (acc[ai][bj][m][(j) >> 2][(j) & 3])

__device__ __forceinline__ void pg8_rowsum_add(const float (&sq)[8], float* ssn, LAS float* xch, const Unit& u, int wr, int wc, int fr, int fq) {
    if (fq == 0) {
#pragma unroll
        for (int g = 0; g < 8; ++g) xch[((wr * 4 + wc) * 8 + g) * 16 + fr] = sq[g]; }
    asm volatile("s_waitcnt lgkmcnt(0)" ::: "memory"); __builtin_amdgcn_s_barrier(); asm volatile("" ::: "memory");
    if (fq < 2) { const int gg = 2 * wc + fq; float t = 0.f;
#pragma unroll
        for (int w = 0; w < 4; ++w) t += xch[((wr * 4 + w) * 8 + gg) * 16 + fr];
        __builtin_amdgcn_global_atomic_fadd_f32((GAS float*)(ssn + u.pm * BM + (gg >> 2) * HALF + wr * 64 + (gg & 3) * 16 + fr), t); }
}
struct EpiResid {
    static constexpr bool PERM = true, AFTER_DRAIN = false, IDEMPOTENT = false, NEEDS_ALIGN_EPI = true;
    bf16_t* h; float* ssn; LAS float* xch;
    __device__ __forceinline__ void operator()(const f32x4 (&acc)[2][2][4][2], const Unit& u, int wr, int wc, int fr, int fq) const {
        { int l_; asm volatile("v_mbcnt_lo_u32_b32 %0, -1, 0\n\tv_mbcnt_hi_u32_b32 %0, -1, %0" : "=v"(l_)); fr = l_ & 15; fq = l_ >> 4; }
        const int col0 = u.pn * BM + wc * 32 + 8 * fq;
        h16x8 hv[8][2];
#pragma unroll
        for (int g_ = 0; g_ < 8; ++g_) { const int row = u.pm * BM + (g_ >> 2) * HALF + wr * 64 + (g_ & 3) * 16 + fr;
#pragma unroll
            for (int bj = 0; bj < 2; ++bj) hv[g_][bj] = *(const GAS h16x8*)(h + (size_t)row * 1024 + col0 + bj * HALF); }
        float sq[8];
        asm volatile("" ::: "memory");
#pragma unroll
        for (int ai = 0; ai < 2; ++ai)
#pragma unroll
            for (int m = 0; m < 4; ++m) {
                const int row = u.pm * BM + ai * HALF + wr * 64 + m * 16 + fr; float s = 0.f;
#pragma unroll
                for (int bj = 0; bj < 2; ++bj) {
                    GAS h16x8* p = (GAS h16x8*)(h + (size_t)row * 1024 + col0 + bj * HALF); h16x8 o = hv[ai * 4 + m][bj];
#pragma unroll
                    for (int j = 0; j < 8; ++j) { const _Float16 r = (_Float16)((float)o[j] + PG8_ACCV(ai, bj, m, j)); o[j] = r; const float rf = (float)r; s += rf * rf; }
                    *p = o;
                }
                s += lx<16>(s); sq[ai * 4 + m] = pair_sum(s);
            }
        pg8_rowsum_add(sq, ssn, xch, u, wr, wc, fr, fq);
    }
};
struct EpiSwiglu {
    static constexpr bool PERM = true, AFTER_DRAIN = false, IDEMPOTENT = true, NEEDS_ALIGN_EPI = false;
    const float* ss; bf16_t* act;
    __device__ __forceinline__ void operator()(const f32x4 (&acc)[2][2][4][2], const Unit& u, int wr, int wc, int fr, int fq) const {
        { int l_; asm volatile("v_mbcnt_lo_u32_b32 %0, -1, 0\n\tv_mbcnt_hi_u32_b32 %0, -1, %0" : "=v"(l_)); fr = l_ & 15; fq = l_ >> 4; }
        const int col0 = u.pn * HALF + wc * 32 + 8 * fq;
        float rsv[8];
#pragma unroll
        for (int i = 0; i < 8; ++i) rsv[i] = ((const GAS float*)ss)[u.pm * BM + (i >> 2) * HALF + wr * 64 + (i & 3) * 16 + fr];
        asm volatile("" ::: "memory");
#pragma unroll
        for (int ai = 0; ai < 2; ++ai)
#pragma unroll
            for (int m = 0; m < 4; ++m) {
                const int row = u.pm * BM + ai * HALF + wr * 64 + m * 16 + fr; const float rstd = __builtin_amdgcn_rsqf(rsv[ai * 4 + m] * (1.f / 1024.f) + 1e-6f), r2 = rstd * rstd, rl = rstd * 1.4426950408889634f;
                h16x8 o;
                float ex[8], nu[8];
#pragma unroll
                for (int j = 0; j < 8; ++j) ex[j] = __builtin_amdgcn_exp2f(-(PG8_ACCV(ai, 0, m, j) * rl));
#pragma unroll
                for (int j = 0; j < 8; ++j) nu[j] = (PG8_ACCV(ai, 0, m, j) * r2) * PG8_ACCV(ai, 1, m, j);
#pragma unroll
                for (int j = 0; j < 8; ++j) ex[j] = __builtin_amdgcn_rcpf(1.f + ex[j]);
#pragma unroll
                for (int j = 0; j < 8; ++j) o[j] = (_Float16)(nu[j] * ex[j]);
                *(GAS h16x8*)(act + (size_t)row * 2816 + col0) = o;

            }
    }
};
struct EpiStore {
    static constexpr bool PERM = true, AFTER_DRAIN = false, IDEMPOTENT = true, NEEDS_ALIGN_EPI = false;
    bf16_t* o;
    __device__ __forceinline__ void operator()(const f32x4 (&acc)[2][2][4][2], const Unit& u, int wr, int wc, int fr, int fq) const {
        { int l_; asm volatile("v_mbcnt_lo_u32_b32 %0, -1, 0\n\tv_mbcnt_hi_u32_b32 %0, -1, %0" : "=v"(l_)); fr = l_ & 15; fq = l_ >> 4; }
        const int col0 = u.pn * BM + wc * 32 + 8 * fq;
#pragma unroll
        for (int ai = 0; ai < 2; ++ai)
#pragma unroll
            for (int m = 0; m < 4; ++m) {
                const int row = u.pm * BM + ai * HALF + wr * 64 + m * 16 + fr;
#pragma unroll
                for (int bj = 0; bj < 2; ++bj) { h16x8 v;
#pragma unroll
                    for (int j = 0; j < 8; ++j) v[j] = (_Float16)PG8_ACCV(ai, bj, m, j);
                    *(GAS h16x8*)(o + (size_t)row * 1024 + col0 + bj * HALF) = v; }
            }
    }
};
struct EpiPle {
    static constexpr bool PERM = true, AFTER_DRAIN = false, IDEMPOTENT = false, NEEDS_ALIGN_EPI = true;
    unsigned char* ws; int L; LAS float* xch;
    __device__ __forceinline__ void operator()(const f32x4 (&acc)[2][2][4][2], const Unit& u, int wr, int wc, int fr, int fq) const {
        { int l_; asm volatile("v_mbcnt_lo_u32_b32 %0, -1, 0\n\tv_mbcnt_hi_u32_b32 %0, -1, %0" : "=v"(l_)); fr = l_ & 15; fq = l_ >> 4; }
        const float* ss = (const float*)(ws + WS_SS) + (size_t)(3 * L + 2) * 32768; float* ssn = (float*)(ws + WS_SS) + (size_t)(3 * L + 3) * 32768;
        const bf16_t* pp = (const bf16_t*)(ws + WS_O16); const bf16_t* hin = (const bf16_t*)(ws + ((L & 1) ? WS_H16B : WS_H16)); bf16_t* hout = (bf16_t*)(ws + ((L & 1) ? WS_H16 : WS_H16B));
        const int col0 = u.pn * BM + wc * 32 + 8 * fq;
        float rsv[8];
#pragma unroll
        for (int i = 0; i < 8; ++i) rsv[i] = ((const GAS float*)ss)[u.pm * BM + (i >> 2) * HALF + wr * 64 + (i & 3) * 16 + fr];
        h16x8 so[8][2]; float sq[8];
#pragma unroll
        for (int ai = 0; ai < 2; ++ai) {
            h16x8 hv[4][2], pv[4][2];
#pragma unroll
            for (int m = 0; m < 4; ++m) { const int row = u.pm * BM + ai * HALF + wr * 64 + m * 16 + fr;
#pragma unroll
                for (int bj = 0; bj < 2; ++bj) { const size_t off = (size_t)row * 1024 + col0 + bj * HALF; hv[m][bj] = *(const GAS h16x8*)(hin + off); pv[m][bj] = *(const GAS h16x8*)(pp + off); } }
            asm volatile("" ::: "memory");
#pragma unroll
            for (int m = 0; m < 4; ++m) { const float rstd = __builtin_amdgcn_rsqf(rsv[ai * 4 + m] * (1.f / 1024.f) + 1e-6f); float s = 0.f;
#pragma unroll
                for (int bj = 0; bj < 2; ++bj) { h16x8 o;
#pragma unroll
                    for (int j = 0; j < 8; ++j) { const _Float16 r = (_Float16)((float)hv[m][bj][j] + (float)pv[m][bj][j] * fast_sigmoid(PG8_ACCV(ai, bj, m, j) * rstd)); o[j] = r; const float rf = (float)r; s += rf * rf; }
                    so[ai * 4 + m][bj] = o; }
                s += lx<16>(s); sq[ai * 4 + m] = pair_sum(s); }
            asm volatile("" ::: "memory");
        }
#pragma unroll
        for (int g_ = 0; g_ < 8; ++g_) { const int row = u.pm * BM + (g_ >> 2) * HALF + wr * 64 + (g_ & 3) * 16 + fr;
#pragma unroll
            for (int bj = 0; bj < 2; ++bj) *(GAS h16x8*)(hout + (size_t)row * 1024 + col0 + bj * HALF) = so[g_][bj];
        }
        pg8_rowsum_add(sq, ssn, xch, u, wr, wc, fr, fq);
    }
};
struct EpiPleFinal {
    static constexpr bool PERM = true, AFTER_DRAIN = false, IDEMPOTENT = false, NEEDS_ALIGN_EPI = true;
    unsigned char* ws; float* out; const float* gain; int L; LAS float* xch;
    __device__ __forceinline__ void operator()(const f32x4 (&acc)[2][2][4][2], const Unit& u, int wr, int wc, int fr, int fq) const {
        { int l_; asm volatile("v_mbcnt_lo_u32_b32 %0, -1, 0\n\tv_mbcnt_hi_u32_b32 %0, -1, %0" : "=v"(l_)); fr = l_ & 15; fq = l_ >> 4; }
        const float* ss = (const float*)(ws + WS_SS) + (size_t)(3 * L + 2) * 32768; float* ssn = (float*)(ws + WS_SS) + (size_t)(3 * L + 3) * 32768;
        const bf16_t* pp = (const bf16_t*)(ws + WS_O16); const bf16_t* hin = (const bf16_t*)(ws + ((L & 1) ? WS_H16B : WS_H16));
        unsigned* ctr = (unsigned*)(ws + WS_CTL) + 65536 + 64 * u.pm;
        const int col0 = u.pn * BM + wc * 32 + 8 * fq;
        float rsv[8];
#pragma unroll
        for (int i = 0; i < 8; ++i) rsv[i] = ((const GAS float*)ss)[u.pm * BM + (i >> 2) * HALF + wr * 64 + (i & 3) * 16 + fr];
        float res[8][2][8]; float sq[8];
#pragma unroll
        for (int ai = 0; ai < 2; ++ai) {
            h16x8 hv[4][2], pv[4][2];
#pragma unroll
            for (int m = 0; m < 4; ++m) { const int row = u.pm * BM + ai * HALF + wr * 64 + m * 16 + fr;
#pragma unroll
                for (int bj = 0; bj < 2; ++bj) { const size_t off = (size_t)row * 1024 + col0 + bj * HALF; hv[m][bj] = *(const GAS h16x8*)(hin + off); pv[m][bj] = *(const GAS h16x8*)(pp + off); } }
            asm volatile("" ::: "memory");
#pragma unroll
            for (int m = 0; m < 4; ++m) { const float rstd = __builtin_amdgcn_rsqf(rsv[ai * 4 + m] * (1.f / 1024.f) + 1e-6f); float s = 0.f;
#pragma unroll
                for (int bj = 0; bj < 2; ++bj)
#pragma unroll
                    for (int j = 0; j < 8; ++j) { const float r = (float)hv[m][bj][j] + (float)pv[m][bj][j] * fast_sigmoid(PG8_ACCV(ai, bj, m, j) * rstd); res[ai * 4 + m][bj][j] = r; s += r * r; }
                s += lx<16>(s); sq[ai * 4 + m] = pair_sum(s); }
            asm volatile("" ::: "memory");
        }
        pg8_rowsum_add(sq, ssn, xch, u, wr, wc, fr, fq);
        asm volatile("s_waitcnt vmcnt(0)" ::: "memory");
        if (fq == 0 && fr == 0) __hip_atomic_fetch_add(ctr, 1u, __ATOMIC_RELAXED, __HIP_MEMORY_SCOPE_AGENT);
        while (__hip_atomic_load(ctr, __ATOMIC_RELAXED, __HIP_MEMORY_SCOPE_AGENT) < 32u) __builtin_amdgcn_s_sleep(2);
        asm volatile("" ::: "memory");
        f32x4 gv[2][2];
#pragma unroll
        for (int bj = 0; bj < 2; ++bj) { gv[bj][0] = *(const GAS f32x4*)(gain + col0 + bj * HALF); gv[bj][1] = *(const GAS f32x4*)(gain + col0 + bj * HALF + 4); }
        float rf[8];
#pragma unroll
        for (int g_ = 0; g_ < 8; ++g_) rf[g_] = __hip_atomic_load(ssn + u.pm * BM + (g_ >> 2) * HALF + wr * 64 + (g_ & 3) * 16 + fr, __ATOMIC_RELAXED, __HIP_MEMORY_SCOPE_AGENT);
#pragma unroll
        for (int g_ = 0; g_ < 8; ++g_) { const int row = u.pm * BM + (g_ >> 2) * HALF + wr * 64 + (g_ & 3) * 16 + fr; const float rstd = __builtin_amdgcn_rsqf(rf[g_] * (1.f / 1024.f) + 1e-6f);
#pragma unroll
            for (int bj = 0; bj < 2; ++bj) { GAS f32x4* o = (GAS f32x4*)(out + (size_t)row * 1024 + col0 + bj * HALF); f32x4 a, b;
#pragma unroll
                for (int j = 0; j < 4; ++j) { a[j] = res[g_][bj][j] * rstd * gv[bj][0][j]; b[j] = res[g_][bj][4 + j] * rstd * gv[bj][1][j]; }
                o[0] = a; o[1] = b; } }
    }
};
struct EpiInProj {
    static constexpr bool PERM = true, AFTER_DRAIN = false, IDEMPOTENT = true, NEEDS_ALIGN_EPI = false;
    unsigned char* ws; int L;
    __device__ __forceinline__ void operator()(const f32x4 (&acc)[2][2][4][2], const Unit& u, int wr, int wc, int fr, int fq) const {
        { int l_; asm volatile("v_mbcnt_lo_u32_b32 %0, -1, 0\n\tv_mbcnt_hi_u32_b32 %0, -1, %0" : "=v"(l_)); fr = l_ & 15; fq = l_ >> 4; }
        const float* ss = (const float*)(ws + WS_SS) + (size_t)(3 * L) * 32768; const float2* rope = (const float2*)(ws + WS_ROPE);
        const float* b_gate = (const float*)(ws + WS_BIAS) + L * 32; const float* b_forget = b_gate + 24;
        bf16_t* const nq = (bf16_t*)(ws + WS_NQ); float* const gates = (float*)(ws + WS_GATES); float* const flog = (float*)(ws + WS_FLOG);
        const int slot = u.pn * 4 + wc;
        if (slot > 44) { pg8_pad16(); return; }
        bf16_t* base = nq; int nh = 8, hidx = slot; bool tokmajor = false, rope_on = false; float scale = 1.f;
        if (slot < 8) { tokmajor = true; rope_on = true; scale = 0.125f * 1.4426950408889634f; }
        else if (slot < 14) { const int t = slot - 8; base = (bf16_t*)(ws + (t < 2 ? WS_KC_IN : (t < 4 ? WS_KS : WS_KW))); nh = 2; hidx = t & 1; rope_on = true; }
        else if (slot < 20) { const int t = slot - 14; base = (bf16_t*)(ws + (t < 2 ? WS_VC_IN : (t < 4 ? WS_VS : WS_VW))); nh = 2; hidx = t & 1; }
        else if (slot < 44) { const int t = slot - 20, which = t >> 2; hidx = t & 3; nh = 4;
            base = (bf16_t*)(ws + WS_FQ + (size_t)which * (16u << 20));
            scale = which == 0 ? 0.125f * 1.4426950408889634f : (which == 3 ? 0.125f : 1.f); }
        float rsv[8];
#pragma unroll
        for (int i = 0; i < 8; ++i) rsv[i] = ((const GAS float*)ss)[u.pm * BM + (i >> 2) * HALF + wr * 64 + (i & 3) * 16 + fr];
        h16x8 so1[8], so2[8];
        f32x4 rb[2][4];
        const int rrow0 = u.pm * BM + wr * 64 + fr;
        f32x4 bg0 = {0.f, 0.f, 0.f, 0.f}, bg1 = bg0;
        if (slot == 44) { if (fq < 3) { bg0 = *(const GAS f32x4*)(b_gate + 8 * fq); bg1 = *(const GAS f32x4*)(b_gate + 8 * fq + 4); } else bg0 = *(const GAS f32x4*)b_forget; }
#pragma unroll
        for (int ai = 0; ai < 2; ++ai) {
#pragma unroll
            for (int m = 0; m < 4; ++m) {
                if (rope_on && (m & 1) == 0) {
#pragma unroll
                    for (int mm = m; mm < m + 2; ++mm) { const GAS f32x4* cs = (const GAS f32x4*)(rope + (size_t)(rrow0 + ai * HALF + mm * 16) * 32 + 8 * fq);
#pragma unroll
                        for (int jj = 0; jj < 4; ++jj) rb[mm & 1][jj] = cs[jj]; }
                    asm volatile("" ::: "memory"); }
                const int row = u.pm * BM + ai * HALF + wr * 64 + m * 16 + fr; const float rs = __builtin_amdgcn_rsqf(rsv[ai * 4 + m] * (1.f / 1024.f) + 1e-6f) * scale;
                const int b = row >> 12, s = row & 4095;
                constexpr int dummy_ = 0; (void)dummy_;
                const int g_ = ai * 4 + m;
                if (slot == 44) {
                    float v[8];
#pragma unroll
                    for (int j = 0; j < 8; ++j) v[j] = PG8_ACCV(ai, 0, m, j) * rs;
                    if (fq < 3) { const f32x4 b0 = bg0, b1 = bg1; f32x4 o0, o1;
#pragma unroll
                        for (int j = 0; j < 4; ++j) { o0[j] = fast_sigmoid(v[j] + b0[j]); o1[j] = fast_sigmoid(v[4 + j] + b1[j]); }
                        float* gp = gates + (size_t)row * 24 + 8 * fq; *(GAS f32x4*)gp = o0; *(GAS f32x4*)(gp + 4) = o1; }
                    else { const f32x4 bf = bg0; GAS float* fp = (GAS float*)(flog + (size_t)b * 4 * 4096 + s);
#pragma unroll
                        for (int j = 0; j < 4; ++j) { const float xx = v[j] + bf[j];
                            fp[(size_t)j * 4096] = fminf(xx, 0.f) - 0.6931471805599453f * __builtin_amdgcn_logf(1.f + __builtin_amdgcn_exp2f(-fabsf(xx) * 1.4426950408889634f)); } }
                    asm volatile("" ::: "memory");
                    continue;
                }
                float x1[8], x2[8];
#pragma unroll
                for (int j = 0; j < 8; ++j) { x1[j] = PG8_ACCV(ai, 0, m, j) * rs; x2[j] = PG8_ACCV(ai, 1, m, j) * rs; }
                if (rope_on) {
#pragma unroll
                    for (int jj = 0; jj < 4; ++jj) { const f32x4 t = rb[m & 1][jj];
                        { const float a = x1[2 * jj], bb = x2[2 * jj]; x1[2 * jj] = a * t[0] - bb * t[1]; x2[2 * jj] = bb * t[0] + a * t[1]; }
                        { const float a = x1[2 * jj + 1], bb = x2[2 * jj + 1]; x1[2 * jj + 1] = a * t[2] - bb * t[3]; x2[2 * jj + 1] = bb * t[2] + a * t[3]; } }
                }
#pragma unroll
                for (int j = 0; j < 8; ++j) { so1[g_][j] = (_Float16)x1[j]; so2[g_][j] = (_Float16)x2[j]; }
                if (m & 1) asm volatile("" ::: "memory");
            }
        }
        if (slot != 44) {
#pragma unroll
            for (int g_ = 0; g_ < 8; ++g_) {
                const int row = u.pm * BM + (g_ >> 2) * HALF + wr * 64 + (g_ & 3) * 16 + fr, b = row >> 12, s = row & 4095;
                bf16_t* dst = tokmajor ? base + ((size_t)row * 8 + hidx) * 64 : base + (((size_t)b * nh + hidx) * 4096 + s) * 64;
                *(GAS h16x8*)(dst + 8 * fq) = so1[g_]; *(GAS h16x8*)(dst + 32 + 8 * fq) = so2[g_]; }
        }
    }
};
#undef PG8_ACCV

template <class Epi, class Sched, bool ALIGN_EPI = false, bool SP2 = false>
__device__ __forceinline__ void gemm_phase(PG8_LAS unsigned char* lds, const Gemm g, const Sched& S, const Epi& E, const int wave_idx  ) {
    static_assert(ALIGN_EPI || !Epi::NEEDS_ALIGN_EPI, "this epilogue waits for other workgroups: all eight waves must enter it together");
    int lane_; asm volatile("v_mbcnt_lo_u32_b32 %0, -1, 0\n\tv_mbcnt_hi_u32_b32 %0, -1, %0" : "=v"(lane_));
    int wid_ = wave_idx; asm volatile("" : "+s"(wid_));
    const int wid = wid_, lane = lane_, tid = wid * 64 + lane, wr = wid >> 2, wc = wid & 3, fr = lane & 15, fq = lane >> 4;
    const int K = g.K, nt = K / BK;
    unsigned voffA[2], voffB[2];
#pragma unroll
    for (int i = 0; i < 2; ++i) { int R, C; stage_rc(tid * 16 + i * 8192, R, C); const int Rb = Epi::PERM ? ((R & ~31) + perm32(R & 31)) : R;
        voffA[i] = (unsigned)(R * K + C) * 2u; voffB[i] = (unsigned)(Rb * K + C) * 2u; }
    const size_t kstep = (size_t)(BK * 2);
    const size_t hstep = (size_t)HALF * K * 2;
    const size_t tstep = 2 * hstep;
    const unsigned ldsw = (unsigned)wid * 1024u;
    const int aoff = lds_byte(wr * 64 + fr, fq * 8), boff = lds_byte(wc * 32 + fr, fq * 8);
#define PG8_SA(b, h) (((b) * 2 + (h)) * HTB)
#define PG8_SB(b, h) ((4 + (b) * 2 + (h)) * HTB)
#define PG8_STAGE(bufoff, gbase, voff) do { _Pragma("unroll") for (int _i = 0; _i < 2; ++_i) \
        __builtin_amdgcn_global_load_lds((const unsigned*)((const char*)(gbase) + (voff)[_i]), (PG8_LAS unsigned*)(lds + (bufoff) + ldsw + _i * 8192), 16, 0, 0); } while (0)
#define PG8_LDA(dst, b, h) do { _Pragma("unroll") for (int m = 0; m < 4; ++m) _Pragma("unroll") for (int k = 0; k < 2; ++k) dst[m][k] = *(const PG8_LAS bf16x8*)(lds + PG8_SA(b, h) + aoff + m * 2048 + k * 1024); } while (0)
#define PG8_LDB(dst, b, h) do { _Pragma("unroll") for (int n = 0; n < 2; ++n) _Pragma("unroll") for (int k = 0; k < 2; ++k) dst[n][k] = *(const PG8_LAS bf16x8*)(lds + PG8_SB(b, h) + boff + n * 2048 + k * 1024); } while (0)
#define PG8_MMA(ai, bj, At, Bt) do { __builtin_amdgcn_s_setprio(1); _Pragma("unroll") for (int m = 0; m < 4; ++m) _Pragma("unroll") for (int n = 0; n < 2; ++n) _Pragma("unroll") for (int k = 0; k < 2; ++k) \
        acc[ai][bj][m][n] = __builtin_amdgcn_mfma_f32_16x16x32_f16(Bt[n][k], At[m][k], acc[ai][bj][m][n], 0, 0, 0); __builtin_amdgcn_s_setprio(0); } while (0)
#define PG8_WAIT_V(n) asm volatile("s_waitcnt vmcnt(" #n ")" ::: "memory")
#define PG8_WAIT_V8_OR_24(tt) asm volatile("s_waitcnt vmcnt(24)\n\ts_cmp_eq_u32 %0, 0\n\ts_cbranch_scc1 .Lpg8w%=\n\ts_waitcnt vmcnt(8)\n.Lpg8w%=:" :: "s"(tt) : "memory", "scc")
#define PG8_WAIT_L(n) asm volatile("s_waitcnt lgkmcnt(" #n ")" ::: "memory")
#define PG8_BAR __builtin_amdgcn_s_barrier()
#define PG8_SCHED __builtin_amdgcn_sched_barrier(0)
    Unit cur, nxt; int ui = 0;
    if (!S.next(0, cur)) return;
    __builtin_amdgcn_s_waitcnt(0x0F70);
    f32x4 acc[2][2][4][2];
#pragma unroll
    for (int a = 0; a < 2; ++a)
#pragma unroll
        for (int b = 0; b < 2; ++b)
#pragma unroll
            for (int m = 0; m < 4; ++m)
#pragma unroll
                for (int n = 0; n < 2; ++n) acc[a][b][m][n] = (f32x4){0.f, 0.f, 0.f, 0.f};
    bf16x8 At[4][2], B0[2][2], B1[2][2];
    const char* cA = (const char*)g.A + (size_t)cur.pm * tstep; const char* cB = (const char*)g.Bt + (size_t)cur.pn * tstep;
    S.a_ready(cur);
    if constexpr (SP2) {
        PG8_STAGE(PG8_SB(0, 0), cB, voffB); PG8_STAGE(PG8_SB(0, 1), cB + hstep, voffB); PG8_STAGE(PG8_SA(0, 0), cA, voffA); PG8_STAGE(PG8_SA(0, 1), cA + hstep, voffA);
        if (wr == 1) PG8_BAR;
        PG8_WAIT_V(2); PG8_BAR;
        PG8_STAGE(PG8_SB(1, 0), cB + kstep, voffB); PG8_STAGE(PG8_SA(1, 0), cA + kstep, voffA); PG8_STAGE(PG8_SB(1, 1), cB + hstep + kstep, voffB);
        PG8_WAIT_V(6); PG8_BAR;
    } else {
        PG8_STAGE(PG8_SB(0, 0), cB, voffB); PG8_STAGE(PG8_SA(0, 0), cA, voffA); PG8_STAGE(PG8_SB(0, 1), cB + hstep, voffB); PG8_STAGE(PG8_SA(0, 1), cA + hstep, voffA);
        if (wr == 1) PG8_BAR;
        PG8_WAIT_V(4); PG8_BAR;
        PG8_STAGE(PG8_SB(1, 0), cB + kstep, voffB); PG8_STAGE(PG8_SA(1, 0), cA + kstep, voffA); PG8_STAGE(PG8_SB(1, 1), cB + hstep + kstep, voffB);
        PG8_WAIT_V(6); PG8_BAR;
    }
    for (;;) {
        const bool has_next = S.next(ui + 1, nxt);
        const char* nA = has_next ? (const char*)g.A + (size_t)nxt.pm * tstep : cA; const char* nB = has_next ? (const char*)g.Bt + (size_t)nxt.pn * tstep : cB;
        for (int t = 0; t < nt; t += 2) {
            const bool last = (t == nt - 2);
            const char* a1 = cA + (size_t)(t + 1) * kstep;
            const char* a2 = last ? nA : cA + (size_t)(t + 2) * kstep; const char* b2 = last ? nB : cB + (size_t)(t + 2) * kstep;
            const char* a3 = a2 + kstep; const char* b3 = b2 + kstep;
            if (last && has_next) S.a_ready(nxt);
            if constexpr (SP2) {
            const int tw = __builtin_amdgcn_readfirstlane(t + (ui == 0 ? 1 : 0));
            PG8_LDB(B0, 0, 0); PG8_LDB(B1, 0, 1); PG8_SCHED; PG8_LDA(At, 0, 0); PG8_STAGE(PG8_SA(1, 1), a1 + hstep, voffA);
            PG8_WAIT_V8_OR_24(tw);
            PG8_WAIT_L(0); PG8_BAR; PG8_MMA(0, 0, At, B0); PG8_MMA(0, 1, At, B1); PG8_BAR; PG8_SCHED;
            PG8_LDA(At, 0, 1); PG8_STAGE(PG8_SB(0, 0), b2, voffB); PG8_STAGE(PG8_SB(0, 1), b2 + hstep, voffB); PG8_STAGE(PG8_SA(0, 0), a2, voffA);
            PG8_WAIT_V8_OR_24(tw);
            PG8_WAIT_L(0); PG8_BAR; PG8_MMA(1, 0, At, B0); PG8_MMA(1, 1, At, B1); PG8_BAR; PG8_SCHED;
            PG8_LDB(B0, 1, 0); PG8_LDB(B1, 1, 1); PG8_SCHED; PG8_LDA(At, 1, 0); PG8_STAGE(PG8_SA(0, 1), a2 + hstep, voffA);
            PG8_WAIT_V(8); PG8_WAIT_L(0); PG8_BAR; PG8_MMA(0, 0, At, B0); PG8_MMA(0, 1, At, B1); PG8_BAR; PG8_SCHED;
            PG8_LDA(At, 1, 1); PG8_STAGE(PG8_SB(1, 0), b3, voffB); PG8_STAGE(PG8_SB(1, 1), b3 + hstep, voffB); PG8_STAGE(PG8_SA(1, 0), a3, voffA);
            PG8_WAIT_V(8); PG8_WAIT_L(0); PG8_BAR; PG8_MMA(1, 0, At, B0); PG8_MMA(1, 1, At, B1); PG8_BAR; PG8_SCHED;
            } else {
            PG8_LDB(B0, 0, 0); PG8_SCHED; PG8_LDA(At, 0, 0); PG8_STAGE(PG8_SA(1, 1), a1 + hstep, voffA);
            PG8_WAIT_L(8); PG8_BAR; PG8_WAIT_L(0); PG8_MMA(0, 0, At, B0); PG8_BAR; PG8_SCHED;
            PG8_LDB(B1, 0, 1); PG8_STAGE(PG8_SB(0, 0), b2, voffB);
            PG8_BAR; PG8_WAIT_L(0); PG8_MMA(0, 1, At, B1); PG8_BAR;
            PG8_LDA(At, 0, 1); PG8_STAGE(PG8_SA(0, 0), a2, voffA);
            PG8_BAR; PG8_WAIT_L(0); PG8_MMA(1, 0, At, B0); PG8_BAR; PG8_SCHED;
            PG8_STAGE(PG8_SB(0, 1), b2 + hstep, voffB);
            PG8_WAIT_V(6); PG8_BAR; PG8_MMA(1, 1, At, B1); PG8_BAR;
            PG8_LDB(B0, 1, 0); PG8_SCHED; PG8_LDA(At, 1, 0); PG8_STAGE(PG8_SA(0, 1), a2 + hstep, voffA);
            PG8_WAIT_L(8); PG8_BAR; PG8_WAIT_L(0); PG8_MMA(0, 0, At, B0); PG8_BAR; PG8_SCHED;
            PG8_LDB(B1, 1, 1); PG8_STAGE(PG8_SB(1, 0), b3, voffB);
            PG8_BAR; PG8_WAIT_L(0); PG8_MMA(0, 1, At, B1); PG8_BAR;
            PG8_LDA(At, 1, 1); PG8_STAGE(PG8_SA(1, 0), a3, voffA);
            PG8_BAR; PG8_WAIT_L(0); PG8_MMA(1, 0, At, B0); PG8_BAR; PG8_SCHED;
            PG8_STAGE(PG8_SB(1, 1), b3 + hstep, voffB);
            PG8_WAIT_V(6); PG8_BAR; PG8_MMA(1, 1, At, B1); PG8_BAR;
            }
        }
        if constexpr (ALIGN_EPI) { if (wr == 0) PG8_BAR; }
        if constexpr (!Epi::AFTER_DRAIN) { E(acc, cur, wr, wc, fr, fq);
#if defined(PROBE_EPI)
            if constexpr (Epi::IDEMPOTENT) { asm volatile("" ::: "memory"); E(acc, cur, wr, wc, fr, fq); }
#endif
            S.done(cur); }
        if (!has_next) break;
#pragma unroll
        for (int a = 0; a < 2; ++a)
#pragma unroll
            for (int b = 0; b < 2; ++b)
#pragma unroll
                for (int m = 0; m < 4; ++m)
#pragma unroll
                    for (int n = 0; n < 2; ++n) acc[a][b][m][n] = (f32x4){0.f, 0.f, 0.f, 0.f};
        cur = nxt; cA = nA; cB = nB; ++ui;
        if constexpr (ALIGN_EPI) { if (wr == 1) PG8_BAR; }
    }
    PG8_WAIT_V(0);
    if constexpr (!ALIGN_EPI) { if (wr == 0) PG8_BAR; }
    PG8_BAR;
    if constexpr (Epi::AFTER_DRAIN) { E.fused(acc, cur, wr, wc, fr, fq, lds, wid, lane); S.done(cur); }
#undef PG8_SA
#undef PG8_SB
#undef PG8_STAGE
#undef PG8_LDA
#undef PG8_LDB
#undef PG8_MMA
#undef PG8_WAIT_V
#undef PG8_WAIT_V8_OR_24
#undef PG8_WAIT_L
#undef PG8_BAR
#undef PG8_SCHED
}
}

#define GAS __attribute__((address_space(1)))
#define LAS __attribute__((address_space(3)))
typedef unsigned v4u __attribute__((ext_vector_type(4)));
typedef GAS unsigned gu32;
typedef GAS unsigned long long gu64;
#define RLX_AGENT __ATOMIC_RELAXED, __HIP_MEMORY_SCOPE_AGENT
#define LDS_WAIT() asm volatile("s_waitcnt lgkmcnt(0)" ::: "memory")
#define VM_WAIT() asm volatile("s_waitcnt vmcnt(0)" ::: "memory")
__device__ __forceinline__ unsigned long long rt() { return __builtin_amdgcn_s_memrealtime(); }
__device__ __forceinline__ unsigned f2bf(float f) { unsigned u = __builtin_bit_cast(unsigned, f); return (u + 0x7fffu + ((u >> 16) & 1u)) >> 16; }
__device__ __forceinline__ unsigned pk2(float lo, float hi) { return f2bf(lo) | (f2bf(hi) << 16); }
#define XB_TMO      128
#define XB_XCNT(j)  (256  + 64 * (j))
#define XB_XSUB(j)  (1280 + 64 * (j))
#define XB_XGEN(j)  (2304 + 64 * (j))
#define XB_TOP      3328
#define XB_TOPGEN   3392
#define XCD_BAR_WORDS 3456
#define XB_SPIN_CAP (1u << 18)

__device__ __forceinline__ unsigned xb_ld(unsigned* p)              { return __hip_atomic_load(p, __ATOMIC_RELAXED, __HIP_MEMORY_SCOPE_AGENT); }
__device__ __forceinline__ unsigned xb_add(unsigned* p, unsigned v) { return __hip_atomic_fetch_add(p, v, __ATOMIC_RELAXED, __HIP_MEMORY_SCOPE_AGENT); }
__device__ __forceinline__ unsigned xb_xcc_id() { return (unsigned)__builtin_amdgcn_s_getreg((3 << 11) | 20) & 0xFu; }
#define XB_SPIN(cond, bar) do { unsigned _sp = 0; while (cond) { __builtin_amdgcn_s_sleep(1); \
    if ((++_sp & 255u) == 0u) { if (xb_ld(&(bar)[XB_TMO])) break; if (_sp > XB_SPIN_CAP) { atomicAdd(&(bar)[XB_TMO], 1u); break; } } } } while (0)

struct XcdBarrier {
    unsigned* bar; unsigned x;
    volatile LAS unsigned* st;
};

__device__ __forceinline__ XcdBarrier xcd_barrier_post(unsigned* bar, volatile LAS unsigned* st) {
    XcdBarrier b; b.bar = bar; b.x = xb_xcc_id(); b.st = st;
    if (threadIdx.x == 0) (void)xb_add(&bar[XB_XCNT(b.x)], 1u);
    return b;
}
__device__ __forceinline__ void xcd_barrier_complete(unsigned* bar, unsigned x, unsigned& nloc, unsigned& nx) {
    const unsigned G = gridDim.x * gridDim.y * gridDim.z;
    unsigned sum, cnt, mine, sp = 0u;
    for (;;) {
        sum = 0u; cnt = 0u; mine = 0u;
#pragma unroll
        for (unsigned j = 0; j < 16; ++j) { const unsigned c = xb_ld(&bar[XB_XCNT(j)]); sum += c; cnt += (c > 0u) ? 1u : 0u; mine = (j == x) ? c : mine; }
        if (sum == G) break;
        __builtin_amdgcn_s_sleep(1);
        if ((++sp & 255u) == 0u) { if (xb_ld(&bar[XB_TMO])) break; if (sp > XB_SPIN_CAP) { atomicAdd(&bar[XB_TMO], 1u); break; } }
    }
    nloc = mine > 0u ? mine : 1u; nx = cnt > 0u ? cnt : 1u;
}

__device__ __forceinline__ void xcd_barrier(const XcdBarrier& b, const bool is_thread0  ) {
    asm volatile("s_waitcnt vmcnt(0)" ::: "memory");
    __syncthreads();
    if (is_thread0) {
        unsigned* bar = b.bar;
        __builtin_amdgcn_s_waitcnt(0);
        unsigned nloc = b.st[0], nx = b.st[1];
        if (nloc == 0u) { xcd_barrier_complete(bar, b.x, nloc, nx); b.st[0] = nloc; b.st[1] = nx; }
        const unsigned old = xb_add(&bar[XB_XSUB(b.x)], 1u);
        const unsigned gen = old / nloc;
        if (old + 1u == (gen + 1u) * nloc) {
            __builtin_amdgcn_fence(__ATOMIC_RELEASE, "agent");
            asm volatile("s_waitcnt vmcnt(0)" ::: "memory");
            const unsigned og = xb_add(&bar[XB_TOP], 1u);
            const unsigned tg = og / nx;
            if (og + 1u == (tg + 1u) * nx) xb_add(&bar[XB_TOPGEN], 1u);
            else XB_SPIN(xb_ld(&bar[XB_TOPGEN]) == tg, bar);
            __builtin_amdgcn_fence(__ATOMIC_ACQUIRE, "agent");
            xb_add(&bar[XB_XGEN(b.x)], 1u);
            asm volatile("s_waitcnt vmcnt(0)" ::: "memory");
        } else {
            XB_SPIN(xb_ld(&bar[XB_XGEN(b.x)]) == gen, bar);
            __builtin_amdgcn_fence(__ATOMIC_ACQUIRE, "agent");
            asm volatile("s_waitcnt vmcnt(0)" ::: "memory");
        }
    }
    __syncthreads();
}


namespace att {
typedef _Float16 h8 __attribute__((ext_vector_type(8)));
typedef _Float16 h4 __attribute__((ext_vector_type(4)));
typedef float f16v __attribute__((ext_vector_type(16)));
typedef short s16x4 __attribute__((ext_vector_type(4)));
#define ATT_ZERO16 {0.f,0.f,0.f,0.f,0.f,0.f,0.f,0.f,0.f,0.f,0.f,0.f,0.f,0.f,0.f,0.f}
constexpr float NEG_BIG = -1e30f;
__device__ __forceinline__ float lz_() { float z = 0.f; asm volatile("" : "+v"(z)); return z; }
#define ATT_Z16() att::splat16(att::lz_())
constexpr int KT_BYTES = 8192;
constexpr int L_K = 0, L_V = 4 * KT_BYTES, L_C = 8 * KT_BYTES,
              L_FLAG = L_C + 1024, L_SLOT = L_FLAG + 64, L_PM = L_C + 1024 + 4096  , L_IMP = L_SLOT + 64, L_MASK = L_IMP + 64 * 65 * 4, L_CALL = L_MASK + 64 * 8, L_OT = L_CALL  , L_END = L_OT + 32 * 512 * 4;
static_assert(L_END <= 153600, "attention LDS map");
__device__ __forceinline__ f16v splat16(float z) { return (f16v){z,z,z,z,z,z,z,z,z,z,z,z,z,z,z,z}; }
__device__ __forceinline__ int crow(int r, int hi) { return (r & 3) + 8 * (r >> 2) + 4 * hi; }

typedef unsigned u4v __attribute__((ext_vector_type(4)));
struct TileRegs { u4v k, v; };
__device__ __forceinline__ void tile_load(TileRegs& r, const u16* Kg, const u16* Vg, int tid) { r.k = ((const GAS u4v*)Kg)[tid]; r.v = ((const GAS u4v*)Vg)[tid]; }
__device__ __forceinline__ void tile_store(const TileRegs& r, LAS unsigned char* bufK, LAS unsigned char* bufV, int tid) {
    const int key = tid >> 3, c = tid & 7;
    *(LAS u4v*)(bufK + key * 128 + ((c ^ ((key >> 1) & 7)) << 4)) = r.k;
    *(LAS u4v*)(bufV + key * 128 + ((c * 16) ^ (((key >> 1) & 1) << 6))) = r.v;
}
__device__ __forceinline__ void qk(f16v& p0, f16v& p1, const LAS unsigned char* bufK, const h8 (&q)[4], int r32, int hi) {
    const LAS unsigned char* kp = bufK + r32 * 128; const int sw = (r32 >> 1) & 7;
    h8 a0[4], a1[4];
#pragma unroll
    for (int d0 = 0; d0 < 4; ++d0) { const int off = ((2 * d0 + hi) ^ sw) << 4; a0[d0] = *(const LAS h8*)(kp + off); a1[d0] = *(const LAS h8*)(kp + 32 * 128 + off); }
    asm volatile("" : "+v"(a0[0]), "+v"(a0[1]), "+v"(a0[2]), "+v"(a0[3]), "+v"(a1[0]), "+v"(a1[1]), "+v"(a1[2]), "+v"(a1[3]));
#pragma unroll
    for (int d0 = 0; d0 < 4; ++d0) { p0 = __builtin_amdgcn_mfma_f32_32x32x16_f16(a0[d0], q[d0], p0, 0, 0, 0); p1 = __builtin_amdgcn_mfma_f32_32x32x16_f16(a1[d0], q[d0], p1, 0, 0, 0); }
}
__device__ __forceinline__ h4 tr_read(const LAS unsigned char* p) { return __builtin_bit_cast(h4, __builtin_amdgcn_ds_read_tr16_b64_v4i16((LAS s16x4*)p)); }
__device__ __forceinline__ void pv(f16v (&o)[2], const LAS unsigned char* bufV, const h8 (&pf)[4], int lane) {
    const int li = lane & 15, g = lane >> 4, hi = g >> 1;
    const int rowA = 4 * hi + (li >> 2);
    const int colb = (16 * (g & 1) + 4 * (li & 3)) * 2;
    const LAS unsigned char* base = bufV + rowA * 128;
    const int x = ((rowA >> 1) & 1) << 6;
#pragma unroll
    for (int dh = 0; dh < 2; ++dh) {
        h8 vf[4];
#pragma unroll
        for (int s = 0; s < 4; ++s) {
            const LAS unsigned char* a = base + s * 16 * 128 + ((colb + 64 * dh) ^ x);
            const h4 lo = tr_read(a), hi4 = tr_read(a + 8 * 128);
            vf[s] = (h8){lo[0], lo[1], lo[2], lo[3], hi4[0], hi4[1], hi4[2], hi4[3]};
        }
        asm volatile("" : "+v"(vf[0]), "+v"(vf[1]), "+v"(vf[2]), "+v"(vf[3]));
#pragma unroll
        for (int s = 0; s < 4; ++s) o[dh] = __builtin_amdgcn_mfma_f32_32x32x16_f16(vf[s], pf[s], o[dh], 0, 0, 0);
    }
}
typedef __fp16 fp16x2_t __attribute__((ext_vector_type(2)));
__device__ __forceinline__ void pack_p(h8 (&pf)[4], const f16v& p0, const f16v& p1) {
    typedef unsigned u4_ __attribute__((ext_vector_type(4)));
#pragma unroll
    for (int s = 0; s < 2; ++s) { u4_ a, b;
#pragma unroll
        for (int j = 0; j < 4; ++j) { a[j] = __builtin_bit_cast(unsigned, __builtin_amdgcn_cvt_pkrtz(p0[8 * s + 2 * j], p0[8 * s + 2 * j + 1])); b[j] = __builtin_bit_cast(unsigned, __builtin_amdgcn_cvt_pkrtz(p1[8 * s + 2 * j], p1[8 * s + 2 * j + 1])); }
        pf[s] = __builtin_bit_cast(h8, a); pf[2 + s] = __builtin_bit_cast(h8, b); }
}
constexpr float SM_THR = 8.f;
__device__ __forceinline__ float sm_ref(float m) { return m == NEG_BIG ? 0.f : m; }
template <bool NEGM = false>
__device__ __forceinline__ void softmax_step(f16v& p0, f16v& p1, float& m, float& l, f16v (&o)[2], f16v* negm = nullptr) {
    float mx = fmaxf(p0[0], p1[0]);
#pragma unroll
    for (int r = 1; r < 16; ++r) mx = fmaxf(fmaxf(mx, p0[r]), p1[r]);
    mx = pair_max(mx);
    const bool first = (m == NEG_BIG) && (mx != -INFINITY);
    const bool move = first || (mx > SM_THR);
    if (__any(move)) {
        const float d = move ? mx : 0.f, alpha = first ? 1.f : __builtin_amdgcn_exp2f(-d);
        if (move) m = sm_ref(m) + d;
        l *= alpha;
#pragma unroll
        for (int r = 0; r < 16; ++r) { o[0][r] *= alpha; o[1][r] *= alpha; p0[r] -= d; p1[r] -= d; }
        if constexpr (NEGM) { const float nm = -sm_ref(m);
#pragma unroll
            for (int r = 0; r < 16; ++r) (*negm)[r] = nm; }
    }
    typedef float f2_ __attribute__((ext_vector_type(2)));
    f2_ ls = {0.f, 0.f};
#pragma unroll
    for (int r = 0; r < 16; r += 2) { p0[r] = __builtin_amdgcn_exp2f(p0[r]); p0[r + 1] = __builtin_amdgcn_exp2f(p0[r + 1]); p1[r] = __builtin_amdgcn_exp2f(p1[r]); p1[r + 1] = __builtin_amdgcn_exp2f(p1[r + 1]);
        ls += (f2_){p0[r], p0[r + 1]} + (f2_){p1[r], p1[r + 1]}; }
    l += ls[0] + ls[1];
}
template <class RowPtr>
__device__ __forceinline__ void norm_store(const f16v (&o)[2], const RowPtr& rowp, LAS unsigned char* stage, int lane) {
    const int r32 = lane & 31, hi = lane >> 5;
    float ss = 0.f;
#pragma unroll
    for (int r = 0; r < 16; ++r) ss += o[0][r] * o[0][r] + o[1][r] * o[1][r];
    ss = pair_sum(ss);
    const float rs = rsqrtf(ss * (1.f / 64.f) + 1e-6f);
#pragma unroll
    for (int dh = 0; dh < 2; ++dh)
#pragma unroll
        for (int g = 0; g < 4; ++g) { const h4 v = {(_Float16)(o[dh][4 * g] * rs), (_Float16)(o[dh][4 * g + 1] * rs), (_Float16)(o[dh][4 * g + 2] * rs), (_Float16)(o[dh][4 * g + 3] * rs)};
            *(LAS h4*)(stage + r32 * 136 + (32 * dh + 8 * g + 4 * hi) * 2) = v; }
    asm volatile("s_waitcnt lgkmcnt(0)" ::: "memory");
    const int c = lane & 7;
#pragma unroll
    for (int j = 0; j < 4; ++j) { const int row = (lane >> 3) + 8 * j; const LAS unsigned char* sp = stage + row * 136 + c * 16;
        const h4 lo = *(const LAS h4*)sp, hi4 = *(const LAS h4*)(sp + 8);
        const h8 v = {lo[0], lo[1], lo[2], lo[3], hi4[0], hi4[1], hi4[2], hi4[3]};
        *(GAS h8*)(rowp(row) + 8 * c) = v; }
    asm volatile("s_waitcnt lgkmcnt(0)" ::: "memory");
}
__device__ __forceinline__ int fetch_unit(gu32* head, volatile LAS unsigned* slot, bool leader) {
    if (leader) *slot = __hip_atomic_fetch_add(head, 1u, __ATOMIC_RELAXED, __HIP_MEMORY_SCOPE_AGENT);
    __syncthreads(); const int u = (int)*slot; __syncthreads(); return u;
}

template <int DEPTH, class Body>
__device__ __forceinline__ void tile_walk(const u16* Kg, const u16* Vg, int kt0, int kt1, LAS unsigned char* lds, int tid, const Body& body) {
    if (kt0 >= kt1) return;
    if constexpr (DEPTH == 2) {
        TileRegs rA, rB;
        tile_load(rA, Kg + (size_t)kt0 * 4096, Vg + (size_t)kt0 * 4096, tid);
        if (kt0 + 1 < kt1) tile_load(rB, Kg + (size_t)(kt0 + 1) * 4096, Vg + (size_t)(kt0 + 1) * 4096, tid);
        tile_store(rA, lds + L_K, lds + L_V, tid);
        if (kt0 + 2 < kt1) tile_load(rA, Kg + (size_t)(kt0 + 2) * 4096, Vg + (size_t)(kt0 + 2) * 4096, tid);
        __syncthreads();
        int kt = kt0;
        for (;;) {
            body(kt, lds + L_K, lds + L_V);
            if (kt + 1 < kt1) tile_store(rB, lds + L_K + KT_BYTES, lds + L_V + KT_BYTES, tid);
            if (kt + 3 < kt1) tile_load(rB, Kg + (size_t)(kt + 3) * 4096, Vg + (size_t)(kt + 3) * 4096, tid);
            __syncthreads();
            if (++kt >= kt1) break;
            body(kt, lds + L_K + KT_BYTES, lds + L_V + KT_BYTES);
            if (kt + 1 < kt1) tile_store(rA, lds + L_K, lds + L_V, tid);
            if (kt + 3 < kt1) tile_load(rA, Kg + (size_t)(kt + 3) * 4096, Vg + (size_t)(kt + 3) * 4096, tid);
            __syncthreads();
            if (++kt >= kt1) break;
        }
    } else {
        TileRegs tr;
        tile_load(tr, Kg + (size_t)kt0 * 4096, Vg + (size_t)kt0 * 4096, tid);
        tile_store(tr, lds + L_K, lds + L_V, tid);
        __syncthreads();
        int it = 0;
        for (int kt = kt0; kt < kt1; ++kt, ++it) {
            const int cur = it & 1, nxt = cur ^ 1; const bool more = kt + 1 < kt1;
            if (more) tile_load(tr, Kg + (size_t)(kt + 1) * 4096, Vg + (size_t)(kt + 1) * 4096, tid);
            body(kt, lds + L_K + cur * KT_BYTES, lds + L_V + cur * KT_BYTES);
            if (more) tile_store(tr, lds + L_K + nxt * KT_BYTES, lds + L_V + nxt * KT_BYTES, tid);
            __syncthreads();
        }
    }
}

template <class Src, class Body>
__device__ __forceinline__ void tile_walk_src(int n, LAS unsigned char* lds, int tid, const Src& src, const Body& body) {
    if (n <= 0) return;
    TileRegs tr; const u16* Kp; const u16* Vp;
    src(0, Kp, Vp); tile_load(tr, Kp, Vp, tid);
    tile_store(tr, lds + L_K, lds + L_V, tid);
    __syncthreads();
    for (int v = 0; v < n; ++v) {
        const int cur = v & 1, nxt = cur ^ 1; const bool more = v + 1 < n;
        if (more) { src(v + 1, Kp, Vp); tile_load(tr, Kp, Vp, tid); }
        body(v, lds + L_K + cur * KT_BYTES, lds + L_V + cur * KT_BYTES);
        if (more) tile_store(tr, lds + L_K + nxt * KT_BYTES, lds + L_V + nxt * KT_BYTES, tid);
        __syncthreads();
    }
}

template <class Body>
__device__ __forceinline__ void tile_walk_pair(const u16* Kg, const u16* Vg, int kt0, int kt1, LAS unsigned char* lds, int tid, const Body& body) {
    if (kt0 >= kt1) return;
    TileRegs ra, rb;
    tile_load(ra, Kg + (size_t)kt0 * 4096, Vg + (size_t)kt0 * 4096, tid);
    if (kt0 + 1 < kt1) tile_load(rb, Kg + (size_t)(kt0 + 1) * 4096, Vg + (size_t)(kt0 + 1) * 4096, tid);
    tile_store(ra, lds + L_K, lds + L_V, tid);
    if (kt0 + 1 < kt1) tile_store(rb, lds + L_K + KT_BYTES, lds + L_V + KT_BYTES, tid);
    __syncthreads();
    int it = 0;
    for (int kt = kt0; kt < kt1; kt += 2, ++it) {
        const int cb = (it & 1) * 2 * KT_BYTES, nb = cb ^ (2 * KT_BYTES); const bool m1 = kt + 2 < kt1, m2 = kt + 3 < kt1;
        if (m1) tile_load(ra, Kg + (size_t)(kt + 2) * 4096, Vg + (size_t)(kt + 2) * 4096, tid);
        if (m2) tile_load(rb, Kg + (size_t)(kt + 3) * 4096, Vg + (size_t)(kt + 3) * 4096, tid);
        body(kt, lds + L_K + cb, lds + L_V + cb);
        if (kt + 1 < kt1) body(kt + 1, lds + L_K + cb + KT_BYTES, lds + L_V + cb + KT_BYTES);
        if (m1) tile_store(ra, lds + L_K + nb, lds + L_V + nb, tid);
        if (m2) tile_store(rb, lds + L_K + nb + KT_BYTES, lds + L_V + nb + KT_BYTES, tid);
        __syncthreads();
    }
}

template <class Body2>
__device__ __forceinline__ void tile_walk_pair2(const u16* Kg, const u16* Vg, int kt0, int kt1, LAS unsigned char* lds, int tid, const Body2& body2) {
    if (kt0 >= kt1) return;
    TileRegs ra, rb;
    tile_load(ra, Kg + (size_t)kt0 * 4096, Vg + (size_t)kt0 * 4096, tid);
    if (kt0 + 1 < kt1) tile_load(rb, Kg + (size_t)(kt0 + 1) * 4096, Vg + (size_t)(kt0 + 1) * 4096, tid);
    tile_store(ra, lds + L_K, lds + L_V, tid);
    if (kt0 + 1 < kt1) tile_store(rb, lds + L_K + KT_BYTES, lds + L_V + KT_BYTES, tid);
    __syncthreads();
    int it = 0;
    for (int kt = kt0; kt < kt1; kt += 2, ++it) {
        const int cb = (it & 1) * 2 * KT_BYTES, nb = cb ^ (2 * KT_BYTES); const bool m1 = kt + 2 < kt1, m2 = kt + 3 < kt1;
        if (m1) tile_load(ra, Kg + (size_t)(kt + 2) * 4096, Vg + (size_t)(kt + 2) * 4096, tid);
        if (m2) tile_load(rb, Kg + (size_t)(kt + 3) * 4096, Vg + (size_t)(kt + 3) * 4096, tid);
        body2(kt, kt + 1 < kt1, lds + L_K + cb, lds + L_V + cb, lds + L_K + cb + KT_BYTES, lds + L_V + cb + KT_BYTES);
        if (m1) tile_store(ra, lds + L_K + nb, lds + L_V + nb, tid);
        if (m2) tile_store(rb, lds + L_K + nb + KT_BYTES, lds + L_V + nb + KT_BYTES, tid);
        __syncthreads();
    }
}
template <class Mask>
__device__ __forceinline__ void attn_two(int kta, int ktb, const LAS unsigned char* bKa, const LAS unsigned char* bVa, const LAS unsigned char* bKb, const LAS unsigned char* bVb,
                                         const h8 (&q)[4], float& m, float& l, f16v (&o)[2], int r32, int hi, int lane, const Mask& mask) {
    const float ref0 = sm_ref(m), ci = -ref0;
    f16v a0 = splat16(ci), a1 = a0, b0 = a0, b1 = a0;
    qk(a0, a1, bKa, q, r32, hi);
    qk(b0, b1, bKb, q, r32, hi);
    mask(kta, a0, a1);
    softmax_step(a0, a1, m, l, o);
    { h8 pf[4]; pack_p(pf, a0, a1); pv(o, bVa, pf, lane); }
    const float dref = sm_ref(m) - ref0;
    if (__any(dref != 0.f)) {
#pragma unroll
        for (int r = 0; r < 16; ++r) { b0[r] -= dref; b1[r] -= dref; } }
    mask(ktb, b0, b1);
    softmax_step(b0, b1, m, l, o);
    { h8 pf[4]; pack_p(pf, b0, b1); pv(o, bVb, pf, lane); }
}
template <class Mask>
__device__ __forceinline__ void attn_one(int kt, const LAS unsigned char* bK, const LAS unsigned char* bV, const h8 (&q)[4], float& m, float& l, f16v (&o)[2], int r32, int hi, int lane, const Mask& mask) {
    const float ci = -sm_ref(m); f16v p0 = splat16(ci), p1 = p0; qk(p0, p1, bK, q, r32, hi);
    mask(kt, p0, p1);
    softmax_step(p0, p1, m, l, o);
    h8 pf[4]; pack_p(pf, p0, p1); pv(o, bV, pf, lane);
}

#define SBAR() __builtin_amdgcn_sched_barrier(0)
#define PIN(x) asm volatile("" : "+v"(x))
typedef unsigned u4w __attribute__((ext_vector_type(4)));
__device__ __forceinline__ unsigned pk2h(float a, float b) { return __builtin_bit_cast(unsigned, __builtin_amdgcn_cvt_pkrtz(a, b)); }
__device__ __forceinline__ bool sm_decide(f16v& C0, f16v& C1, float& m, float& l, float& alpha) {
    float mx = fmaxf(C0[0], C1[0]);
#pragma unroll
    for (int r = 1; r < 16; ++r) mx = fmaxf(fmaxf(mx, C0[r]), C1[r]);
    mx = pair_max(mx);
    const bool first = (m == NEG_BIG) && (mx != -INFINITY);
    const bool move = first || (mx > SM_THR);
    alpha = 1.f;
    if (__any(move)) {
        const float d = move ? mx : 0.f; alpha = first ? 1.f : __builtin_amdgcn_exp2f(-d);
        if (move) m = sm_ref(m) + d;
        l *= alpha;
#pragma unroll
        for (int r = 0; r < 16; ++r) { C0[r] -= d; C1[r] -= d; }
        return true;
    }
    return false;
}
#define PIPE_MF(a, b, c) __builtin_amdgcn_mfma_f32_32x32x16_f16(a, b, c, 0, 0, 0)
#define PIPE_KADDR(kslot, i) ((kslot) + r32 * 128 + ((i) & 1) * 4096 + ((((i) & ~1) + hi) ^ ((r32 >> 1) & 7)) * 16)
template <class CInit, class Mask>
__device__ __forceinline__ void pipe_step(f16v& C0, f16v& C1, const f16v& P0, const f16v& P1, const h8 (&q)[4], float& m, float& l, f16v (&o)[2],
                                          const LAS unsigned char* kcur, const LAS unsigned char* vprev, int kt, int r32, int hi, int lane, const CInit& cinit, const Mask& mask) {
    const int li = lane & 15, g = lane >> 4, rowA = 4 * hi + (li >> 2), colb = (16 * (g & 1) + 4 * (li & 3)) * 2, x = ((rowA >> 1) & 1) << 6;
    const LAS unsigned char* vb = vprev + rowA * 128; const int c0 = colb ^ x, c1 = (colb + 64) ^ x;
    h8 vf[8], kf[8]; u4w pw0, pw1, pw2, pw3;
#define PIPE_VRD(f) do { const LAS unsigned char* a_ = vb + ((f) & 3) * 2048 + (((f) >> 2) ? c1 : c0); const h4 lo_ = tr_read(a_), hi_ = tr_read(a_ + 8 * 128); \
        vf[f] = (h8){lo_[0], lo_[1], lo_[2], lo_[3], hi_[0], hi_[1], hi_[2], hi_[3]}; } while (0)
#define PIPE_KRD(i) do { kf[i] = *(const LAS h8*)PIPE_KADDR(kcur, i); } while (0)
#define PIPE_GAPA(MF, A0, A1, A2, A3, W0, W1, PW) do { MF; sacc += A0; sacc += A1; sacc += A2; sacc += A3; PIN(sacc); W0; W1; PIN(PW); SBAR(); } while (0)
#define PIPE_GAPB(MF, X, B) do { MF; X[B] = __builtin_amdgcn_exp2f(X[B]); X[B + 1] = __builtin_amdgcn_exp2f(X[B + 1]); X[B + 2] = __builtin_amdgcn_exp2f(X[B + 2]); X[B + 3] = __builtin_amdgcn_exp2f(X[B + 3]); PIN(X); SBAR(); } while (0)
    PIPE_KRD(0); PIPE_KRD(1);
    f16v Ci0, Ci1; cinit(kt, Ci0, Ci1);
    SBAR();
    float sacc = P0[0] + P0[1];
    PIPE_KRD(2); PIPE_GAPA(C0 = PIPE_MF(kf[0], q[0], Ci0), P0[2], P0[3], P0[4], P0[5],     pw0[0] = pk2h(P0[0], P0[1]),   pw0[1] = pk2h(P0[2], P0[3]),   pw0);
    PIPE_KRD(3); PIPE_GAPA(C1 = PIPE_MF(kf[1], q[0], Ci1), P0[6], P0[7], P0[8], P0[9],     pw0[2] = pk2h(P0[4], P0[5]),   pw0[3] = pk2h(P0[6], P0[7]),   pw0);
    PIPE_KRD(4); PIPE_GAPA(C0 = PIPE_MF(kf[2], q[1], C0),  P0[10], P0[11], P0[12], P0[13], pw1[0] = pk2h(P0[8], P0[9]),   pw1[1] = pk2h(P0[10], P0[11]), pw1);
    PIPE_KRD(5); PIPE_GAPA(C1 = PIPE_MF(kf[3], q[1], C1),  P0[14], P0[15], P1[0], P1[1],   pw1[2] = pk2h(P0[12], P0[13]), pw1[3] = pk2h(P0[14], P0[15]), pw1);
    PIPE_KRD(6); PIPE_GAPA(C0 = PIPE_MF(kf[4], q[2], C0),  P1[2], P1[3], P1[4], P1[5],     pw2[0] = pk2h(P1[0], P1[1]),   pw2[1] = pk2h(P1[2], P1[3]),   pw2);
    PIPE_KRD(7); PIPE_GAPA(C1 = PIPE_MF(kf[5], q[2], C1),  P1[6], P1[7], P1[8], P1[9],     pw2[2] = pk2h(P1[4], P1[5]),   pw2[3] = pk2h(P1[6], P1[7]),   pw2);
    PIPE_GAPA(C0 = PIPE_MF(kf[6], q[3], C0),  P1[10], P1[11], P1[12], P1[13], pw3[0] = pk2h(P1[8], P1[9]),   pw3[1] = pk2h(P1[10], P1[11]), pw3);
    PIPE_GAPA(C1 = PIPE_MF(kf[7], q[3], C1),  P1[14], P1[15], 0.f, 0.f,       pw3[2] = pk2h(P1[12], P1[13]), pw3[3] = pk2h(P1[14], P1[15]), pw3);
    l += sacc;
    PIPE_VRD(0); PIPE_VRD(4); SBAR();
    mask(kt, C0, C1);
    float alpha; const bool resc = sm_decide(C0, C1, m, l, alpha);
    SBAR();
    PIPE_VRD(1); PIPE_GAPB(o[0] = PIPE_MF(vf[0], __builtin_bit_cast(h8, pw0), o[0]), C0, 0);
    PIPE_VRD(5); PIPE_GAPB(o[1] = PIPE_MF(vf[4], __builtin_bit_cast(h8, pw0), o[1]), C0, 4);
    PIPE_VRD(2); PIPE_GAPB(o[0] = PIPE_MF(vf[1], __builtin_bit_cast(h8, pw1), o[0]), C0, 8);
    PIPE_VRD(6); PIPE_GAPB(o[1] = PIPE_MF(vf[5], __builtin_bit_cast(h8, pw1), o[1]), C0, 12);
    PIPE_VRD(3); PIPE_GAPB(o[0] = PIPE_MF(vf[2], __builtin_bit_cast(h8, pw2), o[0]), C1, 0);
    PIPE_VRD(7); PIPE_GAPB(o[1] = PIPE_MF(vf[6], __builtin_bit_cast(h8, pw2), o[1]), C1, 4);
    PIPE_GAPB(o[0] = PIPE_MF(vf[3], __builtin_bit_cast(h8, pw3), o[0]), C1, 8);
    PIPE_GAPB(o[1] = PIPE_MF(vf[7], __builtin_bit_cast(h8, pw3), o[1]), C1, 12);
    if (resc) {
#pragma unroll
        for (int r = 0; r < 16; ++r) { o[0][r] *= alpha; o[1][r] *= alpha; } }
#undef PIPE_VRD
#undef PIPE_KRD
#undef PIPE_GAPA
#undef PIPE_GAPB
}
template <class CInit, class Mask>
__device__ __forceinline__ void pipe_first(f16v& C0, f16v& C1, const h8 (&q)[4], float& m, float& l, f16v (&o)[2], const LAS unsigned char* kcur, int kt, int r32, int hi, const CInit& cinit, const Mask& mask) {
    cinit(kt, C0, C1);
    qk(C0, C1, kcur, q, r32, hi);
    mask(kt, C0, C1);
    float alpha; const bool resc = sm_decide(C0, C1, m, l, alpha);
    if (resc) {
#pragma unroll
        for (int r = 0; r < 16; ++r) { o[0][r] *= alpha; o[1][r] *= alpha; } }
#pragma unroll
    for (int r = 0; r < 16; ++r) { C0[r] = __builtin_amdgcn_exp2f(C0[r]); C1[r] = __builtin_amdgcn_exp2f(C1[r]); }
}
__device__ __forceinline__ void pipe_drain(const f16v& P0, const f16v& P1, float& l, f16v (&o)[2], const LAS unsigned char* vslot, int lane) {
    float s = 0.f;
#pragma unroll
    for (int r = 0; r < 16; ++r) s += P0[r] + P1[r];
    l += s;
    h8 pf[4]; pack_p(pf, P0, P1);
    pv(o, vslot, pf, lane);
}
template <bool HASC, class Src, class Active, class CInit, class Mask, class PreBar, class PostBar>
__device__ __forceinline__ void pipe_walk(int n, LAS unsigned char* lds, int tid, int lane, const h8 (&q)[4], float& m, float& l, f16v (&o)[2],
                                          const Src& src, const Active& active, const CInit& cinit, const Mask& mask, const PreBar& prebar, const PostBar& postbar) {
    if (n <= 0) return;
    const int r32 = lane & 31, hi = lane >> 5, key = tid >> 3, ch = tid & 7;
    const int kst = key * 128 + ((ch ^ ((key >> 1) & 7)) << 4), vst = key * 128 + ((ch * 16) ^ (((key >> 1) & 1) << 6));
    u4v rk, rv; float cpre = 0.f; const u16* Kp; const u16* Vp; const float* Cp;
    src(0, Kp, Vp, Cp); rk = ((const GAS u4v*)Kp)[tid]; if (HASC && tid < 64) cpre = ((const GAS float*)Cp)[tid];
    *(LAS u4v*)(lds + L_K + kst) = rk; if (HASC && tid < 64) ((LAS float*)(lds + L_C))[tid] = cpre;
    __syncthreads();
    f16v pA0, pA1, pB0, pB1;
    bool pending = false; int v = 0;
#define PIPE_ITER(CN0, CN1, PP0, PP1) { \
        const bool k1 = v + 1 < n; \
        if (k1) { src(v + 1, Kp, Vp, Cp); rk = ((const GAS u4v*)Kp)[tid]; if (HASC && tid < 64) cpre = ((const GAS float*)Cp)[tid]; } \
        src(v, Kp, Vp, Cp); rv = ((const GAS u4v*)Vp)[tid]; \
        const LAS unsigned char* kcur = lds + L_K + (v & 1) * KT_BYTES; \
        const LAS unsigned char* vprev = lds + L_V + ((v + 1) & 1) * KT_BYTES; \
        if (active(v)) { \
            if (pending) pipe_step(CN0, CN1, PP0, PP1, q, m, l, o, kcur, vprev, v, r32, hi, lane, cinit, mask); \
            else { pipe_first(CN0, CN1, q, m, l, o, kcur, v, r32, hi, cinit, mask); pending = true; } \
        } else if (pending) { pipe_drain(PP0, PP1, l, o, vprev, lane); pending = false; } \
        prebar(v); \
        if (k1) { *(LAS u4v*)(lds + L_K + ((v + 1) & 1) * KT_BYTES + kst) = rk; if (HASC && tid < 64) ((LAS float*)(lds + L_C + ((v + 1) & 1) * 256))[tid] = cpre; } \
        *(LAS u4v*)(lds + L_V + (v & 1) * KT_BYTES + vst) = rv; \
        __syncthreads(); }
    bool lastodd = false;
    for (;;) {
        PIPE_ITER(pB0, pB1, pA0, pA1); lastodd = false;
        { const bool stop = postbar(v); ++v; if (stop || v >= n) break; }
        PIPE_ITER(pA0, pA1, pB0, pB1); lastodd = true;
        { const bool stop = postbar(v); ++v; if (stop || v >= n) break; }
    }
#undef PIPE_ITER
    if (pending) { const LAS unsigned char* vlast = lds + L_V + ((v + 1) & 1) * KT_BYTES; if (lastodd) pipe_drain(pA0, pA1, l, o, vlast, lane); else pipe_drain(pB0, pB1, l, o, vlast, lane); }
}

constexpr float FOX_DEAD = -152.f;
__device__ __forceinline__ void fox_unit(unsigned char* ws, LAS unsigned char* lds, int bh, int qb, int wave, int lane) {
    asm volatile("" : "+v"(lane));
    const int tid = wave * 64 + lane, r32 = lane & 31, hi = lane >> 5;
    const u16* Qg = (const u16*)(ws + WS_FQ) + (size_t)bh * SEQ * 64; const u16* Kg = (const u16*)(ws + WS_FK) + (size_t)bh * SEQ * 64; const u16* Vg = (const u16*)(ws + WS_FV) + (size_t)bh * SEQ * 64;
    const GAS float* cg = (const GAS float*)(ws + WS_CFOX) + (size_t)bh * SEQ;
    const int t0w = 256 * qb + 32 * wave, t = t0w + r32;
    h8 q[4]; float qn = 0.f;
#pragma unroll
    for (int d0 = 0; d0 < 4; ++d0) { q[d0] = *(const GAS h8*)(Qg + (size_t)t * 64 + 16 * d0 + 8 * hi);
#pragma unroll
        for (int j = 0; j < 8; ++j) { const float v = (float)q[d0][j]; qn += v * v; } }
    qn = sqrtf(pair_sum(qn)) * 1.001f;
    const float ct = cg[t];
    float m = NEG_BIG, l = 0.f; f16v o[2] = {ATT_Z16(), ATT_Z16()};
    const int ktop = 4 * qb + 3;
    volatile LAS unsigned* flags = (volatile LAS unsigned*)(lds + L_FLAG);
    LAS float* pm = (LAS float*)(lds + L_PM);
    if (wave == 0) { float v = lane <= ktop ? ((const GAS float*)(ws + WS_KN))[bh * 64 + lane] : 0.f;
        int ln = lane; asm volatile("" : "+v"(ln));
#pragma unroll
        for (int d = 1; d < 64; d <<= 1) { const float u = __int_as_float(__builtin_amdgcn_ds_bpermute(4 * (ln - d), __float_as_int(v))); if (ln >= d) v = fmaxf(v, u); }
        pm[lane] = v * 1.001f; pm[64 + lane] = lane <= ktop ? cg[64 * lane + 63] : 0.f; }
    TileRegs tr; float cpre = 0.f;
    tile_load(tr, Kg + (size_t)ktop * 4096, Vg + (size_t)ktop * 4096, tid); if (tid < 64) cpre = cg[64 * ktop + tid];
    tile_store(tr, lds + L_K, lds + L_V, tid); if (tid < 64) ((LAS float*)(lds + L_C))[tid] = cpre;
    __syncthreads();
    bool wave_done = false; int it = 0;
    for (int kt = ktop; kt >= 0; --kt, ++it) {
        const int cur = it & 1, nxt = cur ^ 1; const bool more = kt > 0;
        if (more) { tile_load(tr, Kg + (size_t)(kt - 1) * 4096, Vg + (size_t)(kt - 1) * 4096, tid); if (tid < 64) cpre = cg[64 * (kt - 1) + tid]; }
        const bool reached = 64 * kt <= t0w + 31;
        if (reached && !wave_done) {
            f16v p0, p1; const float ctm = ct - sm_ref(m);
            const LAS float* cs = (const LAS float*)(lds + L_C + cur * 512);
#pragma unroll
            for (int g = 0; g < 4; ++g) { const f32x4 c0 = *(const LAS f32x4*)(cs + 8 * g + 4 * hi), c1 = *(const LAS f32x4*)(cs + 32 + 8 * g + 4 * hi);
#pragma unroll
                for (int e = 0; e < 4; ++e) { p0[4 * g + e] = ctm - c0[e]; p1[4 * g + e] = ctm - c1[e]; } }
            qk(p0, p1, lds + L_K + cur * KT_BYTES, q, r32, hi);
            if (64 * kt + 63 > t0w) {
                int tt = t - 64 * kt; asm volatile("" : "+v"(tt));
#pragma unroll
                for (int r = 0; r < 16; ++r) { const int c = crow(r, hi); if (c > tt) p0[r] = -INFINITY; if (c + 32 > tt) p1[r] = -INFINITY; }
            }
            softmax_step(p0, p1, m, l, o);
            h8 pf[4]; pack_p(pf, p0, p1);
            pv(o, lds + L_V + cur * KT_BYTES, pf, lane);
            if (more) {
                const float bound = qn * pm[kt - 1] + ct - pm[64 + kt - 1] - m;
                wave_done = __all(m != NEG_BIG && bound < FOX_DEAD);
            }
        }
        if (lane == 0) flags[cur * 8 + wave] = (reached && wave_done) ? 1u : 0u;
        if (more) { tile_store(tr, lds + L_K + nxt * KT_BYTES, lds + L_V + nxt * KT_BYTES, tid); if (tid < 64) ((LAS float*)(lds + L_C + nxt * 512))[tid] = cpre; }
        __syncthreads();
        unsigned alld = 1u;
#pragma unroll
        for (int w = 0; w < 8; ++w) alld &= flags[cur * 8 + w];
        if (alld) break;
    }
    __syncthreads();
    l = pair_sum(l); const float inv = 1.f / fmaxf(l, 1e-20f);
#pragma unroll
    for (int r = 0; r < 16; ++r) { o[0][r] *= inv; o[1][r] *= inv; }
    const int b = bh >> 2, h = bh & 3;
    norm_store(o, [&](int r) { return (u16*)(ws + WS_O16) + ((size_t)b * SEQ + t0w + r) * 1024 + (NSA_H + h) * 64; }, lds + L_K + wave * KT_BYTES, lane);
}

constexpr float SB_STOP = -120.f;
__device__ __forceinline__ float softplus_(float z) { return fmaxf(z, 0.f) + 0.6931471805599453f * __builtin_amdgcn_logf(1.f + __builtin_amdgcn_exp2f(-fabsf(z) * 1.4426950408889634f)); }
__device__ __forceinline__ void sb_unit(unsigned char* ws, LAS unsigned char* lds, int bh, int qb, int wave, int lane) {
    asm volatile("" : "+v"(lane));
    const int r32 = lane & 31, hi = lane >> 5;
    const u16* Qg = (const u16*)(ws + WS_SQ) + (size_t)bh * SEQ * 64; const u16* Kg = (const u16*)(ws + WS_SK) + (size_t)bh * SEQ * 64; const u16* Vg = (const u16*)(ws + WS_SV) + (size_t)bh * SEQ * 64;
    const int t0w = 256 * qb + 32 * wave, t = t0w + r32;
    h8 q[4];
#pragma unroll
    for (int d0 = 0; d0 < 4; ++d0) q[d0] = *(const GAS h8*)(Qg + (size_t)t * 64 + 16 * d0 + 8 * hi);
    float carry = 0.f; f16v o[2] = {ATT_Z16(), ATT_Z16()};
    LAS unsigned char* myV = lds + L_K + wave * KT_BYTES;
    for (int kt = (t0w + 31) >> 6; kt >= 0; --kt) {
        h8 ka[4], kb[4]; u4v vv[8];
        { const u16* kp = Kg + ((size_t)64 * kt + r32) * 64 + 8 * hi;
#pragma unroll
          for (int d0 = 0; d0 < 4; ++d0) { ka[d0] = *(const GAS h8*)(kp + 16 * d0); kb[d0] = *(const GAS h8*)(kp + 32 * 64 + 16 * d0); }
          const GAS u4v* vp = (const GAS u4v*)(Vg + (size_t)kt * 4096) + lane;
#pragma unroll
          for (int i = 0; i < 8; ++i) vv[i] = vp[64 * i]; }
#pragma unroll
        for (int i = 0; i < 8; ++i) { const int idx = lane + 64 * i, key = idx >> 3, c = idx & 7; *(LAS u4v*)(myV + key * 128 + ((c * 16) ^ (((key >> 1) & 1) << 6))) = vv[i]; }
        f16v p0 = ATT_Z16(), p1 = ATT_Z16();
#pragma unroll
        for (int d0 = 0; d0 < 4; ++d0) { p0 = __builtin_amdgcn_mfma_f32_32x32x16_f16(ka[d0], q[d0], p0, 0, 0, 0); p1 = __builtin_amdgcn_mfma_f32_32x32x16_f16(kb[d0], q[d0], p1, 0, 0, 0); }
        {
            f16v L0, L1;
            const bool diag = 64 * kt + 63 >= t0w;
            int tt = diag ? t - 64 * kt : 1000; asm volatile("" : "+v"(tt));
#pragma unroll
            for (int r = 0; r < 16; ++r) { const int c = crow(r, hi);
                L0[r] = -softplus_(p0[r]); L1[r] = -softplus_(p1[r]);
                if (c >= tt) L0[r] = 0.f; if (c + 32 >= tt) L1[r] = 0.f; }
            float gt[8];
#pragma unroll
            for (int i = 0; i < 4; ++i) { gt[i] = (L0[4 * i] + L0[4 * i + 1]) + (L0[4 * i + 2] + L0[4 * i + 3]); gt[4 + i] = (L1[4 * i] + L1[4 * i + 1]) + (L1[4 * i + 2] + L1[4 * i + 3]); }
            float og[8];
#pragma unroll
            for (int i = 0; i < 8; ++i) og[i] = pair_other(gt[i], hi);
            float T[8]; float run = 0.f;
#pragma unroll
            for (int i = 7; i >= 0; --i) {
                if (hi == 0) { run += og[i]; T[i] = run; run += gt[i]; }
                else { T[i] = run; run += gt[i]; run += og[i]; }
            }
            const float total = run;
#pragma unroll
            for (int i = 0; i < 4; ++i) {
                {   const float b = carry + T[i];
                    const float w3 = b, w2 = w3 + L0[4 * i + 3], w1 = w2 + L0[4 * i + 2], w0 = w1 + L0[4 * i + 1];
                    p0[4 * i] += L0[4 * i] + w0; p0[4 * i + 1] += L0[4 * i + 1] + w1; p0[4 * i + 2] += L0[4 * i + 2] + w2; p0[4 * i + 3] += L0[4 * i + 3] + w3; }
                {   const float b = carry + T[4 + i];
                    const float w3 = b, w2 = w3 + L1[4 * i + 3], w1 = w2 + L1[4 * i + 2], w0 = w1 + L1[4 * i + 1];
                    p1[4 * i] += L1[4 * i] + w0; p1[4 * i + 1] += L1[4 * i + 1] + w1; p1[4 * i + 2] += L1[4 * i + 2] + w2; p1[4 * i + 3] += L1[4 * i + 3] + w3; }
            }
#pragma unroll
            for (int r = 0; r < 16; ++r) { const int c = crow(r, hi);
                p0[r] = (c >= tt) ? 0.f : __builtin_amdgcn_exp2f(p0[r] * 1.4426950408889634f);
                p1[r] = (c + 32 >= tt) ? 0.f : __builtin_amdgcn_exp2f(p1[r] * 1.4426950408889634f); }
            carry += total;
        }
        h8 pf[4]; pack_p(pf, p0, p1);
        pv(o, myV, pf, lane);
        if (__all(carry < SB_STOP)) break;
    }
    __syncthreads();
    const int b = bh >> 2, h = bh & 3;
    norm_store(o, [&](int r) { return (u16*)(ws + WS_O16) + ((size_t)b * SEQ + t0w + r) * 1024 + (NSA_H + FOX_H + h) * 64; }, lds + L_K + wave * KT_BYTES, lane);
}

__device__ __forceinline__ void nsa_unit(unsigned char* ws, LAS unsigned char* lds, int bg, int cur, int wave, int) {
#define NSA_IDS const int lane = lane_id_fresh(), tid = wave * 64 + lane, r32 = lane & 31, hi = lane >> 5, tl = r32 >> 2, hh = r32 & 3; \
    const int b = bg >> 1, g = bg & 1, tloc = 8 * wave + tl, tok = 64 * cur + tloc, head = 4 * g + hh; const size_t row = (size_t)b * SEQ + tok; \
    (void)tid; (void)tl; (void)hh; (void)tok; (void)head; (void)row; (void)tloc; (void)b; (void)g; (void)hi; (void)r32; \
    LAS float* const ot = (LAS float*)(lds + L_OT) + tid; LAS float* const imp_lds = (LAS float*)(lds + L_IMP); LAS unsigned* const mask_lds = (LAS unsigned*)(lds + L_MASK); \
    const GAS float* const gt = (const GAS float*)(ws + WS_GATES) + row * 24 + head * 3; (void)ot; (void)imp_lds; (void)mask_lds; (void)gt;
    h8 q[4];
    { NSA_IDS
      const u16* Qg = (const u16*)(ws + WS_NQ) + (row * 8 + head) * 64;
#pragma unroll
      for (int d0 = 0; d0 < 4; ++d0) q[d0] = *(const GAS h8*)(Qg + 16 * d0 + 8 * hi); }
    float m = NEG_BIG, l = 0.f;
    {   NSA_IDS
    const u16* kcg = (const u16*)(ws + WS_KC) + (size_t)bg * NCMP_PAD * 64; const u16* vcg = (const u16*)(ws + WS_VC) + (size_t)bg * NCMP_PAD * 64;
    const int nct = (4 * cur + 3 + 63) >> 6;
    const int nlim = tok >= 31 ? ((tok - 31) >> 4) : -1;
    {
        f16v o[2] = {ATT_Z16(), ATT_Z16()}; float carry_last = 0.f;
        float rk0 = 0.f, rk1 = 0.f, rk2 = 0.f, rk3 = 0.f;
        tile_walk<1>(kcg, vcg, 0, nct, lds, tid, [&](int kt, const LAS unsigned char* bK, const LAS unsigned char* bV) {
            const float rb = sm_ref(m);
            f16v p0 = splat16(-rb), p1 = p0; qk(p0, p1, bK, q, r32, hi);
            int nl = nlim - 64 * kt; asm volatile("" : "+v"(nl));
#pragma unroll
            for (int r = 0; r < 16; ++r) { const int n = crow(r, hi); if (n > nl) p0[r] = -INFINITY; if (n + 32 > nl) p1[r] = -INFINITY; }
            softmax_step(p0, p1, m, l, o);
            const float ra = sm_ref(m), cs = __builtin_amdgcn_exp2f(rb - ra);
            rk0 = kt == 0 ? ra : rk0; rk1 = kt == 1 ? ra : rk1; rk2 = kt == 2 ? ra : rk2; rk3 = kt == 3 ? ra : rk3;
            float imp[8], last[8];
#pragma unroll
            for (int i = 0; i < 4; ++i) { imp[i] = (p0[4 * i] + p0[4 * i + 1]) + (p0[4 * i + 2] + p0[4 * i + 3]); last[i] = p0[4 * i + 3];
                                          imp[4 + i] = (p1[4 * i] + p1[4 * i + 1]) + (p1[4 * i + 2] + p1[4 * i + 3]); last[4 + i] = p1[4 * i + 3]; }
            float recv[8];
#pragma unroll
            for (int i = 0; i < 8; ++i) recv[i] = pair_other(last[i], hi);
#pragma unroll
            for (int i = 0; i < 8; ++i) { const float below = hi ? recv[i] : (i > 0 ? recv[i > 0 ? i - 1 : 0] : carry_last * cs); imp[i] += below; }
            carry_last = recv[7];
#pragma unroll
            for (int i = 0; i < 8; ++i) ot[(8 * kt + i) * 512] = imp[i];
            h8 pf[4]; pack_p(pf, p0, p1);
            pv(o, bV, pf, lane);
        });
        l = pair_sum(l);
        const float invl = 1.f / fmaxf(l, 1e-20f), rf = sm_ref(m);
#pragma unroll
        for (int kt = 0; kt < 4; ++kt) if (kt < nct) {
            const float fac = __builtin_amdgcn_exp2f((kt == 0 ? rk0 : kt == 1 ? rk1 : kt == 2 ? rk2 : rk3) - rf) * invl;
#pragma unroll
            for (int i = 0; i < 8; ++i) { float v = ot[(8 * kt + i) * 512] * fac; v += lx<1>(v); v += lx<2>(v);
                if (hh == 0) imp_lds[tloc * 65 + 16 * kt + 2 * i + hi] = v; }
        }
        const float g_c = gt[0] * invl;
#pragma unroll
        for (int r = 0; r < 16; ++r) { ot[r * 512] = g_c * o[0][r]; ot[(16 + r) * 512] = g_c * o[1][r]; }
    }
    }
    { NSA_IDS
    if (cur < 16) {
        if (tid < 64) { const unsigned long long mk = (2ull << cur) - 1ull; mask_lds[2 * tid] = (unsigned)mk; mask_lds[2 * tid + 1] = (unsigned)(mk >> 32); }
    } else {
        __syncthreads();
        const int tk = tid >> 3, sub = tid & 7;
        LAS unsigned* keys = (LAS unsigned*)imp_lds;
        unsigned ks[8];
#pragma unroll
        for (int e = 0; e < 8; ++e) { const int j = 8 * sub + e; const bool forced = (j == 0) || (j == cur) || (j == cur - 1);
            const unsigned nb = __float_as_uint(imp_lds[tk * 65 + j]) | 0x80000000u;
            ks[e] = forced ? (0xFFFFFFC0u | (unsigned)(63 - j)) : (j <= cur ? nb : (unsigned)(63 - j)); }
#pragma unroll
        for (int e = 0; e < 8; ++e) keys[tk * 65 + 8 * sub + e] = ks[e];
        __syncthreads();
        int rank[8] = {0, 0, 0, 0, 0, 0, 0, 0};
        for (int jj = 0; jj < 64; ++jj) { const unsigned ko = keys[tk * 65 + jj];
#pragma unroll
            for (int e = 0; e < 8; ++e) rank[e] += (ko > ks[e]) ? 1 : 0; }
        int rs = ((rank[0] + rank[1]) + (rank[2] + rank[3])) + ((rank[4] + rank[5]) + (rank[6] + rank[7]));
        rs += (int)lxu<1>((unsigned)rs); rs += (int)lxu<2>((unsigned)rs); rs += (int)lxu<4>((unsigned)rs);
        if (__any(rs != 2016)) {
#pragma unroll
            for (int e = 0; e < 8; ++e) rank[e] = 0;
            for (int jj = 0; jj < 64; ++jj) { const unsigned ko = keys[tk * 65 + jj];
#pragma unroll
                for (int e = 0; e < 8; ++e) rank[e] += ((ko > ks[e]) || (ko == ks[e] && jj < 8 * sub + e)) ? 1 : 0; }
        }
        unsigned byte = 0u;
#pragma unroll
        for (int e = 0; e < 8; ++e) if (rank[e] < 16 && (8 * sub + e) <= cur) byte |= 1u << e;
        unsigned lo = sub < 4 ? byte << (8 * sub) : 0u, hi32 = sub >= 4 ? byte << (8 * (sub - 4)) : 0u;
        lo |= lxu<1>(lo); hi32 |= lxu<1>(hi32); lo |= lxu<2>(lo); hi32 |= lxu<2>(hi32); lo |= lxu<4>(lo); hi32 |= lxu<4>(hi32);
        if (sub == 0) { mask_lds[2 * tk] = lo; mask_lds[2 * tk + 1] = hi32; }
    }
    }
    __syncthreads();
    f16v o[2];
    {   NSA_IDS
    unsigned long long rowmask = ((unsigned long long)mask_lds[2 * tloc + 1] << 32) | mask_lds[2 * tloc];
    unsigned long long wmask = rowmask;
    { unsigned wl = (unsigned)wmask, wh = (unsigned)(wmask >> 32);
      wl |= lxu<4>(wl); wh |= lxu<4>(wh); wl |= lxu<8>(wl); wh |= lxu<8>(wh); wl |= lxu<16>(wl); wh |= lxu<16>(wh);
      wmask = ((unsigned long long)(unsigned)__builtin_amdgcn_readfirstlane((int)wh) << 32) | (unsigned)__builtin_amdgcn_readfirstlane((int)wl); }
        const u16* ksg = (const u16*)(ws + WS_KS) + (size_t)bg * SEQ * 64; const u16* vsg = (const u16*)(ws + WS_VS) + (size_t)bg * SEQ * 64;
        m = NEG_BIG; l = 0.f; o[0] = ATT_Z16(); o[1] = ATT_Z16();
        pipe_walk<false>(cur + 1, lds, tid, lane, q, m, l, o,
            [&](int v, const u16*& Kp, const u16*& Vp, const float*& Cp) { Kp = ksg + (size_t)v * 4096; Vp = vsg + (size_t)v * 4096; Cp = nullptr; },
            [&](int v) { return (bool)((wmask >> v) & 1ull); },
            [&](int v, f16v& Ci0, f16v& Ci1) { const bool selrow = (rowmask >> v) & 1ull;
                Ci0 = splat16(selrow ? -sm_ref(m) : -INFINITY); Ci1 = Ci0; },
            [&](int v, f16v& C0, f16v& C1) {
                if (v == cur) {
                    int tq = tloc - 4 * hi; asm volatile("" : "+v"(tq));
#pragma unroll
                    for (int r = 0; r < 16; ++r) { const int c = crow(r, 0); if (c > tq) C0[r] = -INFINITY; if (c + 32 > tq) C1[r] = -INFINITY; } } },
            [](int) {}, [](int) { return false; });
    }
    {   NSA_IDS
        l = pair_sum(l); const float sc_ = gt[1] / fmaxf(l, 1e-20f);
#pragma unroll
        for (int r = 0; r < 16; ++r) { ot[r * 512] += sc_ * o[0][r]; ot[(16 + r) * 512] += sc_ * o[1][r]; }
    }
    {   NSA_IDS
        const u16* kwg = (const u16*)(ws + WS_KW) + (size_t)bg * SEQ * 64; const u16* vwg = (const u16*)(ws + WS_VW) + (size_t)bg * SEQ * 64;
        m = NEG_BIG; l = 0.f; o[0] = ATT_Z16(); o[1] = ATT_Z16();
        const int k0 = cur >= 8 ? cur - 8 : 0;
        auto mask_win = [&](int kt, f16v& p0, f16v& p1) {
            if (kt == cur) {
                int tq = tloc - 4 * hi; asm volatile("" : "+v"(tq));
#pragma unroll
                for (int r = 0; r < 16; ++r) { const int c = crow(r, 0); if (c > tq) p0[r] = -INFINITY; if (c + 32 > tq) p1[r] = -INFINITY; }
            } else if (kt == cur - 8) {
                int tq = tloc - 4 * hi; asm volatile("" : "+v"(tq));
#pragma unroll
                for (int r = 0; r < 16; ++r) { const int c = crow(r, 0); if (c <= tq) p0[r] = -INFINITY; if (c + 32 <= tq) p1[r] = -INFINITY; }
            } };
        tile_walk<1>(kwg, vwg, k0, cur + 1, lds, tid, [&](int kt, const LAS unsigned char* bK, const LAS unsigned char* bV) {
            attn_one(kt, bK, bV, q, m, l, o, r32, hi, lane, mask_win);
        });
    }
    {   NSA_IDS
        l = pair_sum(l); const float sc_ = gt[2] / fmaxf(l, 1e-20f);
#pragma unroll
        for (int r = 0; r < 16; ++r) { o[0][r] = ot[r * 512] + sc_ * o[0][r]; o[1][r] = ot[(16 + r) * 512] + sc_ * o[1][r]; }
        norm_store(o, [&](int r) { return (u16*)(ws + WS_O16) + ((size_t)b * SEQ + 64 * cur + 8 * wave + (r >> 2)) * 1024 + (4 * g + (r & 3)) * 64; }, lds + L_K + wave * KT_BYTES, lane);
    }
#undef NSA_IDS
}
__device__ __forceinline__ void glds16(const void* g, unsigned lds_base) {
    unsigned sv; asm volatile("s_mov_b32 %0, m0\n\ts_mov_b32 m0, %2\n\ts_nop 0\n\tglobal_load_lds_dwordx4 %1, off\n\ts_mov_b32 m0, %0" : "=&s"(sv) : "v"(g), "s"(lds_base) : "memory"); }
__device__ __forceinline__ float gelu_tanh_(float x) { const float u = 0.7978845608028654f * (x + 0.044715f * x * x * x); const float e = __expf(2.f * u); return 0.5f * x * (2.f - 2.f / (1.f + e)); }
__device__ __forceinline__ void compress_unit(const u16* kin  , const u16* w1t  , const float* bias1  , const u16* w2t  ,
                                              u16* out  , int n0, int wave, int lane, LAS unsigned char* lds) {
    const int r32 = lane & 31, hi = lane >> 5;
    f16v acc[4] = {ATT_Z16(), ATT_Z16(), ATT_Z16(), ATT_Z16()};
    const u16* wrow = kin + (size_t)(16 * (n0 + r32)) * 64 + 8 * hi + 256 * wave;
    LAS unsigned char* wimg = lds + wave * 16384; const unsigned wl = (unsigned)(size_t)wimg;
    const int dx = lane >> 3, dc = lane & 7;
    const unsigned srcE = (unsigned)(dx * 4096 + ((dc ^ (dx >> 1)) << 4)), srcO = (unsigned)(dx * 4096 + ((dc ^ (4 + (dx >> 1))) << 4));
    const char* w1b = (const char*)(w1t + 256 * wave);
#pragma unroll 1
    for (int ch = 0; ch < 4; ++ch) {
        h8 bfr[4];
#pragma unroll
        for (int dd = 0; dd < 4; ++dd) bfr[dd] = *(const GAS h8*)(wrow + 64 * ch + 16 * dd);
#pragma unroll
        for (int i = 0; i < 16; ++i) glds16(w1b + ch * 128 + (size_t)i * (8 * 4096) + ((i & 1) ? srcO : srcE), wl + i * 1024);
        asm volatile("s_waitcnt vmcnt(0)" ::: "memory");
#pragma unroll
        for (int dd = 0; dd < 4; ++dd)
#pragma unroll
            for (int hb = 0; hb < 4; ++hb) { const h8 afr = *(const LAS h8*)(wimg + (hb * 32 + r32) * 128 + (((2 * dd + hi) ^ ((r32 >> 1) & 7)) << 4));
                acc[hb] = __builtin_amdgcn_mfma_f32_32x32x16_f16(afr, bfr[dd], acc[hb], 0, 0, 0); }
        asm volatile("s_waitcnt lgkmcnt(0)" ::: "memory");
    }
    LAS float* part = (LAS float*)lds;
#pragma unroll
    for (int hb = 0; hb < 4; ++hb)
#pragma unroll
        for (int r = 0; r < 16; ++r) part[((wave * 64) + hb * 16 + r) * 64 + lane] = acc[hb][r];
    __syncthreads();
    const int hb = wave >> 1, s2 = wave & 1;
    h8 gf;
#pragma unroll
    for (int j = 0; j < 8; ++j) { const int i = hb * 16 + 8 * s2 + j; float v = 0.f;
#pragma unroll
        for (int w = 0; w < 8; ++w) v += part[((w * 64) + i) * 64 + lane];
        gf[j] = (_Float16)gelu_tanh_(v + ((const GAS float*)bias1)[32 * hb + crow(8 * s2 + j, hi)]); }
    f16v oacc[2] = {ATT_Z16(), ATT_Z16()};
    { const int s = wave;
#pragma unroll
      for (int eh = 0; eh < 2; ++eh) { const u16* wp = w2t + (size_t)(32 * eh + r32) * 128 + 16 * s + 4 * hi;
          const h4 a0 = *(const GAS h4*)wp, a1 = *(const GAS h4*)(wp + 8); const h8 af = {a0[0], a0[1], a0[2], a0[3], a1[0], a1[1], a1[2], a1[3]};
          oacc[eh] = __builtin_amdgcn_mfma_f32_32x32x16_f16(af, gf, oacc[eh], 0, 0, 0); } }
    __syncthreads();
#pragma unroll
    for (int eh = 0; eh < 2; ++eh)
#pragma unroll
        for (int r = 0; r < 16; ++r) part[((wave * 32) + eh * 16 + r) * 64 + lane] = oacc[eh][r];
    __syncthreads();
    { const int eh = wave >> 2, g = wave & 3; float v[4];
#pragma unroll
      for (int e = 0; e < 4; ++e) { v[e] = 0.f;
#pragma unroll
          for (int w = 0; w < 8; ++w) v[e] += part[((w * 32) + eh * 16 + 4 * g + e) * 64 + lane]; }
      const int n = n0 + r32;
      h4 o = {(_Float16)v[0], (_Float16)v[1], (_Float16)v[2], (_Float16)v[3]};
      if (n >= NCMP) o = (h4){(_Float16)0.f, (_Float16)0.f, (_Float16)0.f, (_Float16)0.f};
      *(GAS h4*)(out + (size_t)n * 64 + 32 * eh + 8 * g + 4 * hi) = o; }
    __syncthreads();
}
}


constexpr int NWAVES = 8;
constexpr int RING_OFF = 0, RING_BYTES = 153600;
constexpr int LDSCTL_OFF = RING_BYTES, MISC_OFF = LDSCTL_OFF + 320;
constexpr int LDS_BYTES = 155648;
constexpr int CW_TMO = 0, CW_BAR = 4096;
constexpr int CW_QUEUE = 32768;
constexpr int N_BAR_REGIONS = 4;
static_assert((CW_BAR + N_BAR_REGIONS * XCD_BAR_WORDS) <= CW_QUEUE && (CW_QUEUE + 64 * 16) * 4 <= (int)(1 * MiB), "control words");
constexpr size_t WS_P16 = WS_H16B + 64 * MiB;
constexpr size_t WS_W = WS_P16 + 32 * MiB;
constexpr size_t W_IN = 0, W_OUT = 6 * MiB, W_GU = 8 * MiB, W_DN = 19 * MiB, W_PG = W_DN + 5632 * 1024, W_PP = W_PG + 2 * MiB, W_LAYER = 27 * MiB;
constexpr size_t WS_CW = WS_W + 2 * W_LAYER;
constexpr size_t WS_END2 = WS_CW + 4 * MiB;
static_assert(W_PP + 512 * 1024 <= W_LAYER && WS_END2 <= 512 * MiB, "weights map");
constexpr size_t CW_W1T = 0, CW_W2T = 2 * MiB, CW_B1 = 2 * MiB + 64 * 1024;
constexpr size_t WS_UTAB = 2 * MiB - 16384;
constexpr int NIN_PAD = 3072;

#ifndef MK_MASK
#define MK_MASK 0xFFFF
#endif
#ifndef MK_REPEAT
#define MK_REPEAT 0
#endif
#define REPS(k) ((((MK_REPEAT) >> (k)) & 1) ? 2 : 1)
struct Args { const void* in[23]; float* out; unsigned char* ws; int ph_lo, ph_hi, bar_region, rep_mask, fuse_final; };

struct RepOrder { pg8::StaticOrder b; int R;
    __device__ bool next(int i, pg8::Unit& u) const { if (i >= 2 * R) return false; return b.next(i >= R ? i - R : i, u); }
    __device__ __forceinline__ void a_ready(const pg8::Unit&) const {}
    __device__ __forceinline__ void done(const pg8::Unit&) const {} };
struct RangeOrder { pg8::StaticOrder b; int i0, cnt;
    __device__ bool next(int i, pg8::Unit& u) const { if (i >= cnt) return false; return b.next(i0 + i, u); }
    __device__ __forceinline__ void a_ready(const pg8::Unit&) const {}
    __device__ __forceinline__ void done(const pg8::Unit&) const {} };
struct ColSrc { const float* W; int col; };
template <int NI, class Map>
__device__ __forceinline__ void transpose_items(const Map& map, int ldw, int K, const float* gain, u16* WT, int nblk, LAS float* scr, int item0, int lane) {
    float tv[NI][32];
#pragma unroll
    for (int q = 0; q < NI; ++q) { const int item = item0 + q, kb = item / nblk, nb = item % nblk, k0 = 64 * kb, n0 = 32 * nb;
        const ColSrc cs = map(n0 + (lane & 31));
        if (cs.W) { const GAS float* wp = (const GAS float*)cs.W + (size_t)(k0 + (lane >> 5)) * ldw + cs.col;
#pragma unroll
            for (int i = 0; i < 32; ++i) tv[q][i] = wp[(size_t)(2 * i) * ldw]; }
        else {
#pragma unroll
            for (int i = 0; i < 32; ++i) tv[q][i] = 0.f; } }
#pragma unroll
    for (int q = 0; q < NI; ++q) { const int item = item0 + q, kb = item / nblk, nb = item % nblk, k0 = 64 * kb, n0 = 32 * nb;
        if (gain) { const GAS float* gp = (const GAS float*)gain + k0 + (lane >> 5);
#pragma unroll
            for (int i = 0; i < 32; ++i) tv[q][i] *= gp[2 * i]; }
#pragma unroll
        for (int i = 0; i < 32; ++i) scr[(2 * i + (lane >> 5)) * 33 + (lane & 31)] = tv[q][i];
        LDS_WAIT(); asm volatile("" ::: "memory");
        const int c = lane & 7;
#pragma unroll
        for (int j = 0; j < 4; ++j) { const int n = (lane >> 3) + 8 * j; const LAS float* s = scr + (8 * c) * 33 + n;
            pg8::h16x8 o;
#pragma unroll
            for (int e = 0; e < 8; ++e) o[e] = (_Float16)s[e * 33];
            *(pg8::h16x8*)(WT + (size_t)(n0 + n) * K + k0 + 8 * c) = o; }
        LDS_WAIT(); asm volatile("" ::: "memory"); }
}
template <class Map>
__device__ __forceinline__ void transpose_item(const Map& map, int ldw, int K, const float* gain, u16* WT, int nblk, LAS float* scr, int item, int lane) { transpose_items<1>(map, ldw, K, gain, WT, nblk, scr, item, lane); }
struct MapIdent { const float* W; __device__ __forceinline__ ColSrc operator()(int n) const { return ColSrc{W, n}; } };
struct MapGU { const float* Wg; const float* Wu; __device__ __forceinline__ ColSrc operator()(int n) const { const int tile = n >> 8, w = n & 255; return w < 128 ? ColSrc{Wg, tile * 128 + w} : ColSrc{Wu, tile * 128 + w - 128}; } };
struct MapInProj { const float* W; __device__ __forceinline__ ColSrc operator()(int n) const {
    const int tile = n >> 8, w = n & 255, bj = w >> 7, wc = (w & 127) >> 5, dd = w & 31, slot = tile * 4 + wc, d = dd + 32 * bj;
    int base;
    if (slot < 8) base = C_NQ + slot * 64;
    else if (slot < 14) { const int t = slot - 8; base = (t < 2 ? C_KC : (t < 4 ? C_KS : C_KW)) + (t & 1) * 64; }
    else if (slot < 20) { const int t = slot - 14; base = (t < 2 ? C_VC : (t < 4 ? C_VS : C_VW)) + (t & 1) * 64; }
    else if (slot < 44) { const int t = slot - 20, which = t >> 2; base = (which == 0 ? C_FQ : which == 1 ? C_FK : which == 2 ? C_FV : which == 3 ? C_SQ : which == 4 ? C_SK : C_SV) + (t & 3) * 64; }
    else if (slot == 44) { if (bj == 1 || dd >= 28) return ColSrc{nullptr, 0}; return ColSrc{W, dd < 24 ? C_GATE + dd : C_FF + (dd - 24)}; }
    else return ColSrc{nullptr, 0};
    return ColSrc{W, base + d}; } };

__global__ void __launch_bounds__(NWAVES * 64, 2) mk_fwd(Args args) {
    extern __shared__ __attribute__((aligned(16))) unsigned char lds_raw[];
    LAS unsigned char* lds = (LAS unsigned char*)lds_raw;
    const int wave = __builtin_amdgcn_readfirstlane(threadIdx.x >> 6), G = gridDim.x;
#define LANE_ID() lane_id_fresh()
    volatile LAS unsigned* MISC = (volatile LAS unsigned*)(lds + MISC_OFF);
    unsigned char* ws = args.ws;
    gu32* ctl = (gu32*)(ws + WS_CTL);
    for (int u = threadIdx.x; u < (LDS_BYTES - LDSCTL_OFF) / 4; u += NWAVES * 64) ((LAS unsigned*)(lds + LDSCTL_OFF))[u] = 0u;
    __syncthreads();
    XcdBarrier bar = xcd_barrier_post((unsigned*)(ctl + CW_BAR) + args.bar_region * XCD_BAR_WORDS, MISC + 8);
    const int lo = args.ph_lo, hi = args.ph_hi;
#define IN(k) (lo <= (k) && (k) < hi)
#if defined(PROBE_BAR2)
#define SEAM(k) do { if (IN(k) && IN((k) + 1)) { xcd_barrier(bar, wave == 0 && LANE_ID() == 0); xcd_barrier(bar, wave == 0 && LANE_ID() == 0); } } while (0)
#else
#define SEAM(k) do { if (IN(k) && IN((k) + 1)) xcd_barrier(bar, wave == 0 && LANE_ID() == 0); } while (0)
#endif
    const int gw = blockIdx.x * NWAVES + wave, NGW = G * NWAVES;

    constexpr int I_IN = 16 * (NIN_PAD / 32), I_OUT = 16 * 32, I_GU = 16 * (5632 / 32), I_DN = 44 * 32, I_PG = 16 * 32, I_PP = 4 * 32, I_LAYER = I_IN + I_OUT + I_GU + I_DN + I_PG + I_PP;
    constexpr int DEF_W_UNITS0 = I_LAYER / 32, DEF_W_UNITS1 = (I_LAYER - I_IN) / 32, DEF_P_UNITS = (int)((size_t)DEPTH * T * PLE / 8 / 8192);
    static_assert(DEPTH == 2 && I_LAYER % 32 == 0 && (I_LAYER - I_IN) % 32 == 0 && (size_t)DEF_P_UNITS * 8192 * 8 == (size_t)DEPTH * T * PLE, "deferred units");
    auto weight_items = [&](auto ni_tag, int Lw, int r, LAS float* scr, int lane) __attribute__((always_inline)) {
        constexpr int NI = decltype(ni_tag)::value;
        u16* wl = (u16*)(ws + WS_W + (size_t)Lw * W_LAYER);
        if (r < I_IN) { transpose_items<NI>(MapInProj{(const float*)args.in[4] + (size_t)Lw * DM * IN_W}, IN_W, DM, (const float*)args.in[3] + Lw * DM, (u16*)((unsigned char*)wl + W_IN), NIN_PAD / 32, scr, r, lane); return; } r -= I_IN;
        if (r < I_OUT) { transpose_items<NI>(MapIdent{(const float*)args.in[14] + (size_t)Lw * DM * DM}, DM, DM, (const float*)args.in[13] + Lw * DM, (u16*)((unsigned char*)wl + W_OUT), 32, scr, r, lane); return; } r -= I_OUT;
        if (r < I_GU) { transpose_items<NI>(MapGU{(const float*)args.in[16] + (size_t)Lw * DM * DFF, (const float*)args.in[17] + (size_t)Lw * DM * DFF}, DFF, DM, (const float*)args.in[15] + Lw * DM, (u16*)((unsigned char*)wl + W_GU), 5632 / 32, scr, r, lane); return; } r -= I_GU;
        if (r < I_DN) { transpose_items<NI>(MapIdent{(const float*)args.in[18] + (size_t)Lw * DFF * DM}, DM, DFF, nullptr, (u16*)((unsigned char*)wl + W_DN), 32, scr, r, lane); return; } r -= I_DN;
        if (r < I_PG) { transpose_items<NI>(MapIdent{(const float*)args.in[21] + (size_t)Lw * DM * DM}, DM, DM, (const float*)args.in[19] + Lw * DM, (u16*)((unsigned char*)wl + W_PG), 32, scr, r, lane); return; } r -= I_PG;
        transpose_items<NI>(MapIdent{(const float*)args.in[20] + (size_t)Lw * PLE * DM}, DM, PLE, nullptr, (u16*)((unsigned char*)wl + W_PP), 32, scr, r, lane);
    };
    if (MK_MASK & 1) if (IN(0))
_Pragma("unroll") for (int rep = 0; rep < REPS(0); ++rep) {
        const int lane = LANE_ID(), tid = wave * 64 + lane;
        float* ss = (float*)(ws + WS_SS); u16* H16A = (u16*)(ws + WS_H16); float2* rope = (float2*)(ws + WS_ROPE);
        LAS float* scr = (LAS float*)(lds + RING_OFF + wave * 16384);
        for (int it = gw; it < I_IN; it += NGW) weight_items(std::integral_constant<int, 1>{}, 0, it, scr, lane);
        for (int it = gw; it < 4 * (128 + 4); it += NGW) {
            const int c = it / 132, r = it % 132, L = c >> 1, kv = c & 1;
            const float* w1 = (const float*)args.in[kv ? 11 : 8] + (size_t)L * 2048 * 128; const float* w2 = (const float*)args.in[kv ? 12 : 9] + (size_t)L * 128 * 64;
            if (r < 128) transpose_item(MapIdent{w1}, 128, 2048, nullptr, (u16*)(ws + WS_CW + CW_W1T + (size_t)c * 524288), 4, scr, r, lane);
            else transpose_item(MapIdent{w2}, 64, 128, nullptr, (u16*)(ws + WS_CW + CW_W2T + (size_t)c * 16384), 2, scr, r - 128, lane);
        }
        for (int it = gw; it < 512; it += NGW) {
            const int c = it >> 7, hid = it & 127, L = c >> 1, kv = c & 1;
            const float* w1 = (const float*)args.in[kv ? 11 : 8] + (size_t)L * 2048 * 128; const float* pe = (const float*)args.in[kv ? 10 : 7] + (size_t)L * 2048;
            float s = 0.f; { float a_[32], b_[32];
#pragma unroll
              for (int i = 0; i < 32; ++i) { a_[i] = ((const GAS float*)pe)[lane + 64 * i]; b_[i] = ((const GAS float*)w1)[(size_t)(lane + 64 * i) * 128 + hid]; }
#pragma unroll
              for (int i = 0; i < 32; ++i) s += a_[i] * b_[i]; }
            s = wsum64(s); if (lane == 0) ((float*)(ws + WS_CW + CW_B1))[c * 128 + hid] = s;
        }
        {
            auto cost = [](int id) { if (id < 1024) { const int cur = id >> 4, nct = (4 * cur + 66) >> 6; return 150 + 18 * (2 * nct + cur + 1 + (cur + 1 < 9 ? cur + 1 : 9)); }
                                     if (id < 1536) { const int q = 4 * (((id - 1024) >> 5) + 1); return 100 + 18 * (q < 15 ? q : 15); } return 200 + ((id - 1536) * 11) / 4; };
            for (int id = gw; id < 2048; id += NGW) { const int c = cost(id); float rank = 0.f;
                for (int o = lane; o < 2048; o += 64) { const int co = cost(o); rank += (co > c || (co == c && o < id)) ? 1.f : 0.f; }
                rank = wsum64(rank);
                if (lane == 0) ((u16*)(ws + WS_UTAB))[(int)rank] = (u16)id; }
        }
        {
            typedef float f32x4z __attribute__((ext_vector_type(4)));
            for (int i = (int)blockIdx.x * NWAVES * 64 + tid; i < 6 * T / 4; i += G * NWAVES * 64) ((GAS f32x4z*)(ss + T))[i] = (f32x4z){0.f, 0.f, 0.f, 0.f}; }
        const float* x = (const float*)args.in[0]; const int* pos = (const int*)args.in[2];
        for (int m0 = gw; m0 < T; m0 += 8 * NGW) {
            f32x4 v[8][4];
#pragma unroll
            for (int rr = 0; rr < 8; ++rr) { const int mr = m0 + rr * NGW < T ? m0 + rr * NGW : T - 1; const GAS f32x4* xr = (const GAS f32x4*)(x + (size_t)mr * DM) + lane;
#pragma unroll
                for (int j = 0; j < 4; ++j) v[rr][j] = xr[64 * j]; }
#pragma unroll
            for (int rr = 0; rr < 8; ++rr) { const int m = m0 + rr * NGW; float s = 0.f; if (m >= T) break;
                GAS unsigned long long* o8 = (GAS unsigned long long*)(H16A + (size_t)m * DM) + lane;
#pragma unroll
                for (int j = 0; j < 4; ++j) { const f32x4 w = v[rr][j]; s += (w[0] * w[0] + w[1] * w[1]) + (w[2] * w[2] + w[3] * w[3]);
                    typedef _Float16 h4 __attribute__((ext_vector_type(4))); h4 hv = {(_Float16)w[0], (_Float16)w[1], (_Float16)w[2], (_Float16)w[3]};
                    o8[64 * j] = __builtin_bit_cast(unsigned long long, hv); }
                s = wsum64(s);
                if (lane == 0) ss[m] = s;
                if (lane < 32) { const float inv_freq = powf(10000.f, -(float)lane / 32.f); const float ang = (float)pos[m] * inv_freq; rope[(size_t)m * 32 + lane] = make_float2(cosf(ang), sinf(ang)); } }
        }
        if (blockIdx.x == 0 && tid < 64) { const int L = tid >> 5, c = tid & 31; float v = 0.f; if (c < 24) v = ((const float*)args.in[5])[L * 24 + c]; else if (c < 28) v = ((const float*)args.in[6])[L * 4 + c - 24]; ((float*)(ws + WS_BIAS))[tid] = v; }
    }
    SEAM(0);

#pragma unroll 1
    for (int L = 0; L < DEPTH; ++L) {
        const int pb = 1 + 7 * L;
#define PH_LOCALS unsigned char* wsl = args.ws; asm volatile("" : "+s"(wsl)); \
        u16* hcur = (u16*)(wsl + ((L & 1) ? WS_H16B : WS_H16)); (void)hcur; float* ssL = (float*)(wsl + WS_SS) + (size_t)(3 * L) * T; (void)ssL; \
        const unsigned char* wl = wsl + WS_W + (size_t)L * W_LAYER; (void)wl;
        if ((MK_MASK >> 1) & 1) if (IN(pb + 0))
_Pragma("unroll") for (int rep = 0; rep < REPS(1); ++rep) { PH_LOCALS
            pg8::Gemm g{hcur, (const u16*)(wl + W_IN), T, NIN_PAD, DM}; pg8::StaticOrder S; S.init(T, NIN_PAD, G, (int)blockIdx.x);
            pg8::EpiInProj E{wsl, L};
            if constexpr ((MK_REPEAT) & 0x800) { RepOrder S2{S, (S.nwg + G - 1) / G}; pg8::gemm_phase<pg8::EpiInProj, RepOrder, true, true>(lds + RING_OFF, g, S2, E, wave); }
            else
            pg8::gemm_phase<pg8::EpiInProj, pg8::StaticOrder, true, true>(lds + RING_OFF, g, S, E, wave);
        }
        SEAM(pb + 0);
        if ((MK_MASK >> 2) & 1) if (IN(pb + 1))
_Pragma("unroll") for (int rep = 0; rep < REPS(2); ++rep) {
            unsigned char* wsl = args.ws; asm volatile("" : "+s"(wsl));
            const int lane = LANE_ID(); const int gw = (int)blockIdx.x * NWAVES + wave, NGW = G * NWAVES;
            for (int it = (G > 64 ? gw - 32 * NWAVES : gw); it < 2048; it += (G > 64 ? NGW - 32 * NWAVES : NGW)) { if (it < 0) break;
                const GAS att::h8* kr = (const GAS att::h8*)((const u16*)(wsl + WS_FK) + ((size_t)it * 64 + lane) * 64); float s = 0.f;
#pragma unroll
                for (int c = 0; c < 8; ++c) { const att::h8 v = kr[c];
#pragma unroll
                    for (int j = 0; j < 8; ++j) { const float x = (float)v[j]; s += x * x; } }
                s = fmaxf(s, lx<1>(s)); s = fmaxf(s, lx<2>(s)); s = fmaxf(s, lx<4>(s)); s = fmaxf(s, lx<8>(s)); s = fmaxf(s, lx<16>(s)); s = pair_max(s);
                if (lane == 0) ((GAS float*)(wsl + WS_KN))[it] = sqrtf(s);
            }
            for (int u = (int)blockIdx.x; u < 256; u += G) {
                const int kv = u >> 7, bg = (u >> 3) & 15, n0 = (u & 7) * 32, c = 2 * L + kv;
                att::compress_unit((const u16*)(wsl + (kv ? WS_VC_IN : WS_KC_IN)) + (size_t)bg * SEQ * 64, (const u16*)(wsl + WS_CW + CW_W1T + (size_t)c * 524288),
                                   (const float*)(wsl + WS_CW + CW_B1) + c * 128, (const u16*)(wsl + WS_CW + CW_W2T + (size_t)c * 16384),
                                   (u16*)(wsl + (kv ? WS_VC : WS_KC)) + (size_t)bg * NCMP_PAD * 64, n0, wave, lane, lds);
            }
            if ((int)blockIdx.x < 32) {
                const int bh = (int)blockIdx.x, tid = wave * 64 + lane;
                const GAS f32x4* fp = (const GAS f32x4*)((const float*)(wsl + WS_FLOG) + (size_t)bh * SEQ) + 2 * tid; const f32x4 xa = fp[0], xb = fp[1];
                const float tot = ((xa[0] + xa[1]) + (xa[2] + xa[3])) + ((xb[0] + xb[1]) + (xb[2] + xb[3]));
                float inc = tot;
#pragma unroll
                for (int d = 1; d < 64; d <<= 1) { const float v = __int_as_float(__builtin_amdgcn_ds_bpermute(4 * (lane - d), __float_as_int(inc))); if (lane >= d) inc += v; }
                LAS float* wt = (LAS float*)(lds + att::L_FLAG);
                if (lane == 63) wt[wave] = inc;
                __syncthreads();
                float acc = inc - tot;
                for (int w = 0; w < 8; ++w) acc += (w < wave) ? wt[w] : 0.f;
                f32x4 oa, ob;
                acc += xa[0]; oa[0] = acc * LOG2E; acc += xa[1]; oa[1] = acc * LOG2E; acc += xa[2]; oa[2] = acc * LOG2E; acc += xa[3]; oa[3] = acc * LOG2E;
                acc += xb[0]; ob[0] = acc * LOG2E; acc += xb[1]; ob[1] = acc * LOG2E; acc += xb[2]; ob[2] = acc * LOG2E; acc += xb[3]; ob[3] = acc * LOG2E;
                GAS f32x4* op = (GAS f32x4*)((float*)(wsl + WS_CFOX) + (size_t)bh * SEQ) + 2 * tid; op[0] = oa; op[1] = ob;
                __syncthreads();
            }
        }
        SEAM(pb + 1);
        if ((MK_MASK >> 3) & 1) if (IN(pb + 2))
{ constexpr int rep = 0; constexpr int NQ = ((MK_REPEAT) & 0x708) ? 4096 : 2048;
            unsigned char* wsl = args.ws; asm volatile("" : "+s"(wsl));
            const int lane = LANE_ID();
            gu32* head = (gu32*)(wsl + WS_CTL) + CW_QUEUE + 64 * (L + 2 * rep);
            volatile LAS unsigned* slot = (volatile LAS unsigned*)(lds + att::L_SLOT);
            (void)NQ;
            const int def_w = (L == 0) ? DEF_W_UNITS0 : DEF_W_UNITS1, nq = 2048 + def_w + ((L == 0) ? DEF_P_UNITS : 0);
            for (;;) {
                const int u = att::fetch_unit(head, slot, wave == 0 && lane == 0);
                if (u >= nq) break;
                if (u >= 2048) {
                    const int d = u - 2048;
                    if (d < def_w) {
                        LAS float* scr = (LAS float*)(lds + att::L_OT + wave * 8704);
                        { const int j = d * 32 + wave * 4; const bool own = (L == 1) || j < I_LAYER - I_IN;
                            weight_items(std::integral_constant<int, 4>{}, (L == 1 || !own) ? 1 : 0, own ? I_IN + j : j - (I_LAYER - I_IN), scr, lane); }
                    } else {
                        const float* p = (const float*)args.in[1]; u16* p16 = (u16*)(wsl + WS_P16);
                        const size_t i0 = (size_t)(d - def_w) * 8192 + (size_t)(wave * 64 + lane);
#pragma unroll 1
                        for (int rnd = 0; rnd < 4; ++rnd) { f32x4 pa[4], pb[4];
#pragma unroll
                            for (int k = 0; k < 4; ++k) { const size_t i = i0 + (size_t)(4 * rnd + k) * 512; pa[k] = ((const GAS f32x4*)p)[2 * i]; pb[k] = ((const GAS f32x4*)p)[2 * i + 1]; }
#pragma unroll
                            for (int k = 0; k < 4; ++k) { const size_t i = i0 + (size_t)(4 * rnd + k) * 512;
                                pg8::h16x8 o = {(_Float16)pa[k][0], (_Float16)pa[k][1], (_Float16)pa[k][2], (_Float16)pa[k][3], (_Float16)pb[k][0], (_Float16)pb[k][1], (_Float16)pb[k][2], (_Float16)pb[k][3]};
                                ((GAS pg8::h16x8*)p16)[i] = o; } }
                    }
                    continue;
                }
                const int id = ((const GAS u16*)(wsl + WS_UTAB))[u];
#ifndef MK_UNITS
#define MK_UNITS 7
#endif
                if (id < 1024) { if (MK_UNITS & 1) att::nsa_unit(wsl, lds, id & 15, id >> 4, wave, lane); }
                else { const int v = (id - 1024) & 511, qb = v >> 5, bh = v & 31;
                    if (id < 1536) { if (MK_UNITS & 2) att::fox_unit(wsl, lds, bh, qb, wave, lane); } else { if (MK_UNITS & 4) att::sb_unit(wsl, lds, bh, qb, wave, lane); } }
            }
        }
        SEAM(pb + 2);
        if ((MK_MASK >> 4) & 1) if (IN(pb + 3))
_Pragma("unroll") for (int rep = 0; rep < REPS(4); ++rep) { PH_LOCALS
            pg8::Gemm g{(const u16*)(wsl + WS_O16), (const u16*)(wl + W_OUT), T, DM, DM}; pg8::StaticOrder S; S.init(T, DM, G, (int)blockIdx.x);
            if (REPS(4) == 2 && rep == 0) { pg8::EpiStore E{(u16*)(wsl + WS_ACT)}; pg8::gemm_phase<pg8::EpiStore, pg8::StaticOrder, true, true>(lds + RING_OFF, g, S, E, wave); }
            else { pg8::EpiResid E{hcur, ssL + T, (LAS float*)(lds + pg8::STAGE_BYTES)};
            pg8::gemm_phase<pg8::EpiResid, pg8::StaticOrder, true, true>(lds + RING_OFF, g, S, E, wave); }
        }
        SEAM(pb + 3);
        if ((MK_MASK >> 5) & 1) if (IN(pb + 4))
_Pragma("unroll") for (int rep = 0; rep < REPS(5); ++rep) { PH_LOCALS
            int grp = 0; asm volatile("" : "+s"(grp));
#pragma nounroll
            for (int part = 0; part < 3; ++part) {
                if (part == 1) { pg8::Gemm g{hcur, (const u16*)(wl + W_GU), T, 2 * DFF, DM}; pg8::StaticOrder S; S.init(T, 2 * DFF, G, (int)blockIdx.x);
                    pg8::EpiSwiglu E{ssL + T, (u16*)(wsl + WS_ACT)};
                    pg8::gemm_phase<pg8::EpiSwiglu, pg8::StaticOrder, true, true>(lds + RING_OFF, g, S, E, wave); }
                else { pg8::Gemm g{(const u16*)(wsl + WS_P16) + (size_t)L * T * PLE, (const u16*)(wl + W_PP), T, DM, PLE};
                    RangeOrder S; S.b.init(T, DM, G, (int)blockIdx.x); S.i0 = part == 0 ? 0 : grp; S.cnt = part == 0 ? grp : 2 - grp;
                    pg8::EpiStore E{(u16*)(wsl + WS_O16)};
                    pg8::gemm_phase<pg8::EpiStore, RangeOrder, true, true>(lds + RING_OFF, g, S, E, wave); }
            }
        }
        SEAM(pb + 4);
        if ((MK_MASK >> 6) & 1) if (IN(pb + 5))
_Pragma("unroll") for (int rep = 0; rep < REPS(6); ++rep) { PH_LOCALS
            pg8::Gemm g{(const u16*)(wsl + WS_ACT), (const u16*)(wl + W_DN), T, DM, DFF}; pg8::StaticOrder S; S.init(T, DM, G, (int)blockIdx.x);
            if (REPS(6) == 2 && rep == 0) { pg8::EpiStore E{(u16*)(wsl + ((L & 1) ? WS_H16 : WS_H16B))}; pg8::gemm_phase<pg8::EpiStore, pg8::StaticOrder, true, true>(lds + RING_OFF, g, S, E, wave); }
            else { pg8::EpiResid E{hcur, ssL + 2 * T, (LAS float*)(lds + pg8::STAGE_BYTES)};
            pg8::gemm_phase<pg8::EpiResid, pg8::StaticOrder, true, true>(lds + RING_OFF, g, S, E, wave); }
        }
        SEAM(pb + 5);
        if ((MK_MASK >> 7) & 1) if (IN(pb + 6))
_Pragma("unroll") for (int rep = 0; rep < REPS(7); ++rep) { PH_LOCALS
            pg8::Gemm g{hcur, (const u16*)(wl + W_PG), T, DM, DM}; pg8::StaticOrder S; S.init(T, DM, G, (int)blockIdx.x);
            if (REPS(7) == 2 && rep == 0) { pg8::EpiStore E{(u16*)(wsl + ((L & 1) ? WS_H16 : WS_H16B))}; pg8::gemm_phase<pg8::EpiStore, pg8::StaticOrder, true, true>(lds + RING_OFF, g, S, E, wave); }
            else if (L == DEPTH - 1 && args.fuse_final) { pg8::EpiPleFinal E{wsl, args.out, (const float*)args.in[22], L, (LAS float*)(lds + pg8::STAGE_BYTES)};
            pg8::gemm_phase<pg8::EpiPleFinal, pg8::StaticOrder, true, true>(lds + RING_OFF, g, S, E, wave); }
            else { pg8::EpiPle E{wsl, L, (LAS float*)(lds + pg8::STAGE_BYTES)};
            pg8::gemm_phase<pg8::EpiPle, pg8::StaticOrder, true, true>(lds + RING_OFF, g, S, E, wave); }
        }
        if (L < DEPTH - 1 || !args.fuse_final) SEAM(pb + 6);
    }
    if (!args.fuse_final) if ((MK_MASK >> 15) & 1) if (IN(15))
_Pragma("unroll") for (int rep = 0; rep < REPS(15); ++rep) {
        const int lane = LANE_ID();
        const float* ssF = (const float*)(ws + WS_SS) + (size_t)6 * T; const float* gf = (const float*)args.in[22]; const u16* hf = (const u16*)(ws + WS_H16);
        for (int m = gw; m < T; m += NGW) {
            const float rstd = rsqrtf(ssF[m] * (1.f / DM) + RMS_EPS);
            const unsigned long long* h8 = (const unsigned long long*)(hf + (size_t)m * DM) + lane; f32x4* o = (f32x4*)(args.out + (size_t)m * DM) + lane;
#pragma unroll
            for (int j = 0; j < 4; ++j) { typedef _Float16 h4 __attribute__((ext_vector_type(4))); const h4 hv = __builtin_bit_cast(h4, h8[64 * j]); const f32x4 gv = ((const f32x4*)gf)[64 * j + lane];
                o[64 * j] = (f32x4){(float)hv[0] * rstd * gv[0], (float)hv[1] * rstd * gv[1], (float)hv[2] * rstd * gv[2], (float)hv[3] * rstd * gv[3]}; }
        }
    }
#undef IN
#undef SEAM
}


extern "C" void kernel_launch(void* const* d_in, const int* in_sizes, int n_in, void* d_out, int out_size, void* d_ws, size_t ws_size, hipStream_t stream) {
    static int grid = 0;
    if (grid == 0) {
        if (n_in != 23 || ws_size < WS_END2 || out_size != T * DM) { fprintf(stderr, "kernel_launch: unexpected inputs (n_in %d, ws %zu < %zu, out %d)\n", n_in, ws_size, (size_t)WS_END2, out_size); grid = -1; return; }
        int dev = 0, cus = 0, per_cu = 0;
        if (hipGetDevice(&dev) != hipSuccess || hipDeviceGetAttribute(&cus, hipDeviceAttributeMultiprocessorCount, dev) != hipSuccess) { grid = -1; return; }
        if (hipFuncSetAttribute((const void*)mk_fwd, hipFuncAttributeMaxDynamicSharedMemorySize, LDS_BYTES) != hipSuccess) { fprintf(stderr, "kernel_launch: hipFuncSetAttribute failed\n"); grid = -1; return; }
        if (hipOccupancyMaxActiveBlocksPerMultiprocessor(&per_cu, (const void*)mk_fwd, NWAVES * 64, LDS_BYTES) != hipSuccess || per_cu < 1) { fprintf(stderr, "kernel_launch: occupancy query says %d blocks per CU\n", per_cu); }
        (void)hipGetLastError();
        grid = cus;
    }
    if (grid < 0) return;
    unsigned char* ws = (unsigned char*)d_ws;
    (void)hipMemsetAsync(ws, 0, ZERO_BYTES, stream);
    Args a{};
    for (int i = 0; i < 23; ++i) a.in[i] = d_in[i];
    a.out = (float*)d_out; a.ws = ws; a.ph_lo = 0; a.ph_hi = 16; a.bar_region = 0; a.rep_mask = 0;
    a.fuse_final = (grid % 256 == 0) ? 1 : 0;
    hipLaunchKernelGGL(mk_fwd, dim3(grid), dim3(NWAVES * 64), LDS_BYTES, stream, a);
}
```
